# Optimizing an MI355X kernel written in HIP

```python
import math
import jax, jax.numpy as jnp
from jax import lax
import numpy as np

D_MODEL = 2048
BATCH = 8
SEQ = 2048
DEPTH = 1

N_META = 16
Q_BLOCK = 128
EPS = 1e-6

MLA_HEADS = 16
MLA_Q_RANK = 768
MLA_KV_RANK = 512
MLA_NOPE = 128
MLA_ROPE = 64
MLA_V = 128
MLA_QK = MLA_NOPE + MLA_ROPE
MLA_WIDTH = MLA_HEADS * MLA_V
ROPE_THETA = 10000.0

DIFF_HEADS = 8
DIFF_QK = 128
DIFF_V = 2 * DIFF_QK
DIFF_WIDTH = DIFF_HEADS * DIFF_V
DIFF_QK_WIDTH = DIFF_HEADS * 2 * DIFF_QK

REL_BUCKETS = 32
REL_MAX_DIST = 128

IN_SPLITS = (MLA_Q_RANK, MLA_KV_RANK, MLA_ROPE, MLA_WIDTH,
             DIFF_QK_WIDTH, DIFF_QK_WIDTH, DIFF_WIDTH, DIFF_WIDTH,
             D_MODEL, D_MODEL)
IN_WIDTH = sum(IN_SPLITS)

kernel_name = "hybrid_mla_diffattn_gated_encoder"


def rmsnorm(x, g):
    xf = x.astype(jnp.float32)
    y = xf * lax.rsqrt(jnp.mean(xf * xf, axis=-1, keepdims=True) + EPS)
    return (y * g.astype(jnp.float32)).astype(x.dtype)


def apply_rope(x, pos):
    half = x.shape[-1] // 2
    inv = ROPE_THETA ** (-jnp.arange(half, dtype=jnp.float32) / half)
    ang = pos.astype(jnp.float32)[:, None] * inv[None, :]
    cos = jnp.cos(ang)[None, :, None, :]
    sin = jnp.sin(ang)[None, :, None, :]
    x1 = x[..., :half].astype(jnp.float32)
    x2 = x[..., half:].astype(jnp.float32)
    out = jnp.concatenate([x1 * cos - x2 * sin, x2 * cos + x1 * sin], axis=-1)
    return out.astype(x.dtype)


def t5_bucket(rel):
    nb = REL_BUCKETS // 2
    max_exact = nb // 2
    ret = jnp.where(rel > 0, nb, 0)
    n = jnp.abs(rel)
    nf = jnp.maximum(n, 1).astype(jnp.float32)
    large = max_exact + (jnp.log(nf / max_exact) / math.log(REL_MAX_DIST / max_exact)
                         * (nb - max_exact)).astype(jnp.int32)
    large = jnp.minimum(large, nb - 1)
    return ret + jnp.where(n < max_exact, n, large)


def _to_blocks(t, n_blk):
    pad = n_blk * Q_BLOCK - t.shape[1]
    t = jnp.pad(t, [(0, 0), (0, pad)] + [(0, 0)] * (t.ndim - 2))
    t = t.reshape((t.shape[0], n_blk, Q_BLOCK) + t.shape[2:])
    return jnp.moveaxis(t, 1, 0)


def _from_blocks(o, L):
    o = jnp.moveaxis(o, 0, 1)
    o = o.reshape((o.shape[0], -1) + o.shape[3:])
    return o[:, :L]


def mla_attention(q, k, v):
    L = q.shape[1]
    n_blk = -(-L // Q_BLOCK)
    scale = MLA_QK ** -0.5

    def body(qb):
        s = jnp.einsum("bqhd,bkhd->bhqk", qb, k, preferred_element_type=jnp.float32) * scale
        p = jax.nn.softmax(s, axis=-1).astype(v.dtype)
        return jnp.einsum("bhqk,bkhd->bqhd", p, v)

    return _from_blocks(lax.map(body, _to_blocks(q, n_blk)), L)


def diff_attention(q1, q2, k1, k2, v, lam, rel_bias):
    L = q1.shape[1]
    n_blk = -(-L // Q_BLOCK)
    scale = DIFF_QK ** -0.5
    kpos = jnp.arange(L, dtype=jnp.int32)
    qpos_blocks = jnp.arange(n_blk * Q_BLOCK, dtype=jnp.int32).reshape(n_blk, Q_BLOCK)

    def body(args):
        q1b, q2b, qpos = args
        bias = rel_bias[t5_bucket(kpos[None, :] - qpos[:, None])]
        bias = jnp.transpose(bias, (2, 0, 1)).astype(jnp.float32)[None]
        s1 = jnp.einsum("bqhd,bkhd->bhqk", q1b, k1, preferred_element_type=jnp.float32) * scale + bias
        s2 = jnp.einsum("bqhd,bkhd->bhqk", q2b, k2, preferred_element_type=jnp.float32) * scale + bias
        a = jax.nn.softmax(s1, axis=-1) - lam * jax.nn.softmax(s2, axis=-1)
        return jnp.einsum("bhqk,bkhd->bqhd", a.astype(v.dtype), v)

    out = lax.map(body, (_to_blocks(q1, n_blk), _to_blocks(q2, n_blk), qpos_blocks))
    return _from_blocks(out, L)


def hybrid_layer(h, pos, rel_bias, norm_in, w_in, q_a_norm, kv_a_norm, w_uq, w_ukv,
                 mla_q_norm, mla_k_norm, diff_q_norm, diff_k_norm, diff_lambda,
                 diff_subln, w_branch_a, w_branch_b, w_out, layer_idx):
    B, L, _ = h.shape
    u = rmsnorm(h, norm_in)
    proj = u @ w_in
    split_at = [int(i) for i in np.cumsum(IN_SPLITS)[:-1]]
    c_q, c_kv, k_rope, z_a, q_d, k_d, v_d, z_b, g_a, g_b = jnp.split(proj, split_at, axis=-1)

    q = (rmsnorm(c_q, q_a_norm) @ w_uq).reshape(B, L, MLA_HEADS, MLA_QK)
    kv = (rmsnorm(c_kv, kv_a_norm) @ w_ukv).reshape(B, L, MLA_HEADS, MLA_NOPE + MLA_V)
    k_nope, v_a = kv[..., :MLA_NOPE], kv[..., MLA_NOPE:]
    k_r = jnp.broadcast_to(k_rope[:, :, None, :], (B, L, MLA_HEADS, MLA_ROPE))
    k = jnp.concatenate([k_nope, k_r], axis=-1)
    q = rmsnorm(q, mla_q_norm)
    k = rmsnorm(k, mla_k_norm)
    q = jnp.concatenate([q[..., :MLA_NOPE], apply_rope(q[..., MLA_NOPE:], pos)], axis=-1)
    k = jnp.concatenate([k[..., :MLA_NOPE], apply_rope(k[..., MLA_NOPE:], pos)], axis=-1)
    o_a = mla_attention(q, k, v_a).reshape(B, L, MLA_WIDTH) * jax.nn.silu(z_a)

    q_d = rmsnorm(q_d.reshape(B, L, DIFF_HEADS, 2, DIFF_QK), diff_q_norm)
    k_d = rmsnorm(k_d.reshape(B, L, DIFF_HEADS, 2, DIFF_QK), diff_k_norm)
    v_d = v_d.reshape(B, L, DIFF_HEADS, DIFF_V)
    lam_init = 0.8 - 0.6 * math.exp(-0.3 * layer_idx)
    lv = diff_lambda.astype(jnp.float32)
    lam = jnp.exp(jnp.sum(lv[0] * lv[1])) - jnp.exp(jnp.sum(lv[2] * lv[3])) + lam_init
    o_b = diff_attention(q_d[..., 0, :], q_d[..., 1, :], k_d[..., 0, :], k_d[..., 1, :],
                         v_d, lam, rel_bias)
    o_b = rmsnorm(o_b, diff_subln) * (1.0 - lam_init)
    o_b = o_b.reshape(B, L, DIFF_WIDTH) * jax.nn.silu(z_b)

    m = jax.nn.sigmoid(g_a) * (o_a @ w_branch_a) + jax.nn.sigmoid(g_b) * (o_b @ w_branch_b)
    return h + m @ w_out


def setup_inputs(seed: int = 0) -> dict:
    key = jax.random.key(seed)
    ks = jax.random.split(key, 18)
    f32 = jnp.float32

    def nrm(k, shape, scale):
        return jax.random.normal(k, shape, f32) * scale

    def gain(k, shape):
        return 1.0 + 0.02 * jax.random.normal(k, shape, f32)

    Lr = DEPTH
    return {
        "x": nrm(ks[0], (BATCH, SEQ, D_MODEL), 1.0),
        "meta_tokens": nrm(ks[1], (N_META, D_MODEL), 1.0),
        "rel_bias": nrm(ks[2], (REL_BUCKETS, DIFF_HEADS), 0.5),
        "norm_in": gain(ks[3], (Lr, D_MODEL)),
        "w_in": nrm(ks[4], (Lr, D_MODEL, IN_WIDTH), D_MODEL ** -0.5),
        "q_a_norm": gain(ks[5], (Lr, MLA_Q_RANK)),
        "kv_a_norm": gain(ks[6], (Lr, MLA_KV_RANK)),
        "w_uq": nrm(ks[7], (Lr, MLA_Q_RANK, MLA_HEADS * MLA_QK), MLA_Q_RANK ** -0.5),
        "w_ukv": nrm(ks[8], (Lr, MLA_KV_RANK, MLA_HEADS * (MLA_NOPE + MLA_V)), MLA_KV_RANK ** -0.5),
        "mla_q_norm": gain(ks[9], (Lr, MLA_QK)),
        "mla_k_norm": gain(ks[10], (Lr, MLA_QK)),
        "diff_q_norm": gain(ks[11], (Lr, DIFF_QK)),
        "diff_k_norm": gain(ks[12], (Lr, DIFF_QK)),
        "diff_lambda": nrm(ks[13], (Lr, 4, DIFF_QK), 0.1),
        "diff_subln": gain(ks[14], (Lr, DIFF_V)),
        "w_branch_a": nrm(ks[15], (Lr, MLA_WIDTH, D_MODEL), MLA_WIDTH ** -0.5),
        "w_branch_b": nrm(ks[16], (Lr, DIFF_WIDTH, D_MODEL), DIFF_WIDTH ** -0.5),
        "w_out": nrm(ks[17], (Lr, D_MODEL, D_MODEL), D_MODEL ** -0.5),
    }


def reference(x, meta_tokens, rel_bias, norm_in, w_in, q_a_norm, kv_a_norm, w_uq, w_ukv,
              mla_q_norm, mla_k_norm, diff_q_norm, diff_k_norm, diff_lambda, diff_subln,
              w_branch_a, w_branch_b, w_out):
    B = x.shape[0]
    meta = jnp.broadcast_to(meta_tokens[None].astype(x.dtype), (B, N_META, x.shape[-1]))
    h = jnp.concatenate([meta, x], axis=1)
    pos = jnp.arange(h.shape[1], dtype=jnp.int32)
    for l in range(DEPTH):
        h = hybrid_layer(h, pos, rel_bias, norm_in[l], w_in[l], q_a_norm[l], kv_a_norm[l],
                         w_uq[l], w_ukv[l], mla_q_norm[l], mla_k_norm[l], diff_q_norm[l],
                         diff_k_norm[l], diff_lambda[l], diff_subln[l], w_branch_a[l],
                         w_branch_b[l], w_out[l], l)
    return h[:, N_META:]
```

```cpp
#include <hip/hip_runtime.h>
#include <math.h>
namespace nv {
constexpr int D = 2048, NBATCH = 8, SEQ = 2048, NMETA = 16, L = 2064, INW = 15680;
constexpr int C_CQ = 0, C_CKV = 768, C_KR = 1280, C_ZA = 1344, C_QD = 3392, C_KD = 5440, C_VD = 7488, C_ZB = 9536, C_GA = 11584, C_GB = 13632;
constexpr float EPS = 1e-6f;

template <bool TB>
__global__ void __launch_bounds__(256) ngemm(const float* __restrict__ A, int lda, long sA, const float* __restrict__ B, int ldb, long sB,
                                             float* __restrict__ C, int ldc, long sC, int M, int N, int K) {
    __shared__ float As[16][68], Bs[16][68];
    const int tid = threadIdx.x, tx = tid & 15, ty = tid >> 4;
    const int m0 = blockIdx.y * 64, n0 = blockIdx.x * 64;
    A += (long)blockIdx.z * sA; B += (long)blockIdx.z * sB; C += (long)blockIdx.z * sC;
    float acc[4][4];
#pragma unroll
    for (int i = 0; i < 4; ++i)
#pragma unroll
        for (int j = 0; j < 4; ++j) acc[i][j] = 0.f;
    for (int k0 = 0; k0 < K; k0 += 16) {
#pragma unroll
        for (int i = 0; i < 4; ++i) {
            const int idx = tid + 256 * i, m = idx >> 4, k = idx & 15;
            const int gm = m0 + m;
            As[k][m] = (gm < M) ? A[(long)gm * lda + k0 + k] : 0.f;
        }
        if (TB) {
#pragma unroll
            for (int i = 0; i < 4; ++i) {
                const int idx = tid + 256 * i, n = idx >> 4, k = idx & 15;
                const int gn = n0 + n;
                Bs[k][n] = (gn < N) ? B[(long)gn * ldb + k0 + k] : 0.f;
            }
        } else {
#pragma unroll
            for (int i = 0; i < 4; ++i) {
                const int idx = tid + 256 * i, k = idx >> 6, n = idx & 63;
                const int gn = n0 + n;
                Bs[k][n] = (gn < N) ? B[(long)(k0 + k) * ldb + gn] : 0.f;
            }
        }
        __syncthreads();
#pragma unroll
        for (int k = 0; k < 16; ++k) {
            float a[4], b[4];
#pragma unroll
            for (int i = 0; i < 4; ++i) a[i] = As[k][ty * 4 + i];
#pragma unroll
            for (int j = 0; j < 4; ++j) b[j] = Bs[k][tx * 4 + j];
#pragma unroll
            for (int i = 0; i < 4; ++i)
#pragma unroll
                for (int j = 0; j < 4; ++j) acc[i][j] = fmaf(a[i], b[j], acc[i][j]);
        }
        __syncthreads();
    }
#pragma unroll
    for (int i = 0; i < 4; ++i) {
        const int gm = m0 + ty * 4 + i;
        if (gm < M) {
#pragma unroll
            for (int j = 0; j < 4; ++j) { const int gn = n0 + tx * 4 + j; if (gn < N) C[(long)gm * ldc + gn] = acc[i][j]; }
        }
    }
}

__device__ __forceinline__ float block_sum(float v, float* red) {
#pragma unroll
    for (int o = 32; o > 0; o >>= 1) v += __shfl_xor(v, o);
    const int w = threadIdx.x >> 6;
    __syncthreads();
    if ((threadIdx.x & 63) == 0) red[w] = v;
    __syncthreads();
    float s = 0.f;
    for (int i = 0; i < (int)(blockDim.x >> 6); ++i) s += red[i];
    return s;
}
__device__ __forceinline__ float block_max(float v, float* red) {
#pragma unroll
    for (int o = 32; o > 0; o >>= 1) v = fmaxf(v, __shfl_xor(v, o));
    const int w = threadIdx.x >> 6;
    __syncthreads();
    if ((threadIdx.x & 63) == 0) red[w] = v;
    __syncthreads();
    float s = red[0];
    for (int i = 1; i < (int)(blockDim.x >> 6); ++i) s = fmaxf(s, red[i]);
    return s;
}

__global__ void __launch_bounds__(256) rms_rows(const float* __restrict__ in, int ldi, const float* __restrict__ g, float* __restrict__ out, int ldo, int cols, float post) {
    __shared__ float red[4];
    const float* x = in + (long)blockIdx.x * ldi; float* o = out + (long)blockIdx.x * ldo;
    float s = 0.f;
    for (int c = threadIdx.x; c < cols; c += 256) { const float v = x[c]; s += v * v; }
    s = block_sum(s, red);
    const float rs = rsqrtf(s / (float)cols + EPS) * post;
    for (int c = threadIdx.x; c < cols; c += 256) o[c] = x[c] * rs * g[c];
}
__global__ void __launch_bounds__(256) rms_groups(const float* __restrict__ in, int ldi, const float* __restrict__ g, float* __restrict__ out, int ldo, int ngroups, int gsz, float post) {
    const int w = threadIdx.x >> 6, lane = threadIdx.x & 63;
    for (int gi = w; gi < ngroups; gi += 4) {
        const float* x = in + (long)blockIdx.x * ldi + gi * gsz; float* o = out + (long)blockIdx.x * ldo + gi * gsz;
        float s = 0.f;
        for (int c = lane; c < gsz; c += 64) { const float v = x[c]; s += v * v; }
#pragma unroll
        for (int of = 32; of > 0; of >>= 1) s += __shfl_xor(s, of);
        const float rs = rsqrtf(s / (float)gsz + EPS) * post;
        for (int c = lane; c < gsz; c += 64) o[c] = x[c] * rs * g[c];
    }
}
__global__ void __launch_bounds__(256) mla_prep(const float* __restrict__ q, const float* __restrict__ kv, const float* __restrict__ proj,
                                               const float* __restrict__ gq, const float* __restrict__ gk, float* __restrict__ qf, float* __restrict__ kf) {
    __shared__ float buf[4][192];
    const int row = blockIdx.x, w = threadIdx.x >> 6, lane = threadIdx.x & 63;
    for (int job = w; job < 32; job += 4) {
        const int h = job & 15; const bool isk = job >= 16;
        float v[3]; float s = 0.f;
#pragma unroll
        for (int j = 0; j < 3; ++j) {
            const int d = lane + 64 * j;
            float x;
            if (!isk) x = q[(long)row * 3072 + h * 192 + d];
            else x = (d < 128) ? kv[(long)row * 4096 + h * 256 + d] : proj[(long)row * INW + C_KR + (d - 128)];
            v[j] = x; s += x * x;
        }
#pragma unroll
        for (int of = 32; of > 0; of >>= 1) s += __shfl_xor(s, of);
        const float rs = rsqrtf(s / 192.f + EPS);
        const float* g = isk ? gk : gq;
#pragma unroll
        for (int j = 0; j < 3; ++j) { const int d = lane + 64 * j; buf[w][d] = v[j] * rs * g[d]; }
        __syncthreads();
        float* o = (isk ? kf : qf) + (long)row * 3072 + h * 192;
#pragma unroll
        for (int j = 0; j < 3; ++j) {
            const int d = lane + 64 * j;
            float r;
            if (d < 128) r = buf[w][d];
            else {
                const int i = (d - 128) & 31; const bool second = (d - 128) >= 32;
                const float inv = powf(10000.f, -(float)i / 32.f);
                const float ang = (float)row * inv; const float c = cosf(ang), sn = sinf(ang);
                const float x1 = buf[w][128 + i], x2 = buf[w][160 + i];
                r = second ? (x2 * c + x1 * sn) : (x1 * c - x2 * sn);
            }
            o[d] = r;
        }
        __syncthreads();
    }
}
__device__ __forceinline__ int t5_bucket(int rel) {
    const int n = rel < 0 ? -rel : rel; int b;
    if (n < 8) b = n;
    else b = 8 + (n >= 12) + (n >= 16) + (n >= 23) + (n >= 32) + (n >= 46) + (n >= 64) + (n >= 91);
    return b + (rel > 0 ? 16 : 0);
}
__global__ void __launch_bounds__(256) softmax_rows(float* __restrict__ S, float scale, const float* __restrict__ rel_bias, int zdiv, int h0) {
    __shared__ float red[4];
    const int qrow = blockIdx.x, z = blockIdx.y;
    float* s = S + ((long)z * L + qrow) * L;
    const int head = h0 + z / zdiv;
    float v[9]; float mx = -3.0e38f;
#pragma unroll
    for (int j = 0; j < 9; ++j) {
        const int k = threadIdx.x + 256 * j;
        float x = -3.0e38f;
        if (k < L) { x = s[k] * scale; if (rel_bias) x += rel_bias[t5_bucket(k - qrow) * 8 + head]; }
        v[j] = x; mx = fmaxf(mx, x);
    }
    mx = block_max(mx, red);
    float sum = 0.f;
#pragma unroll
    for (int j = 0; j < 9; ++j) { const int k = threadIdx.x + 256 * j; if (k < L) { v[j] = __expf(v[j] - mx); sum += v[j]; } }
    sum = block_sum(sum, red);
    const float inv = 1.f / sum;
#pragma unroll
    for (int j = 0; j < 9; ++j) { const int k = threadIdx.x + 256 * j; if (k < L) s[k] = v[j] * inv; }
}
__global__ void __launch_bounds__(256) lam_kernel(const float* __restrict__ dl, float* __restrict__ out) {
    __shared__ float red[4];
    const int t = threadIdx.x;
    float a = (t < 128) ? dl[t] * dl[128 + t] : 0.f;
    float b = (t < 128) ? dl[256 + t] * dl[384 + t] : 0.f;
    a = block_sum(a, red); b = block_sum(b, red);
    if (t == 0) out[0] = __expf(a) - __expf(b) + 0.2f;
}
__global__ void __launch_bounds__(256) diff_combine(float* __restrict__ S, const float* __restrict__ lam, int nh) {
    const long n = (long)L * L; const float lm = lam[0];
    for (int h = 0; h < nh; ++h) {
        float* p1 = S + (long)(2 * h) * n; const float* p2 = S + (long)(2 * h + 1) * n;
        for (long i = blockIdx.x * 256L + threadIdx.x; i < n; i += gridDim.x * 256L) p1[i] = p1[i] - lm * p2[i];
    }
}
__device__ __forceinline__ float silu_f(float v) { return v / (1.f + __expf(-v)); }
__device__ __forceinline__ float sigm_f(float v) { return 1.f / (1.f + __expf(-v)); }
__global__ void __launch_bounds__(256) mul_silu(float* __restrict__ o, const float* __restrict__ proj, int zc) {
    const int r = blockIdx.x;
    for (int c = threadIdx.x; c < D; c += 256) o[(long)r * D + c] *= silu_f(proj[(long)r * INW + zc + c]);
}
__global__ void __launch_bounds__(256) merge_gate(const float* __restrict__ ta, const float* __restrict__ tb, const float* __restrict__ proj, float* __restrict__ m) {
    const int r = blockIdx.x;
    for (int c = threadIdx.x; c < D; c += 256)
        m[(long)r * D + c] = sigm_f(proj[(long)r * INW + C_GA + c]) * ta[(long)r * D + c] + sigm_f(proj[(long)r * INW + C_GB + c]) * tb[(long)r * D + c];
}
__global__ void __launch_bounds__(256) final_add(const float* __restrict__ x, const float* __restrict__ tt, float* __restrict__ out) {
    const int t = blockIdx.x;
    for (int c = threadIdx.x; c < D; c += 256) out[(long)t * D + c] = x[(long)t * D + c] + tt[(long)(t + NMETA) * D + c];
}

struct NaiveBufs {
    float *h, *u, *q, *kv, *proj, *cqn, *ckvn, *qf, *kf, *S, *oa, *qdn, *kdn, *obp, *ob, *ta, *tb, *mm, *tt, *lam;
};
constexpr size_t naive_floats() {
    return (size_t)L * D * 2 + (size_t)L * 3072 + (size_t)L * 4096 + (size_t)L * INW + (size_t)L * 768 + (size_t)L * 512 + (size_t)L * 3072 * 2 + (size_t)8 * L * L + (size_t)L * D * 5 + 64;
}
inline NaiveBufs carve(float* p) {
    NaiveBufs b;
    b.h = p; p += (size_t)L * D; b.u = p; p += (size_t)L * D; b.q = p; p += (size_t)L * 3072; b.kv = p; p += (size_t)L * 4096;
    b.ta = b.h; b.tb = b.h + (size_t)L * D; b.mm = b.h + (size_t)2 * L * D; b.tt = b.h + (size_t)3 * L * D;
    b.proj = p; p += (size_t)L * INW; b.cqn = p; p += (size_t)L * 768; b.ckvn = p; p += (size_t)L * 512;
    b.qf = p; p += (size_t)L * 3072; b.kf = p; p += (size_t)L * 3072; b.S = p; p += (size_t)8 * L * L;
    b.oa = p; p += (size_t)L * D; b.qdn = p; p += (size_t)L * D; b.kdn = p; p += (size_t)L * D; b.obp = p; p += (size_t)L * D; b.ob = p; p += (size_t)L * D;
    b.lam = p; p += 64;
    return b;
}
struct NaiveIn { const float *x, *meta, *rel_bias, *norm_in, *w_in, *q_a_norm, *kv_a_norm, *w_uq, *w_ukv, *mla_q_norm, *mla_k_norm, *diff_q_norm, *diff_k_norm, *diff_lambda, *diff_subln, *w_a, *w_b, *w_out; };

template <bool TB>
inline void gemm(hipStream_t st, const float* A, int lda, long sA, const float* B, int ldb, long sB, float* C, int ldc, long sC, int M, int N, int K, int Z) {
    dim3 grid((N + 63) / 64, (M + 63) / 64, Z);
    hipLaunchKernelGGL(ngemm<TB>, grid, dim3(256), 0, st, A, lda, sA, B, ldb, sB, C, ldc, sC, M, N, K);
}
inline void forward_batch(hipStream_t st, const NaiveIn& in, const NaiveBufs& b, int batch, float* out) {
    hipMemcpyAsync(b.h, in.meta, (size_t)NMETA * D * 4, hipMemcpyDeviceToDevice, st);
    hipMemcpyAsync(b.h + (size_t)NMETA * D, in.x + (size_t)batch * SEQ * D, (size_t)SEQ * D * 4, hipMemcpyDeviceToDevice, st);
    hipLaunchKernelGGL(rms_rows, dim3(L), dim3(256), 0, st, b.h, D, in.norm_in, b.u, D, D, 1.f);
    gemm<false>(st, b.u, D, 0, in.w_in, INW, 0, b.proj, INW, 0, L, INW, D, 1);
    hipLaunchKernelGGL(rms_rows, dim3(L), dim3(256), 0, st, b.proj + C_CQ, INW, in.q_a_norm, b.cqn, 768, 768, 1.f);
    hipLaunchKernelGGL(rms_rows, dim3(L), dim3(256), 0, st, b.proj + C_CKV, INW, in.kv_a_norm, b.ckvn, 512, 512, 1.f);
    gemm<false>(st, b.cqn, 768, 0, in.w_uq, 3072, 0, b.q, 3072, 0, L, 3072, 768, 1);
    gemm<false>(st, b.ckvn, 512, 0, in.w_ukv, 4096, 0, b.kv, 4096, 0, L, 4096, 512, 1);
    hipLaunchKernelGGL(mla_prep, dim3(L), dim3(256), 0, st, b.q, b.kv, b.proj, in.mla_q_norm, in.mla_k_norm, b.qf, b.kf);
    for (int hg = 0; hg < 2; ++hg) {
        gemm<true>(st, b.qf + hg * 8 * 192, 3072, 192, b.kf + hg * 8 * 192, 3072, 192, b.S, L, (long)L * L, L, L, 192, 8);
        hipLaunchKernelGGL(softmax_rows, dim3(L, 8), dim3(256), 0, st, b.S, 0.07216878364870322f, (const float*)nullptr, 1, 0);
        gemm<false>(st, b.S, L, (long)L * L, b.kv + hg * 8 * 256 + 128, 4096, 256, b.oa + hg * 8 * 128, D, 128, L, 128, L, 8);
    }
    hipLaunchKernelGGL(mul_silu, dim3(L), dim3(256), 0, st, b.oa, b.proj, C_ZA);
    hipLaunchKernelGGL(lam_kernel, dim3(1), dim3(256), 0, st, in.diff_lambda, b.lam);
    hipLaunchKernelGGL(rms_groups, dim3(L), dim3(256), 0, st, b.proj + C_QD, INW, in.diff_q_norm, b.qdn, D, 16, 128, 1.f);
    hipLaunchKernelGGL(rms_groups, dim3(L), dim3(256), 0, st, b.proj + C_KD, INW, in.diff_k_norm, b.kdn, D, 16, 128, 1.f);
    for (int hg = 0; hg < 2; ++hg) {
        gemm<true>(st, b.qdn + hg * 1024, D, 128, b.kdn + hg * 1024, D, 128, b.S, L, (long)L * L, L, L, 128, 8);
        hipLaunchKernelGGL(softmax_rows, dim3(L, 8), dim3(256), 0, st, b.S, 0.08838834764831845f, in.rel_bias, 2, hg * 4);
        hipLaunchKernelGGL(diff_combine, dim3(2048), dim3(256), 0, st, b.S, b.lam, 4);
        gemm<false>(st, b.S, L, 2L * L * L, b.proj + C_VD + hg * 1024, INW, 256, b.obp + hg * 1024, D, 256, L, 256, L, 4);
    }
    hipLaunchKernelGGL(rms_groups, dim3(L), dim3(256), 0, st, b.obp, D, in.diff_subln, b.ob, D, 8, 256, 0.8f);
    hipLaunchKernelGGL(mul_silu, dim3(L), dim3(256), 0, st, b.ob, b.proj, C_ZB);
    gemm<false>(st, b.oa, D, 0, in.w_a, D, 0, b.ta, D, 0, L, D, D, 1);
    gemm<false>(st, b.ob, D, 0, in.w_b, D, 0, b.tb, D, 0, L, D, D, 1);
    hipLaunchKernelGGL(merge_gate, dim3(L), dim3(256), 0, st, b.ta, b.tb, b.proj, b.mm);
    gemm<false>(st, b.mm, D, 0, in.w_out, D, 0, b.tt, D, 0, L, D, D, 1);
    if (out) hipLaunchKernelGGL(final_add, dim3(SEQ), dim3(256), 0, st, in.x + (size_t)batch * SEQ * D, b.tt, out + (size_t)batch * SEQ * D);
}
}

extern "C" void kernel_launch(void* const* d_in, const int* in_sizes, int n_in, void* d_out, int out_size, void* d_ws, size_t ws_size, hipStream_t stream) {
    nv::NaiveIn in;
    in.x = (const float*)d_in[0]; in.meta = (const float*)d_in[1]; in.rel_bias = (const float*)d_in[2]; in.norm_in = (const float*)d_in[3];
    in.w_in = (const float*)d_in[4]; in.q_a_norm = (const float*)d_in[5]; in.kv_a_norm = (const float*)d_in[6]; in.w_uq = (const float*)d_in[7];
    in.w_ukv = (const float*)d_in[8]; in.mla_q_norm = (const float*)d_in[9]; in.mla_k_norm = (const float*)d_in[10]; in.diff_q_norm = (const float*)d_in[11];
    in.diff_k_norm = (const float*)d_in[12]; in.diff_lambda = (const float*)d_in[13]; in.diff_subln = (const float*)d_in[14];
    in.w_a = (const float*)d_in[15]; in.w_b = (const float*)d_in[16]; in.w_out = (const float*)d_in[17];
    if (ws_size < nv::naive_floats() * 4) return;
    nv::NaiveBufs b = nv::carve((float*)d_ws);
    for (int batch = 0; batch < nv::NBATCH; ++batch) nv::forward_batch(stream, in, b, batch, (float*)d_out);
}
```

```cpp
#include <hip/hip_runtime.h>
#include <hip/hip_cooperative_groups.h>
#include <math.h>
#include <stdint.h>
#include <cstdio>
namespace mk {
namespace cg = cooperative_groups;
#define LAS __attribute__((address_space(3)))
typedef unsigned short bf16;
typedef short bf16x8 __attribute__((ext_vector_type(8)));
typedef short s16x4 __attribute__((ext_vector_type(4)));
typedef float f32x4 __attribute__((ext_vector_type(4)));
typedef float f32x2 __attribute__((ext_vector_type(2)));
typedef float f32x16 __attribute__((ext_vector_type(16)));
typedef unsigned u32x4 __attribute__((ext_vector_type(4)));
typedef unsigned u32x2 __attribute__((ext_vector_type(2)));
typedef __bf16 bf16x2_t __attribute__((ext_vector_type(2)));
typedef __attribute__((address_space(1))) float GF;

constexpr int DM = 2048, NBATCH = 8, SEQ = 2048, NMETA = 16;
constexpr int HB = 4, MH = HB * SEQ, MHK = MH + 256;
constexpr int NIN = 15872;
constexpr int INW = 15680;
constexpr float EPS = 1e-6f, LOG2E = 1.4426950408889634f;
constexpr float QS_MLA = 0.07216878364870322f * LOG2E;
constexpr float QS_DIFF = 0.08838834764831845f * LOG2E;
constexpr int NWAVES = 8, NTHREADS = 512;
constexpr int T_CQ = 0, T_CKV = 3, T_KR = 5, T_ZA = 6, T_QD = 14, T_KD = 22, T_VD = 30, T_ZB = 38, T_GA = 46, T_GB = 54, T_END = 62;

constexpr size_t al(size_t x) { return (x + 4095) / 4096 * 4096; }
constexpr size_t WS_WIN = 0;
constexpr size_t WS_WUQ = WS_WIN + al((size_t)NIN * 2048 * 2);
constexpr size_t WS_WUKV = WS_WUQ + al((size_t)4096 * 768 * 2);
constexpr size_t WS_WA = WS_WUKV + al((size_t)4096 * 512 * 2);
constexpr size_t WS_WB = WS_WA + al((size_t)2048 * 2048 * 2);
constexpr size_t WS_WO = WS_WB + al((size_t)2048 * 2048 * 2);
constexpr size_t WS_UMETA = WS_WO + al((size_t)2048 * 2048 * 2);
constexpr size_t WS_TAB = WS_UMETA + al((size_t)256 * 2048 * 2);
constexpr size_t TAB_COS = 0, TAB_SIN = (size_t)2064 * 32 * 4, TAB_BIAS = 2 * TAB_SIN, TAB_LAM = TAB_BIAS + 8 * 260 * 4;
constexpr size_t WS_CQ = WS_TAB + al(TAB_LAM + 64);
constexpr size_t WS_CKV = WS_CQ + al((size_t)MHK * 768 * 2);
constexpr size_t WS_KR = WS_CKV + al((size_t)MHK * 512 * 2);
constexpr size_t WS_SSP = WS_KR + al((size_t)MHK * 64 * 2);
constexpr size_t SZ_ACT = al((size_t)MHK * 2048 * 2);
constexpr size_t WS_ZA = WS_SSP + al((size_t)MHK * 16 * 4);
constexpr size_t WS_QD = WS_ZA + SZ_ACT, WS_KD = WS_QD + SZ_ACT, WS_VD = WS_KD + SZ_ACT, WS_ZB = WS_VD + SZ_ACT, WS_SA = WS_ZB + SZ_ACT, WS_SB = WS_SA + SZ_ACT;
constexpr size_t WS_QM = WS_SB + SZ_ACT;
constexpr size_t WS_KM = WS_QM + al((size_t)MHK * 3072 * 2);
constexpr size_t WS_VM = WS_KM + al((size_t)MHK * 3072 * 2);
constexpr size_t WS_END = WS_VM + SZ_ACT;
constexpr size_t WS_MB = WS_VM;
constexpr size_t O1S_BYTES = (size_t)256 * 8 * 32 * 256 * 4;
static_assert(WS_WUKV - WS_WIN >= O1S_BYTES, "O1 stash of half 1 overlays WIN_T|WUQ_T");
static_assert(WS_END <= (size_t)512 * 1024 * 1024, "workspace");

constexpr int LDS_RING = 0, RING_BYTES = 131072;
constexpr int LDS_X = RING_BYTES;
constexpr int LDS_X2 = LDS_X + 8192;
constexpr int LDS_WSC = LDS_X2 + 1024;
constexpr int LDS_WSS = LDS_WSC + 2048;
constexpr int LDS_BT = LDS_WSS + 1024;
constexpr int LDS_BYTES = 147456;

struct Params {
    const float* in[18];
    float* out; unsigned char* ws;
};

#define CAS __attribute__((address_space(4)))
typedef const float* cfp_t; typedef float* fp_t; typedef unsigned char* ucp_t;
__device__ __forceinline__ const float* kin(int k) { const volatile CAS cfp_t* kp = (const volatile CAS cfp_t*)__builtin_amdgcn_kernarg_segment_ptr(); return kp[k]; }
__device__ __forceinline__ float* kout() { const volatile CAS fp_t* kp = (const volatile CAS fp_t*)__builtin_amdgcn_kernarg_segment_ptr(); return kp[18]; }
__device__ __forceinline__ unsigned char* kws() { const volatile CAS ucp_t* kp = (const volatile CAS ucp_t*)__builtin_amdgcn_kernarg_segment_ptr(); return kp[19]; }
__device__ __forceinline__ unsigned char* wsp(unsigned char* ws, size_t off) { unsigned k = (unsigned)(off >> 12); asm volatile("" : "+s"(k)); return ws + ((size_t)k << 12); }
__device__ __forceinline__ unsigned cvtpk(float lo, float hi) { f32x2 v = {lo, hi}; bf16x2_t b = __builtin_convertvector(v, bf16x2_t); return __builtin_bit_cast(unsigned, b); }
__device__ __forceinline__ float bflo(unsigned u) { return __builtin_bit_cast(float, u << 16); }
__device__ __forceinline__ float bfhi(unsigned u) { return __builtin_bit_cast(float, u & 0xffff0000u); }
__device__ __forceinline__ float silu_f(float v) { return v * __builtin_amdgcn_rcpf(1.f + __expf(-v)); }
__device__ __forceinline__ float sigm_f(float v) { return __builtin_amdgcn_rcpf(1.f + __expf(-v)); }
__device__ __forceinline__ float wave_sum(float v) {
#pragma unroll
    for (int o = 1; o < 64; o <<= 1) v += __shfl_xor(v, o);
    return v;
}
__device__ __forceinline__ int crow(int r, int hi) { return (r & 3) + 8 * (r >> 2) + 4 * hi; }
__device__ __forceinline__ int opaque(int x) { asm volatile("" : "+v"(x)); return x; }
#define LDS_WAIT() asm volatile("s_waitcnt lgkmcnt(0)" ::: "memory")
#define SBAR() __builtin_amdgcn_sched_barrier(0)

constexpr int BM = 256, BK = 64, HALF = 128, HTB = HALF * BK * 2, NXCD = 8, WGM = 8;
__device__ __forceinline__ int lds_byte(int r, int c) { const int st = (r >> 4) * 2 + (c >> 5), rr = r & 15, cc = c & 31, ob = rr * 64 + cc * 2; return st * 1024 + (ob ^ (((ob >> 9) & 1) << 5)); }
__device__ __forceinline__ void stage_rc(int b, int& R, int& C) { const int st = b / 1024, sb = b % 1024, swz = sb ^ (((sb >> 9) & 1) << 5); R = (st >> 1) * 16 + swz / 64; C = (st & 1) * 32 + (swz % 64) / 2; }
__device__ __forceinline__ int perm32(int rho) { const int n = rho >> 4, i = rho & 15; return 8 * (i >> 2) + 4 * n + (i & 3); }

struct Unit { const char* A; const char* B; int pm, pn, kind; };
struct TileOrder {
    int nM, nN, nwg, G, c;
    __device__ void init(int nM_, int nN_, int G_, int c_) { nM = nM_; nN = nN_; nwg = nM * nN; G = G_; c = c_; }
    __device__ bool tile(int i, int& pm, int& pn) const {
        const long L = (long)i * G + c; if (L >= nwg) return false;
        int wgid = (int)L; { const int q = nwg / NXCD, r = nwg % NXCD, xcd = wgid % NXCD, off = wgid / NXCD; wgid = (xcd < r ? xcd * (q + 1) : r * (q + 1) + (xcd - r) * q) + off; }
        const int nig = WGM * nN, gid = wgid / nig, fm = gid * WGM, gsz = (nM - fm) < WGM ? (nM - fm) : WGM;
        pm = fm + ((wgid % nig) % gsz); pn = (wgid % nig) / gsz; return true;
    }
};

typedef f32x4 Acc[2][2][4][2];

template <class Epi, class Sched>
__device__ __forceinline__ void gemm_phase(LAS unsigned char* lds, const int lda, const int ldb, const int nt, const Sched& S, const Epi& E) {
    const int tid = opaque(threadIdx.x), wid = __builtin_amdgcn_readfirstlane(tid >> 6), lane = tid & 63, wr = wid >> 2, wc = wid & 3, fr = lane & 15, fq = lane >> 4;
    unsigned voffA[2], voffB[2];
#pragma unroll
    for (int i = 0; i < 2; ++i) { int R, C; stage_rc(tid * 16 + i * 8192, R, C); const int Rb = (R & ~31) + perm32(R & 31);
        voffA[i] = (unsigned)(R * lda + C) * 2u; voffB[i] = (unsigned)(Rb * ldb + C) * 2u; }
    const size_t kstep = (size_t)(BK * 2);
    const size_t hstepA = (size_t)HALF * lda * 2, hstepB = (size_t)HALF * ldb * 2;
    const unsigned ldsw = (unsigned)wid * 1024u;
    const int aoff = lds_byte(wr * 64 + fr, fq * 8), boff = lds_byte(wc * 32 + fr, fq * 8);
#define PG8_SA(b, h) (((b) * 2 + (h)) * HTB)
#define PG8_SB(b, h) ((4 + (b) * 2 + (h)) * HTB)
#define PG8_STAGE(bufoff, gbase, voff) do { _Pragma("unroll") for (int _i = 0; _i < 2; ++_i) \
        __builtin_amdgcn_global_load_lds((const unsigned*)((const char*)(gbase) + (voff)[_i]), (LAS unsigned*)(lds + (bufoff) + ldsw + _i * 8192), 16, 0, 0); } while (0)
#define PG8_LDA(dst, b, h) do { _Pragma("unroll") for (int m = 0; m < 4; ++m) _Pragma("unroll") for (int k = 0; k < 2; ++k) dst[m][k] = *(const LAS bf16x8*)(lds + PG8_SA(b, h) + aoff + m * 2048 + k * 1024); } while (0)
#define PG8_LDB(dst, b, h) do { _Pragma("unroll") for (int n = 0; n < 2; ++n) _Pragma("unroll") for (int k = 0; k < 2; ++k) dst[n][k] = *(const LAS bf16x8*)(lds + PG8_SB(b, h) + boff + n * 2048 + k * 1024); } while (0)
#define PG8_MMA(ai, bj, At, Bt) do { __builtin_amdgcn_s_setprio(1); _Pragma("unroll") for (int m = 0; m < 4; ++m) _Pragma("unroll") for (int n = 0; n < 2; ++n) _Pragma("unroll") for (int k = 0; k < 2; ++k) \
        acc[ai][bj][m][n] = __builtin_amdgcn_mfma_f32_16x16x32_bf16(Bt[n][k], At[m][k], acc[ai][bj][m][n], 0, 0, 0); __builtin_amdgcn_s_setprio(0); } while (0)
#define PG8_WAIT_V(n) asm volatile("s_waitcnt vmcnt(" #n ")" ::: "memory")
#define PG8_WAIT_L(n) asm volatile("s_waitcnt lgkmcnt(" #n ")" ::: "memory")
#define PG8_BAR __builtin_amdgcn_s_barrier()
#define PG8_SCHED __builtin_amdgcn_sched_barrier(0)
    Unit cur, nxt; int ui = 0;
    if (!S.next(0, cur)) return;
    Acc acc;
#pragma unroll
    for (int a = 0; a < 2; ++a)
#pragma unroll
        for (int b = 0; b < 2; ++b)
#pragma unroll
            for (int m = 0; m < 4; ++m)
#pragma unroll
                for (int n = 0; n < 2; ++n) acc[a][b][m][n] = (f32x4){0.f, 0.f, 0.f, 0.f};
    bf16x8 At[4][2], B0[2][2], B1[2][2];
    const char* cA = cur.A; const char* cB = cur.B;
    PG8_STAGE(PG8_SB(0, 0), cB, voffB); PG8_STAGE(PG8_SB(0, 1), cB + hstepB, voffB); PG8_STAGE(PG8_SA(0, 0), cA, voffA); PG8_STAGE(PG8_SA(0, 1), cA + hstepA, voffA);
    if (wr == 1) PG8_BAR;
    PG8_WAIT_V(2); PG8_BAR;
    PG8_STAGE(PG8_SB(1, 0), cB + kstep, voffB); PG8_STAGE(PG8_SA(1, 0), cA + kstep, voffA); PG8_STAGE(PG8_SB(1, 1), cB + hstepB + kstep, voffB);
    PG8_WAIT_V(6); PG8_BAR;
    for (;;) {
        const bool has_next = S.next(ui + 1, nxt);
        const char* nA = has_next ? nxt.A : cA; const char* nB = has_next ? nxt.B : cB;
        for (int t = 0; t < nt; t += 2) {
            const bool last = (t == nt - 2);
            const char* a1 = cA + (size_t)(t + 1) * kstep;
            const char* a2 = last ? nA : cA + (size_t)(t + 2) * kstep; const char* b2 = last ? nB : cB + (size_t)(t + 2) * kstep;
            const char* a3 = a2 + kstep; const char* b3 = b2 + kstep;
            PG8_LDB(B0, 0, 0); PG8_LDB(B1, 0, 1); PG8_SCHED; PG8_LDA(At, 0, 0); PG8_STAGE(PG8_SA(1, 1), a1 + hstepA, voffA);
            PG8_WAIT_V(8); PG8_WAIT_L(0); PG8_BAR; PG8_MMA(0, 0, At, B0); PG8_MMA(0, 1, At, B1); PG8_BAR; PG8_SCHED;
            PG8_LDA(At, 0, 1); PG8_STAGE(PG8_SB(0, 0), b2, voffB); PG8_STAGE(PG8_SB(0, 1), b2 + hstepB, voffB); PG8_STAGE(PG8_SA(0, 0), a2, voffA);
            PG8_WAIT_V(8); PG8_WAIT_L(0); PG8_BAR; PG8_MMA(1, 0, At, B0); PG8_MMA(1, 1, At, B1); PG8_BAR; PG8_SCHED;
            PG8_LDB(B0, 1, 0); PG8_LDB(B1, 1, 1); PG8_SCHED; PG8_LDA(At, 1, 0); PG8_STAGE(PG8_SA(0, 1), a2 + hstepA, voffA);
            PG8_WAIT_V(8); PG8_WAIT_L(0); PG8_BAR; PG8_MMA(0, 0, At, B0); PG8_MMA(0, 1, At, B1); PG8_BAR; PG8_SCHED;
            PG8_LDA(At, 1, 1); PG8_STAGE(PG8_SB(1, 0), b3, voffB); PG8_STAGE(PG8_SB(1, 1), b3 + hstepB, voffB); PG8_STAGE(PG8_SA(1, 0), a3, voffA);
            PG8_WAIT_V(8); PG8_WAIT_L(0); PG8_BAR; PG8_MMA(1, 0, At, B0); PG8_MMA(1, 1, At, B1); PG8_BAR; PG8_SCHED;
        }
        if (wr == 0) PG8_BAR;
        const bool keep = E(acc, cur, wr, wc, fr, fq, lds);
        if (!has_next) break;
        if (!keep) {
#pragma unroll
            for (int a = 0; a < 2; ++a)
#pragma unroll
                for (int b = 0; b < 2; ++b)
#pragma unroll
                    for (int m = 0; m < 4; ++m)
#pragma unroll
                        for (int n = 0; n < 2; ++n) acc[a][b][m][n] = (f32x4){0.f, 0.f, 0.f, 0.f};
        }
        cur = nxt; cA = nA; cB = nB; ++ui;
        if (wr == 1) PG8_BAR;
    }
    PG8_WAIT_V(0);
    PG8_BAR;
#undef PG8_SA
#undef PG8_SB
#undef PG8_STAGE
#undef PG8_LDA
#undef PG8_LDB
#undef PG8_MMA
#undef PG8_WAIT_V
#undef PG8_WAIT_L
#undef PG8_BAR
#undef PG8_SCHED
}

__device__ __forceinline__ void tile_half_ss(const Acc& acc, LAS unsigned char* lds, int wr, int wc, int fr, int fq, float (&ss)[2][4][2]) {
    LAS float* X = (LAS float*)(lds + LDS_X);
#pragma unroll
    for (int ai = 0; ai < 2; ++ai)
#pragma unroll
        for (int m = 0; m < 4; ++m)
#pragma unroll
            for (int bj = 0; bj < 2; ++bj) {
                const f32x4 a = acc[ai][bj][m][0], b = acc[ai][bj][m][1];
                float s = (a[0] * a[0] + a[1] * a[1]) + (a[2] * a[2] + a[3] * a[3]) + (b[0] * b[0] + b[1] * b[1]) + (b[2] * b[2] + b[3] * b[3]);
                s += __shfl_xor(s, 16); s += __shfl_xor(s, 32);
                if (fq == 0) X[((ai * 128 + wr * 64 + m * 16 + fr) * 2 + bj) * 4 + wc] = s;
            }
    LDS_WAIT(); __builtin_amdgcn_s_barrier(); asm volatile("" ::: "memory");
#pragma unroll
    for (int ai = 0; ai < 2; ++ai)
#pragma unroll
        for (int m = 0; m < 4; ++m)
#pragma unroll
            for (int bj = 0; bj < 2; ++bj) {
                const f32x4 v = *(const LAS f32x4*)(X + ((ai * 128 + wr * 64 + m * 16 + fr) * 2 + bj) * 4);
                ss[ai][m][bj] = (v[0] + v[1]) + (v[2] + v[3]);
            }
}
__device__ __forceinline__ u32x4 pack8(const f32x4 a, const f32x4 b) { u32x4 w; w.x = cvtpk(a[0], a[1]); w.y = cvtpk(a[2], a[3]); w.z = cvtpk(b[0], b[1]); w.w = cvtpk(b[2], b[3]); return w; }

struct EpiP1 {
    unsigned char* ws; const float* gqd; const float* gkd;
    __device__ __forceinline__ bool operator()(Acc& acc, const Unit& u, int wr, int wc, int fr, int fq, LAS unsigned char* lds) const {
        fr = opaque(fr); fq = opaque(fq);
        const int pn = u.pn; const int row0 = u.pm * 256 + wr * 64 + fr;
        const int colw = wc * 32 + 8 * fq;
        if (pn < T_KR) {
            float ss[2][4][2]; tile_half_ss(acc, lds, wr, wc, fr, fq, ss);
            const bool iscq = pn < T_CKV;
            bf16* dst = iscq ? (bf16*)(wsp(ws, WS_CQ)) : (bf16*)(wsp(ws, WS_CKV)); const int ld = iscq ? 768 : 512; const int c0 = iscq ? pn * 256 : (pn - T_CKV) * 256;
            const int chunk0 = iscq ? pn * 2 : 6 + (pn - T_CKV) * 2;
            float* ssp = (float*)(wsp(ws, WS_SSP));
#pragma unroll
            for (int ai = 0; ai < 2; ++ai)
#pragma unroll
                for (int m = 0; m < 4; ++m) { const int row = row0 + ai * 128 + m * 16;
#pragma unroll
                    for (int bj = 0; bj < 2; ++bj) {
                        *(u32x4*)(dst + (size_t)row * ld + c0 + bj * 128 + colw) = pack8(acc[ai][bj][m][0], acc[ai][bj][m][1]);
                        if (wc == 0 && fq == 0) ssp[(size_t)row * 16 + chunk0 + bj] = ss[ai][m][bj];
                    } }
            return false;
        }
        if (pn == T_KR) {
            if (wc < 2) { bf16* dst = (bf16*)(wsp(ws, WS_KR));
#pragma unroll
                for (int ai = 0; ai < 2; ++ai)
#pragma unroll
                    for (int m = 0; m < 4; ++m) { const int row = row0 + ai * 128 + m * 16; *(u32x4*)(dst + (size_t)row * 64 + colw) = pack8(acc[ai][0][m][0], acc[ai][0][m][1]); } }
            return false;
        }
        if (pn >= T_QD && pn < T_VD) {
            float ss[2][4][2]; tile_half_ss(acc, lds, wr, wc, fr, fq, ss);
            const bool isq = pn < T_KD; const float* g = isq ? gqd : gkd; const float post = isq ? QS_DIFF : 1.f;
            bf16* dst = isq ? (bf16*)(wsp(ws, WS_QD)) : (bf16*)(wsp(ws, WS_KD)); const int c0 = (isq ? pn - T_QD : pn - T_KD) * 256;
            const f32x4 g0 = *(const f32x4*)(g + colw), g1 = *(const f32x4*)(g + colw + 4);
#pragma unroll
            for (int ai = 0; ai < 2; ++ai)
#pragma unroll
                for (int m = 0; m < 4; ++m) { const int row = row0 + ai * 128 + m * 16;
#pragma unroll
                    for (int bj = 0; bj < 2; ++bj) { const float rs = __builtin_amdgcn_rsqf(ss[ai][m][bj] * (1.f / 128.f) + EPS) * post;
                        *(u32x4*)(dst + (size_t)row * 2048 + c0 + bj * 128 + colw) = pack8(acc[ai][bj][m][0] * g0 * rs, acc[ai][bj][m][1] * g1 * rs); } }
            return false;
        }
        int mode; bf16* dst; int c0;
        if (pn < T_QD) { mode = 1; dst = (bf16*)(wsp(ws, WS_ZA)); c0 = (pn - T_ZA) * 256; }
        else if (pn < T_ZB) { mode = 0; dst = (bf16*)(wsp(ws, WS_VD)); c0 = (pn - T_VD) * 256; }
        else if (pn < T_GA) { mode = 1; dst = (bf16*)(wsp(ws, WS_ZB)); c0 = (pn - T_ZB) * 256; }
        else if (pn < T_GB) { mode = 2; dst = (bf16*)(wsp(ws, WS_SA)); c0 = (pn - T_GA) * 256; }
        else { mode = 2; dst = (bf16*)(wsp(ws, WS_SB)); c0 = (pn - T_GB) * 256; }
#pragma unroll
        for (int ai = 0; ai < 2; ++ai)
#pragma unroll
            for (int m = 0; m < 4; ++m) { const int row = row0 + ai * 128 + m * 16;
#pragma unroll
                for (int bj = 0; bj < 2; ++bj) { f32x4 a = acc[ai][bj][m][0], b = acc[ai][bj][m][1];
                    if (mode == 1) {
#pragma unroll
                        for (int e = 0; e < 4; ++e) { a[e] = silu_f(a[e]); b[e] = silu_f(b[e]); } }
                    else if (mode == 2) {
#pragma unroll
                        for (int e = 0; e < 4; ++e) { a[e] = sigm_f(a[e]); b[e] = sigm_f(b[e]); } }
                    *(u32x4*)(dst + (size_t)row * 2048 + c0 + bj * 128 + colw) = pack8(a, b); } }
        return false;
    }
};
struct SchedP1 {
    TileOrder T; const char* U; const char* Umeta; const char* W;
    __device__ __forceinline__ bool next(int i, Unit& u) const {
        int pm, pn; if (!T.tile(i, pm, pn)) return false;
        u.pm = pm; u.pn = pn; u.kind = 0;
        u.A = (pm < 32) ? U + (size_t)pm * 256 * 2048 * 2 : Umeta; u.B = W + (size_t)pn * 256 * 2048 * 2; return true;
    }
};

__device__ __forceinline__ float ssp_rs(const float* ssp, int row, int c0, int n, float invw) {
    float s = 0.f; for (int c = 0; c < n; ++c) s += ssp[(size_t)row * 16 + c0 + c]; return __builtin_amdgcn_rsqf(s * invw + EPS);
}
struct EpiP2Q {
    unsigned char* ws; const float* gq;
    __device__ __forceinline__ bool operator()(Acc& acc, const Unit& u, int wr, int wc, int fr, int fq, LAS unsigned char* lds) const {
        fr = opaque(fr); fq = opaque(fq);
        const int h = u.pn; const int row0 = u.pm * 256 + wr * 64 + fr; const int colw = wc * 32 + 8 * fq;
        const float* ssp = (const float*)(wsp(ws, WS_SSP));
#pragma unroll
        for (int ai = 0; ai < 2; ++ai)
#pragma unroll
            for (int m = 0; m < 4; ++m) { const float rs = ssp_rs(ssp, row0 + ai * 128 + m * 16, 0, 6, 1.f / 768.f);
#pragma unroll
                for (int bj = 0; bj < 2; ++bj) { acc[ai][bj][m][0] *= rs; acc[ai][bj][m][1] *= rs; }
                if (m & 1) asm volatile("" ::: "memory"); }
        float ss[2][4][2]; tile_half_ss(acc, lds, wr, wc, fr, fq, ss);
        bf16* dst = (bf16*)(wsp(ws, WS_QM));
        { const f32x4 g0 = *(const f32x4*)(gq + colw), g1 = *(const f32x4*)(gq + colw + 4);
#pragma unroll
          for (int ai = 0; ai < 2; ++ai)
#pragma unroll
            for (int m = 0; m < 4; ++m) { const int row = row0 + ai * 128 + m * 16;
                const float rs = __builtin_amdgcn_rsqf((ss[ai][m][0] + ss[ai][m][1]) * (1.f / 192.f) + EPS) * QS_MLA;
                *(u32x4*)(dst + (size_t)row * 3072 + h * 192 + colw) = pack8(acc[ai][0][m][0] * g0 * rs, acc[ai][0][m][1] * g1 * rs); } }
        if (wc < 2) {
            const int ib = opaque(16 * wc + 4 * fq);
            const f32x4 gr1 = *(const f32x4*)(gq + 128 + ib), gr2 = *(const f32x4*)(gq + 160 + ib);
            const float* ctab = (const float*)(wsp(ws, WS_TAB) + TAB_COS); const float* stab = (const float*)(wsp(ws, WS_TAB) + TAB_SIN);
#pragma unroll
            for (int ai = 0; ai < 2; ++ai)
#pragma unroll
                for (int m = 0; m < 4; ++m) { const int row = row0 + ai * 128 + m * 16;
                    const float rs = __builtin_amdgcn_rsqf((ss[ai][m][0] + ss[ai][m][1]) * (1.f / 192.f) + EPS) * QS_MLA;
                    const int pos = NMETA + (row & (SEQ - 1));
                    const f32x4 c = *(const f32x4*)(ctab + pos * 32 + ib), sn = *(const f32x4*)(stab + pos * 32 + ib);
                    const f32x4 x1 = acc[ai][1][m][0] * gr1 * rs, x2 = acc[ai][1][m][1] * gr2 * rs;
                    *(u32x4*)(dst + (size_t)row * 3072 + h * 192 + 128 + colw) = pack8(x1 * c - x2 * sn, x2 * c + x1 * sn);
                    asm volatile("" ::: "memory"); }
        }
        return false;
    }
};
struct SchedP2Q {
    TileOrder T; const char* CQ; const char* W;
    __device__ __forceinline__ bool next(int i, Unit& u) const {
        int pm, pn; if (!T.tile(i, pm, pn)) return false;
        u.pm = pm; u.pn = pn; u.kind = 0; u.A = CQ + (size_t)pm * 256 * 768 * 2; u.B = W + (size_t)pn * 256 * 768 * 2; return true;
    }
};
struct EpiP2KV {
    unsigned char* ws; const float* gk;
    __device__ __forceinline__ bool operator()(Acc& acc, const Unit& u, int wr, int wc, int fr, int fq, LAS unsigned char* lds) const {
        fr = opaque(fr); fq = opaque(fq);
        const int h = u.pn; const int row0 = u.pm * 256 + wr * 64 + fr; const int colw = wc * 32 + 8 * fq;
        const float* ssp = (const float*)(wsp(ws, WS_SSP));
#pragma unroll
        for (int ai = 0; ai < 2; ++ai)
#pragma unroll
            for (int m = 0; m < 4; ++m) { const float rs = ssp_rs(ssp, row0 + ai * 128 + m * 16, 6, 4, 1.f / 512.f);
#pragma unroll
                for (int bj = 0; bj < 2; ++bj) { acc[ai][bj][m][0] *= rs; acc[ai][bj][m][1] *= rs; }
                if (m & 1) asm volatile("" ::: "memory"); }
        const int tid = opaque(threadIdx.x), rr = tid >> 1, hf = tid & 1; const int rrow = u.pm * 256 + rr;
        const bf16* kr = (const bf16*)(wsp(ws, WS_KR)) + (size_t)rrow * 64 + hf * 32;
        u32x4 kv[4]; float sr = 0.f;
#pragma unroll
        for (int j = 0; j < 4; ++j) { kv[j] = *(const u32x4*)(kr + j * 8);
#pragma unroll
            for (int e = 0; e < 4; ++e) { const float a = bflo(kv[j][e]), b = bfhi(kv[j][e]); sr += a * a + b * b; } }
        sr += __shfl_xor(sr, 1);
        LAS float* X2 = (LAS float*)(lds + LDS_X2);
        if (hf == 0) X2[rr] = sr;
        float ss[2][4][2]; tile_half_ss(acc, lds, wr, wc, fr, fq, ss);
        const f32x4 g0 = *(const f32x4*)(gk + colw), g1 = *(const f32x4*)(gk + colw + 4);
        bf16* kdst = (bf16*)(wsp(ws, WS_KM)); bf16* vdst = (bf16*)(wsp(ws, WS_VM));
#pragma unroll
        for (int ai = 0; ai < 2; ++ai)
#pragma unroll
            for (int m = 0; m < 4; ++m) { const int trow = ai * 128 + wr * 64 + m * 16 + fr; const int row = u.pm * 256 + trow;
                const float rs = __builtin_amdgcn_rsqf((ss[ai][m][0] + X2[trow]) * (1.f / 192.f) + EPS);
                *(u32x4*)(kdst + (size_t)row * 3072 + h * 192 + colw) = pack8(acc[ai][0][m][0] * g0 * rs, acc[ai][0][m][1] * g1 * rs);
                *(u32x4*)(vdst + (size_t)row * 2048 + h * 128 + colw) = pack8(acc[ai][1][m][0], acc[ai][1][m][1]); }
        { const LAS float* X = (const LAS float*)(lds + LDS_X); const f32x4 pv = *(const LAS f32x4*)(X + (rr * 2 + 0) * 4);
          const float rs = __builtin_amdgcn_rsqf(((pv[0] + pv[1]) + (pv[2] + pv[3]) + sr) * (1.f / 192.f) + EPS);
          const int pos = (u.pm < 32) ? NMETA + (rrow & (SEQ - 1)) : (rr < NMETA ? rr : 0);
          const float* ctab = (const float*)(wsp(ws, WS_TAB) + TAB_COS) + pos * 32; const float* stab = (const float*)(wsp(ws, WS_TAB) + TAB_SIN) + pos * 32;
#pragma unroll
          for (int j = 0; j < 4; ++j) { const int g = hf * 4 + j; const int i0 = 4 * g;
              const f32x4 c = *(const f32x4*)(ctab + i0), s = *(const f32x4*)(stab + i0), gg1 = *(const f32x4*)(gk + 128 + i0), gg2 = *(const f32x4*)(gk + 160 + i0);
              f32x4 x1 = {bflo(kv[j][0]), bfhi(kv[j][0]), bflo(kv[j][1]), bfhi(kv[j][1])}, x2 = {bflo(kv[j][2]), bfhi(kv[j][2]), bflo(kv[j][3]), bfhi(kv[j][3])};
              x1 = x1 * gg1 * rs; x2 = x2 * gg2 * rs;
              *(u32x4*)(kdst + (size_t)rrow * 3072 + h * 192 + 128 + g * 8) = pack8(x1 * c - x2 * s, x2 * c + x1 * s); } }
        return false;
    }
};
struct SchedP2KV {
    TileOrder T; const char* CKV; const char* W;
    __device__ __forceinline__ bool next(int i, Unit& u) const {
        int pm, pn; if (!T.tile(i, pm, pn)) return false;
        u.pm = pm; u.pn = pn; u.kind = 0; u.A = CKV + (size_t)pm * 256 * 512 * 2; u.B = W + (size_t)pn * 256 * 512 * 2; return true;
    }
};

struct EpiP4 {
    unsigned char* ws;
    __device__ __forceinline__ bool operator()(Acc& acc, const Unit& u, int wr, int wc, int fr, int fq, LAS unsigned char* lds) const {
        fr = opaque(fr); fq = opaque(fq);
        const int row0 = u.pm * 256 + wr * 64 + fr; const int col0 = u.pn * 256 + wc * 32 + 8 * fq;
        const bf16* sa = (const bf16*)(wsp(ws, WS_SA)); const bf16* sb = (const bf16*)(wsp(ws, WS_SB)); bf16* mb = (bf16*)(wsp(ws, WS_MB));
#pragma unroll
        for (int ai = 0; ai < 2; ++ai)
#pragma unroll
            for (int m = 0; m < 4; ++m) { const int row = row0 + ai * 128 + m * 16;
#pragma unroll
                for (int bj = 0; bj < 2; ++bj) { const size_t off = (size_t)row * 2048 + col0 + bj * 128;
                    const u32x4 b = *(const u32x4*)(sb + off);
                    const f32x4 b0 = {bflo(b[0]), bfhi(b[0]), bflo(b[1]), bfhi(b[1])}, b1 = {bflo(b[2]), bfhi(b[2]), bflo(b[3]), bfhi(b[3])};
                    if (u.kind == 0) { const u32x4 a = *(const u32x4*)(sa + off);
                        const f32x4 a0 = {bflo(a[0]), bfhi(a[0]), bflo(a[1]), bfhi(a[1])}, a1 = {bflo(a[2]), bfhi(a[2]), bflo(a[3]), bfhi(a[3])};
#pragma unroll
                        for (int e = 0; e < 4; ++e) { acc[ai][bj][m][0][e] *= a0[e] * __builtin_amdgcn_rcpf(b0[e]); acc[ai][bj][m][1][e] *= a1[e] * __builtin_amdgcn_rcpf(b1[e]); } }
                    else *(u32x4*)(mb + off) = pack8(acc[ai][bj][m][0] * b0, acc[ai][bj][m][1] * b1); } }
        return u.kind == 0;
    }
};
struct SchedP4 {
    TileOrder T; const char* OA; const char* OB; const char* WA; const char* WB;
    __device__ __forceinline__ bool next(int i, Unit& u) const {
        int pm, pn; if (!T.tile(i >> 1, pm, pn)) return false;
        u.pm = pm; u.pn = pn; u.kind = i & 1;
        u.A = ((i & 1) ? OB : OA) + (size_t)pm * 256 * 2048 * 2; u.B = ((i & 1) ? WB : WA) + (size_t)pn * 256 * 2048 * 2; return true;
    }
};
struct EpiP5 {
    const float* x; float* out;
    __device__ __forceinline__ bool operator()(Acc& acc, const Unit& u, int wr, int wc, int fr, int fq, LAS unsigned char* lds) const {
        fr = opaque(fr); fq = opaque(fq);
        const int row0 = u.pm * 256 + wr * 64 + fr; const int col0 = u.pn * 256 + wc * 32 + 8 * fq;
#pragma unroll
        for (int ai = 0; ai < 2; ++ai)
#pragma unroll
            for (int m = 0; m < 4; ++m) { const int row = row0 + ai * 128 + m * 16;
#pragma unroll
                for (int bj = 0; bj < 2; ++bj) { const size_t off = (size_t)row * 2048 + col0 + bj * 128;
                    const f32x4 x0 = *(const f32x4*)(x + off), x1 = *(const f32x4*)(x + off + 4);
                    *(f32x4*)(out + off) = x0 + acc[ai][bj][m][0]; *(f32x4*)(out + off + 4) = x1 + acc[ai][bj][m][1]; } }
        return false;
    }
};
struct SchedP5 {
    TileOrder T; const char* MB; const char* WO;
    __device__ __forceinline__ bool next(int i, Unit& u) const {
        int pm, pn; if (!T.tile(i, pm, pn)) return false;
        u.pm = pm; u.pn = pn; u.kind = 0; u.A = MB + (size_t)pm * 256 * 2048 * 2; u.B = WO + (size_t)pn * 256 * 2048 * 2; return true;
    }
};

constexpr float NEGBIG = -1e30f;
constexpr float THR_L2 = 8.f * LOG2E;
template <int NCB> __device__ __forceinline__ int v_st(int k, int c) { const int kk = (k & ~0xC) | ((k & 4) << 1) | ((k & 8) >> 1); return ((kk >> 3) * NCB + (c >> 5)) * 512 + ((kk & 7) * 32 + (c & 31)) * 2; }
__device__ __forceinline__ int v_rd_base(int lane) { return ((lane & 3) << 3) | (((lane >> 2) & 3) << 6) | (((lane >> 4) & 1) << 5) | (((lane >> 5) & 1) << 8); }
template <int OFF> __device__ __forceinline__ s16x4 tr_read(int vb) { s16x4 r; asm volatile("ds_read_b64_tr_b16 %0, %1 offset:%2" : "=&v"(r) : "v"(vb), "i"(OFF) : "memory"); return r; }
template <int D0, int NCB> __device__ __forceinline__ void pv_one(f32x16& od, int vb, bf16x8 pa0, bf16x8 pa1, bf16x8 pa2, bf16x8 pa3) {
    constexpr int KS = NCB * 1024, HF = NCB * 512;
    const s16x4 l0 = tr_read<D0 * 512 + 0 * KS>(vb), h0 = tr_read<D0 * 512 + 0 * KS + HF>(vb), l1 = tr_read<D0 * 512 + 1 * KS>(vb), h1 = tr_read<D0 * 512 + 1 * KS + HF>(vb);
    const s16x4 l2 = tr_read<D0 * 512 + 2 * KS>(vb), h2 = tr_read<D0 * 512 + 2 * KS + HF>(vb), l3 = tr_read<D0 * 512 + 3 * KS>(vb), h3 = tr_read<D0 * 512 + 3 * KS + HF>(vb);
    asm volatile("s_waitcnt lgkmcnt(0)" ::: "memory"); SBAR();
#define PK(L, H) (bf16x8){L[0], L[1], L[2], L[3], H[0], H[1], H[2], H[3]}
    od = __builtin_amdgcn_mfma_f32_32x32x16_bf16(pa0, PK(l0, h0), od, 0, 0, 0);
    od = __builtin_amdgcn_mfma_f32_32x32x16_bf16(pa1, PK(l1, h1), od, 0, 0, 0);
    od = __builtin_amdgcn_mfma_f32_32x32x16_bf16(pa2, PK(l2, h2), od, 0, 0, 0);
    od = __builtin_amdgcn_mfma_f32_32x32x16_bf16(pa3, PK(l3, h3), od, 0, 0, 0);
#undef PK
}
template <int DV> struct PV;
template <> struct PV<128> { static __device__ __forceinline__ void run(f32x16* o, int vb, bf16x8 a, bf16x8 b, bf16x8 c, bf16x8 d) {
    pv_one<0, 4>(o[0], vb, a, b, c, d); pv_one<1, 4>(o[1], vb, a, b, c, d); pv_one<2, 4>(o[2], vb, a, b, c, d); pv_one<3, 4>(o[3], vb, a, b, c, d); } };

template <int DQK, int DV, bool BIAS>
__device__ __forceinline__ void attn_pass(f32x16 (&o)[DV / 32], float& l_out, const bf16* __restrict__ Q, int ldq, const bf16* __restrict__ Kr, const bf16* __restrict__ Km, int ldk,
                                          const bf16* __restrict__ Vr, const bf16* __restrict__ Vm, int ldv, int q0, LAS unsigned char* ldsb) {
    constexpr int CPRK = DQK / 8, NKP = 64 * DQK * 2 / 8192, NVP = 64 * DV * 2 / 8192, KB = 64 * DQK * 2, VB = 64 * DV * 2, ND0 = DV / 32, NQ = DQK / 16, NCB = DV / 32;
    constexpr int GS = 2, NG = NQ / GS;
    const int tid = opaque(threadIdx.x), lane = tid & 63, r32 = lane & 31, hi = lane >> 5; const int wid = __builtin_amdgcn_readfirstlane(tid >> 6);
    char* lds = (char*)ldsb;
    char* K_lds = lds; char* V_lds = lds + 2 * KB;
    float* wsc = (float*)(lds + LDS_WSC) + wid * 64; float* al_l = wsc + 32;
    const float* btab = (const float*)(lds + LDS_BT);
    const int qw0 = q0 + wid * 32;
    bf16x8 qr[NQ];
    { const bf16* Qw = Q + (size_t)(wid * 32 + r32) * ldq + hi * 8;
#pragma unroll
      for (int d0 = 0; d0 < NQ; ++d0) qr[d0] = *(const bf16x8*)(Qw + d0 * 16); }
    const int vb0 = (int)(uintptr_t)V_lds + v_rd_base(lane);
    unsigned ksrc[NKP], vsrc[NVP];
#pragma unroll
    for (int j = 0; j < NKP; ++j) { const int off = 8192 * j + 16 * tid, row = off / (DQK * 2), cpos = (off % (DQK * 2)) >> 4; ksrc[j] = (unsigned)(row * ldk + ((cpos ^ (row & 7)) << 3)); }
#pragma unroll
    for (int j = 0; j < NVP; ++j) { const int off = 8192 * j + 16 * tid, st = off >> 9, kk = (st / NCB) * 8 + ((off & 511) >> 6), c = (st % NCB) * 32 + ((off & 63) >> 1);
        const int k = (kk & ~0xC) | ((kk & 4) << 1) | ((kk & 8) >> 1); vsrc[j] = (unsigned)(k * ldv + c); }
    const unsigned ldsw = (unsigned)wid * 1024u;
#define DMA(t, b) do { const bf16* kp = (t) == 0 ? Km : Kr + (size_t)((t) - 1) * 64 * ldk; const bf16* vp = (t) == 0 ? Vm : Vr + (size_t)((t) - 1) * 64 * ldv; \
        _Pragma("unroll") for (int j = 0; j < NKP; ++j) __builtin_amdgcn_global_load_lds((const unsigned*)(kp + ksrc[j]), (LAS unsigned*)(ldsb + (b) * KB + 8192 * j + ldsw), 16, 0, 0); \
        _Pragma("unroll") for (int j = 0; j < NVP; ++j) __builtin_amdgcn_global_load_lds((const unsigned*)(vp + vsrc[j]), (LAS unsigned*)(ldsb + 2 * KB + (b) * VB + 8192 * j + ldsw), 16, 0, 0); } while (0)
    float m_reg = NEGBIG, l_reg = 0.f;
#pragma unroll
    for (int d = 0; d < ND0; ++d) o[d] = (f32x16){0.f, 0.f, 0.f, 0.f, 0.f, 0.f, 0.f, 0.f, 0.f, 0.f, 0.f, 0.f, 0.f, 0.f, 0.f, 0.f};
#define PK4(P, BASE, OUT) do { unsigned a0 = cvtpk(P[BASE + 0], P[BASE + 1]), a1 = cvtpk(P[BASE + 2], P[BASE + 3]), b0_ = cvtpk(P[BASE + 4], P[BASE + 5]), b1_ = cvtpk(P[BASE + 6], P[BASE + 7]); \
        auto r0 = __builtin_amdgcn_permlane32_swap(a0, b0_, false, false); auto r1 = __builtin_amdgcn_permlane32_swap(a1, b1_, false, false); \
        u32x4 w = {r0[0], r1[0], r0[1], r1[1]}; OUT = __builtin_bit_cast(bf16x8, w); } while (0)
#define LOADK(KF, G_) do { _Pragma("unroll") for (int s_ = 0; s_ < GS; ++s_) { const int cb = (((G_) * GS + s_) * 16 + hi * 8) * 2; \
        KF[2 * s_] = *(const bf16x8*)(Kb + r32 * (DQK * 2) + (cb ^ ((r32 & 7) << 4))); KF[2 * s_ + 1] = *(const bf16x8*)(Kb + (32 + r32) * (DQK * 2) + (cb ^ ((r32 & 7) << 4))); } } while (0)
#define MMAK(KF, G_) do { _Pragma("unroll") for (int s_ = 0; s_ < GS; ++s_) { \
        p0 = __builtin_amdgcn_mfma_f32_32x32x16_bf16(KF[2 * s_], qr[(G_) * GS + s_], p0, 0, 0, 0); p1 = __builtin_amdgcn_mfma_f32_32x32x16_bf16(KF[2 * s_ + 1], qr[(G_) * GS + s_], p1, 0, 0, 0); } } while (0)
#define STEP(META_, TR_, B_) do { \
        f32x16 p0, p1; \
        if (META_) { \
            _Pragma("unroll") for (int r = 0; r < 16; ++r) { p1[r] = NEGBIG; \
                if (r < 8) { if (BIAS) { int idx = crow(r, hi) - NMETA - (qw0 + r32) + 128; idx = idx < 0 ? 0 : idx; p0[r] = btab[idx]; } else p0[r] = 0.f; } \
                else p0[r] = NEGBIG; } \
        } else if (BIAS) { \
            const int d = 64 * (TR_) - qw0; \
            if (d <= -154 || d >= 122) { const float bv = btab[d < 0 ? 0 : 256]; \
                _Pragma("unroll") for (int r = 0; r < 16; ++r) { p0[r] = bv; p1[r] = bv; } } \
            else { \
                _Pragma("unroll") for (int r = 0; r < 16; ++r) { int i0 = d + crow(r, hi) - r32 + 128, i1 = i0 + 32; \
                    i0 = i0 < 0 ? 0 : (i0 > 256 ? 256 : i0); i1 = i1 < 0 ? 0 : (i1 > 256 ? 256 : i1); p0[r] = btab[i0]; p1[r] = btab[i1]; } } \
        } else { \
            _Pragma("unroll") for (int r = 0; r < 16; ++r) { p0[r] = 0.f; p1[r] = 0.f; } \
        } \
        { const char* Kb = K_lds + (B_) * KB; bf16x8 kfa[2 * GS], kfb[2 * GS]; \
          LOADK(kfa, 0); \
          _Pragma("unroll") for (int g = 0; g < NG; g += 2) { \
              SBAR(); if (g + 1 < NG) LOADK(kfb, g + 1); MMAK(kfa, g); \
              SBAR(); if (g + 2 < NG) LOADK(kfa, g + 2); if (g + 1 < NG) MMAK(kfb, g + 1); } } \
        float pmax = p0[0]; \
        _Pragma("unroll") for (int r = 1; r < 16; ++r) pmax = fmaxf(pmax, p0[r]); \
        _Pragma("unroll") for (int r = 0; r < 16; ++r) pmax = fmaxf(pmax, p1[r]); \
        { auto rr = __builtin_amdgcn_permlane32_swap(__float_as_uint(pmax), __float_as_uint(pmax), false, false); pmax = fmaxf(__uint_as_float(rr[0]), __uint_as_float(rr[1])); } \
        float alpha = 1.f; \
        if (!__all(pmax - m_reg <= THR_L2)) { const float mn = fmaxf(m_reg, pmax); alpha = __builtin_amdgcn_exp2f(m_reg - mn); m_reg = mn; \
            if (hi == 0) al_l[r32] = alpha; asm volatile("s_waitcnt lgkmcnt(0)" ::: "memory"); \
            _Pragma("unroll") for (int d = 0; d < ND0; ++d) \
                _Pragma("unroll") for (int r = 0; r < 16; ++r) o[d][r] *= al_l[crow(r, hi)]; } \
        float ps = 0.f; \
        _Pragma("unroll") for (int r = 0; r < 16; ++r) { p0[r] = __builtin_amdgcn_exp2f(p0[r] - m_reg); ps += p0[r]; } \
        _Pragma("unroll") for (int r = 0; r < 16; ++r) { p1[r] = __builtin_amdgcn_exp2f(p1[r] - m_reg); ps += p1[r]; } \
        { auto rr = __builtin_amdgcn_permlane32_swap(__float_as_uint(ps), __float_as_uint(ps), false, false); ps = __uint_as_float(rr[0]) + __uint_as_float(rr[1]); } \
        l_reg = l_reg * alpha + ps; \
        bf16x8 pa0, pa1, pa2, pa3; \
        PK4(p0, 0, pa0); PK4(p0, 8, pa1); PK4(p1, 0, pa2); PK4(p1, 8, pa3); \
        SBAR(); \
        PV<DV>::run(o, vb0 + (B_) * VB, pa0, pa1, pa2, pa3); } while (0)
#define XSTEP(META_, TR_, B_) STEP(META_, TR_, B_)
    DMA(0, 0); __syncthreads();
    DMA(1, 1); XSTEP(true, 0, 0); __syncthreads();
#pragma unroll 1
    for (int t = 1; t < 33; t += 2) {
        DMA(t + 1, 0); XSTEP(false, t - 1, 1); __syncthreads();
        if (t + 2 < 33) DMA(t + 2, 1);
        XSTEP(false, t, 0); __syncthreads();
    }
#undef XSTEP
#undef STEP
#undef PK4
#undef LOADK
#undef MMAK
#undef DMA
    l_out = l_reg;
}

__device__ __forceinline__ void mla_unit(unsigned char* ws, int bl, int h, int qb, LAS unsigned char* ldsb) {
    const int tid = opaque(threadIdx.x); int lane = tid & 63, r32 = lane & 31, hi = lane >> 5; const int wid = __builtin_amdgcn_readfirstlane(tid >> 6);
    char* lds = (char*)ldsb; float* wsc = (float*)(lds + LDS_WSC) + wid * 64;
    const size_t rb = (size_t)bl * SEQ; const int q0 = qb * 256;
    const bf16* QM = (const bf16*)(wsp(ws, WS_QM)); const bf16* KM = (const bf16*)(wsp(ws, WS_KM)); const bf16* VM = (const bf16*)(wsp(ws, WS_VM));
    f32x16 o[4]; float l;
    attn_pass<192, 128, false>(o, l, QM + (rb + q0) * 3072 + h * 192, 3072, KM + rb * 3072 + h * 192, KM + (size_t)MH * 3072 + h * 192, 3072,
                               VM + rb * 2048 + h * 128, VM + (size_t)MH * 2048 + h * 128, 2048, q0, ldsb);
    lane = opaque(lane); r32 = lane & 31; hi = lane >> 5;
    if (hi == 0) wsc[r32] = l; LDS_WAIT();
    bf16* stg = (bf16*)(lds + wid * 8192);
#pragma unroll
    for (int r = 0; r < 16; ++r) { const float rl = __builtin_amdgcn_rcpf(wsc[crow(r, hi)]); const int orow = crow(r, hi);
#pragma unroll
        for (int d0 = 0; d0 < 4; ++d0) { const unsigned w = cvtpk(o[d0][r] * rl, 0.f); stg[orow * 128 + d0 * 32 + r32] = (bf16)(w & 0xffffu); } }
    LDS_WAIT();
    bf16* zp = (bf16*)(wsp(ws, WS_ZA)) + (rb + q0 + wid * 32 + (lane >> 4)) * 2048 + h * 128 + (lane & 15) * 8; const bf16* sp = stg + (lane >> 4) * 128 + (lane & 15) * 8;
#pragma unroll
    for (int i = 0; i < 8; ++i, zp += 4 * 2048, sp += 4 * 128) { asm volatile("" : "+v"(zp));
        const u32x4 s = *(const u32x4*)sp; const u32x4 z = *(const u32x4*)zp; u32x4 w;
#pragma unroll
        for (int e = 0; e < 4; ++e) w[e] = cvtpk(bflo(s[e]) * bflo(z[e]), bfhi(s[e]) * bfhi(z[e]));
        *(u32x4*)zp = w; }
    __syncthreads();
}
__device__ __forceinline__ void diff_unit(unsigned char* ws, float* o1s, const float* subln, int bl, int h, int qb, LAS unsigned char* ldsb) {
    const int tid = opaque(threadIdx.x); int lane = tid & 63, r32 = lane & 31, hi = lane >> 5; const int wid = __builtin_amdgcn_readfirstlane(tid >> 6);
    char* lds = (char*)ldsb; float* wsc = (float*)(lds + LDS_WSC) + wid * 64; float* wss = (float*)(lds + LDS_WSS) + wid * 32;
    const size_t rb = (size_t)bl * SEQ; const int q0 = qb * 256;
    const bf16* QD = (const bf16*)(wsp(ws, WS_QD)); const bf16* KD = (const bf16*)(wsp(ws, WS_KD)); const bf16* VD = (const bf16*)(wsp(ws, WS_VD));
    { float* bt = (float*)(lds + LDS_BT); const float* src = (const float*)(wsp(ws, WS_TAB) + TAB_BIAS) + h * 260; for (int i = tid; i < 257; i += NTHREADS) bt[i] = src[i]; }
    __syncthreads();
    const float lam = *(const float*)(wsp(ws, WS_TAB) + TAB_LAM);
#pragma unroll 1
    for (int pass = 0; pass < 4; ++pass) {
        const int mp = pass >> 1, vh = pass & 1;
        f32x16 o[4]; float l;
        attn_pass<128, 128, true>(o, l, QD + (rb + q0) * 2048 + h * 256 + mp * 128, 2048, KD + rb * 2048 + h * 256 + mp * 128, KD + (size_t)MH * 2048 + h * 256 + mp * 128, 2048,
                                  VD + rb * 2048 + h * 256 + vh * 128, VD + (size_t)MH * 2048 + h * 256 + vh * 128, 2048, q0, ldsb);
        lane = opaque(lane); r32 = lane & 31; hi = lane >> 5;
        if (hi == 0) wsc[r32] = l; LDS_WAIT();
        GF* st = (GF*)o1s + ((size_t)blockIdx.x * 8 + wid) * (32 * 256) + vh * 128 + r32;
        if (mp == 0) {
#pragma unroll
            for (int r = 0; r < 16; ++r) { const float rl = __builtin_amdgcn_rcpf(wsc[crow(r, hi)]); GF* sp = st + crow(r, hi) * 256;
#pragma unroll
                for (int d0 = 0; d0 < 4; ++d0) sp[d0 * 32] = o[d0][r] * rl; }
        } else {
#pragma unroll
            for (int r = 0; r < 16; ++r) { const float rl = __builtin_amdgcn_rcpf(wsc[crow(r, hi)]); GF* sp = st + crow(r, hi) * 256; float sq = 0.f;
#pragma unroll
                for (int d0 = 0; d0 < 4; ++d0) { const float y = sp[d0 * 32] - lam * (o[d0][r] * rl); sp[d0 * 32] = y; sq += y * y; }
                sq += __shfl_xor(sq, 1); sq += __shfl_xor(sq, 2); sq += __shfl_xor(sq, 4); sq += __shfl_xor(sq, 8); sq += __shfl_xor(sq, 16);
                if (r32 == 0) { if (vh == 0) wss[crow(r, hi)] = sq; else wss[crow(r, hi)] += sq; } }
        }
        asm volatile("s_waitcnt vmcnt(0) lgkmcnt(0)" ::: "memory");
    }
    { const GF* yp = (const GF*)o1s + ((size_t)blockIdx.x * 8 + wid) * (32 * 256) + (lane >> 5) * 256 + (lane & 31) * 8;
      bf16* zp = (bf16*)(wsp(ws, WS_ZB)) + (rb + q0 + wid * 32 + (lane >> 5)) * 2048 + h * 256 + (lane & 31) * 8;
      const f32x4 g0 = *(const f32x4*)(subln + (lane & 31) * 8), g1 = *(const f32x4*)(subln + (lane & 31) * 8 + 4);
#pragma unroll 4
      for (int i = 0; i < 16; ++i, zp += 2 * 2048, yp += 2 * 256) {
          const float rsn = __builtin_amdgcn_rsqf(wss[2 * i + (lane >> 5)] * (1.f / 256.f) + EPS) * 0.8f;
          const f32x4 y0 = *(const __attribute__((address_space(1))) f32x4*)yp, y1 = *(const __attribute__((address_space(1))) f32x4*)(yp + 4); const u32x4 z = *(const u32x4*)zp; u32x4 w;
          w[0] = cvtpk(y0[0] * rsn * g0[0] * bflo(z[0]), y0[1] * rsn * g0[1] * bfhi(z[0])); w[1] = cvtpk(y0[2] * rsn * g0[2] * bflo(z[1]), y0[3] * rsn * g0[3] * bfhi(z[1]));
          w[2] = cvtpk(y1[0] * rsn * g1[0] * bflo(z[2]), y1[1] * rsn * g1[1] * bfhi(z[2])); w[3] = cvtpk(y1[2] * rsn * g1[2] * bflo(z[3]), y1[3] * rsn * g1[3] * bfhi(z[3]));
          *(u32x4*)zp = w; } }
    __syncthreads();
}

template <class Map>
__device__ __forceinline__ void transpose_item(const float* __restrict__ W, int Nsrc, int K, bf16* __restrict__ WT, LAS float* scr, int item, int lane, const float* __restrict__ gain, Map map) {
    const int nkb = K / 64, nb = item / nkb, kb = item % nkb, k0 = 64 * kb, n0 = 32 * nb;
    const int sc = map(n0 + (lane & 31));
#pragma unroll 8
    for (int i = 0; i < 32; ++i) { const int kk = 2 * i + (lane >> 5); float v = (sc >= 0) ? W[(size_t)(k0 + kk) * Nsrc + sc] : 0.f; if (gain) v *= gain[k0 + kk]; scr[kk * 33 + (lane & 31)] = v; }
    LDS_WAIT(); asm volatile("" ::: "memory");
    const int c = lane & 7;
#pragma unroll
    for (int j = 0; j < 4; ++j) { const int n = (lane >> 3) + 8 * j; const LAS float* s = scr + (8 * c) * 33 + n;
        u32x4 o; o.x = cvtpk(s[0 * 33], s[1 * 33]); o.y = cvtpk(s[2 * 33], s[3 * 33]); o.z = cvtpk(s[4 * 33], s[5 * 33]); o.w = cvtpk(s[6 * 33], s[7 * 33]);
        *(u32x4*)(WT + (size_t)(n0 + n) * K + k0 + 8 * c) = o; }
    LDS_WAIT(); asm volatile("" ::: "memory");
}
__device__ __forceinline__ int rope_orig(int c) { return 32 * ((c >> 2) & 1) + 4 * (c >> 3) + (c & 3); }
struct MapWin { __device__ int operator()(int n) const { if (n < 1280) return n; if (n < 1536) { const int c = n - 1280; return c < 64 ? 1280 + rope_orig(c) : -1; } return n - 192; } };
struct MapWuq { __device__ int operator()(int n) const { const int h = n >> 8, c = n & 255; if (c < 128) return h * 192 + c; if (c < 192) return h * 192 + 128 + rope_orig(c - 128); return -1; } };
struct MapId { __device__ int operator()(int n) const { return n; } };

__device__ __forceinline__ int t5_bucket(int rel) {
    const int n = rel < 0 ? -rel : rel; int b;
    if (n < 8) b = n; else b = 8 + (n >= 12) + (n >= 16) + (n >= 23) + (n >= 32) + (n >= 46) + (n >= 64) + (n >= 91);
    return b + (rel > 0 ? 16 : 0);
}
__device__ __forceinline__ void rms_row_bf16(const float* __restrict__ xrow, const float* __restrict__ g, bf16* __restrict__ orow, int lane) {
    u32x2* o8 = (u32x2*)orow + lane;
    if (!xrow) {
#pragma unroll
        for (int j = 0; j < 8; ++j) o8[64 * j] = (u32x2){0u, 0u};
        return; }
    const f32x4* xr = (const f32x4*)xrow + lane; const f32x4* gr = (const f32x4*)g + lane;
    f32x4 v[8]; float s = 0.f;
#pragma unroll
    for (int j = 0; j < 8; ++j) { v[j] = xr[64 * j]; s += (v[j][0] * v[j][0] + v[j][1] * v[j][1]) + (v[j][2] * v[j][2] + v[j][3] * v[j][3]); }
    const float rs = __builtin_amdgcn_rsqf(wave_sum(s) * (1.f / 2048.f) + EPS);
#pragma unroll
    for (int j = 0; j < 8; ++j) { const f32x4 gg = gr[64 * j]; const f32x4 y = v[j] * rs * gg; o8[64 * j] = (u32x2){cvtpk(y[0], y[1]), cvtpk(y[2], y[3])}; }
}
__device__ __forceinline__ void p0_prologue(LAS unsigned char* ldsb, int vcu, int G) {
    const int tid = opaque(threadIdx.x), lane = tid & 63; const int wave = __builtin_amdgcn_readfirstlane(tid >> 6);
    LAS float* scr = (LAS float*)(ldsb + wave * 16384);
    const int gw = vcu * NWAVES + wave, NGW = G * NWAVES;
    unsigned char* ws = kws();
    constexpr int I_WIN = (NIN / 32) * 32, I_WUQ = 128 * 12, I_WUKV = 128 * 8, I_SQ = 64 * 32;
    constexpr int NITEMS = I_WIN + I_WUQ + I_WUKV + 3 * I_SQ;
    for (int it = gw; it < NITEMS; it += NGW) {
        int r = it;
        if (r < I_WIN) { transpose_item(kin(4), INW, 2048, (bf16*)(wsp(ws, WS_WIN)), scr, r, lane, nullptr, MapWin()); continue; } r -= I_WIN;
        if (r < I_WUQ) { transpose_item(kin(7), 3072, 768, (bf16*)(wsp(ws, WS_WUQ)), scr, r, lane, kin(5), MapWuq()); continue; } r -= I_WUQ;
        if (r < I_WUKV) { transpose_item(kin(8), 4096, 512, (bf16*)(wsp(ws, WS_WUKV)), scr, r, lane, kin(6), MapId()); continue; } r -= I_WUKV;
        if (r < I_SQ) { transpose_item(kin(15), 2048, 2048, (bf16*)(wsp(ws, WS_WA)), scr, r, lane, nullptr, MapId()); continue; } r -= I_SQ;
        if (r < I_SQ) { transpose_item(kin(16), 2048, 2048, (bf16*)(wsp(ws, WS_WB)), scr, r, lane, nullptr, MapId()); continue; } r -= I_SQ;
        transpose_item(kin(17), 2048, 2048, (bf16*)(wsp(ws, WS_WO)), scr, r, lane, nullptr, MapId());
    }
    bf16* ureal = (bf16*)((unsigned char*)kout() + (size_t)64 * 1024 * 1024); bf16* umeta = (bf16*)(wsp(ws, WS_UMETA));
    for (int m = gw; m < NBATCH * SEQ + 256; m += NGW) {
        if (m < NBATCH * SEQ) rms_row_bf16(kin(0) + (size_t)m * DM, kin(3), ureal + (size_t)m * DM, lane);
        else { const int j = m - NBATCH * SEQ; rms_row_bf16(j < NMETA ? kin(1) + (size_t)j * DM : nullptr, kin(3), umeta + (size_t)j * DM, lane); }
    }
    const int gt = vcu * NTHREADS + tid, NGT = G * NTHREADS;
    float* ctab = (float*)(wsp(ws, WS_TAB) + TAB_COS); float* stab = (float*)(wsp(ws, WS_TAB) + TAB_SIN); float* btab = (float*)(wsp(ws, WS_TAB) + TAB_BIAS);
    for (int i = gt; i < 2064 * 32; i += NGT) { const int pos = i >> 5, k = i & 31; const float inv = powf(10000.f, -(float)k / 32.f); const float ang = (float)pos * inv; ctab[i] = cosf(ang); stab[i] = sinf(ang); }
    for (int i = gt; i < 8 * 257; i += NGT) { const int h = i / 257, j = i % 257; btab[h * 260 + j] = kin(2)[t5_bucket(j - 128) * 8 + h] * LOG2E; }
    if (vcu == 0 && wave == 0) { const float* dl = kin(13);
        float a = dl[lane] * dl[128 + lane] + dl[64 + lane] * dl[192 + lane], b = dl[256 + lane] * dl[384 + lane] + dl[320 + lane] * dl[448 + lane];
        a = wave_sum(a); b = wave_sum(b); if (lane == 0) *(float*)(wsp(ws, WS_TAB) + TAB_LAM) = __expf(a) - __expf(b) + 0.2f; }
}

#ifndef MK_PH_LO
#define MK_PH_LO 0
#define MK_PH_HI 99
#endif
#ifndef MK_ONLY
#define MK_ON(n) 1
#else
#define MK_ON(n) (MK_ONLY == (n))
#endif
#define WSL() kws()
template <int half> __device__ __forceinline__ void run_half(LAS unsigned char* lds, cg::grid_group& grid, int G, int bx, int vcu) {
        unsigned char* ws;
        ws = WSL(); if (MK_ON(1)) { SchedP1 S; S.T.init(33, 62, G, bx); S.U = (const char*)kout() + (size_t)64 * 1024 * 1024 + (size_t)half * MH * 2048 * 2; S.Umeta = (const char*)(wsp(ws, WS_UMETA)); S.W = (const char*)(wsp(ws, WS_WIN));
          EpiP1 E{ws, kin(11), kin(12)};
          gemm_phase(lds, 2048, 2048, 32, S, E); }
        grid.sync();
        ws = WSL(); if (MK_ON(2)) { SchedP2Q S; S.T.init(32, 16, G, bx); S.CQ = (const char*)(wsp(ws, WS_CQ)); S.W = (const char*)(wsp(ws, WS_WUQ)); EpiP2Q E{ws, kin(9)};
          gemm_phase(lds, 768, 768, 12, S, E); }
        ws = WSL(); if (MK_ON(3)) { SchedP2KV S; S.T.init(33, 16, G, bx); S.CKV = (const char*)(wsp(ws, WS_CKV)); S.W = (const char*)(wsp(ws, WS_WUKV)); EpiP2KV E{ws, kin(10)};
          gemm_phase(lds, 512, 512, 8, S, E); }
        grid.sync();
        ws = WSL(); { const int x = vcu >> 5, v = vcu & 31;
          float* o1s = half == 0 ? kout() : (float*)(wsp(ws, WS_WIN));
          if (G == 256) {
              if (MK_ON(4)) for (int i = 0; i < 2; ++i) { const int pair = 8 * x + 4 * i + (v >> 3); mla_unit(ws, pair >> 4, pair & 15, v & 7, lds); }
              if (MK_ON(5)) { const int pair = 4 * x + (v >> 3); diff_unit(ws, o1s, kin(14), pair >> 3, pair & 7, v & 7, lds); }
          } else {
              if (MK_ON(4)) for (int uidx = bx; uidx < 512; uidx += G) mla_unit(ws, uidx >> 7, (uidx >> 3) & 15, uidx & 7, lds);
              if (MK_ON(5)) for (int uidx = bx; uidx < 256; uidx += G) diff_unit(ws, o1s, kin(14), uidx >> 6, (uidx >> 3) & 7, uidx & 7, lds);
          } }
        grid.sync();
        ws = WSL(); if (MK_ON(6)) { SchedP4 S; S.T.init(32, 8, G, bx); S.OA = (const char*)(wsp(ws, WS_ZA)); S.OB = (const char*)(wsp(ws, WS_ZB)); S.WA = (const char*)(wsp(ws, WS_WA)); S.WB = (const char*)(wsp(ws, WS_WB));
          EpiP4 E{ws}; gemm_phase(lds, 2048, 2048, 32, S, E); }
        grid.sync();
        ws = WSL(); if (MK_ON(7)) { SchedP5 S; S.T.init(32, 8, G, bx); S.MB = (const char*)(wsp(ws, WS_MB)); S.WO = (const char*)(wsp(ws, WS_WO));
          EpiP5 E{kin(0) + (size_t)half * MH * DM, kout() + (size_t)half * MH * DM}; gemm_phase(lds, 2048, 2048, 32, S, E); }
    }
__global__ void __launch_bounds__(NTHREADS, 2) mega(Params p) {
    extern __shared__ __attribute__((aligned(16))) unsigned char lds_raw[];
    LAS unsigned char* lds = (LAS unsigned char*)lds_raw;
    cg::grid_group grid = cg::this_grid();
    const int G = gridDim.x, bx = blockIdx.x; const int vcu = (G % 8 == 0) ? (bx % 8) * (G / 8) + bx / 8 : bx;
    if (MK_ON(0)) p0_prologue(lds, vcu, G);
    grid.sync();
    run_half<0>(lds, grid, G, bx, vcu);
    run_half<1>(lds, grid, G, bx, vcu);
}
}
extern "C" void kernel_launch(void* const* d_in, const int* in_sizes, int n_in, void* d_out, int out_size, void* d_ws, size_t ws_size, hipStream_t stream) {
    static int grid_blocks = 0;
    if (!grid_blocks) {
        int dev = 0, cus = 0, per_cu = 0;
        (void)hipGetDevice(&dev);
        (void)hipDeviceGetAttribute(&cus, hipDeviceAttributeMultiprocessorCount, dev);
        (void)hipFuncSetAttribute((const void*)mk::mega, hipFuncAttributeMaxDynamicSharedMemorySize, mk::LDS_BYTES);
        (void)hipOccupancyMaxActiveBlocksPerMultiprocessor(&per_cu, (const void*)mk::mega, mk::NTHREADS, mk::LDS_BYTES);
        if (per_cu < 1) per_cu = 1;
        grid_blocks = cus * per_cu;
        if (ws_size < mk::WS_END) { fprintf(stderr, "kernel_launch: workspace too small: %zu < %zu\n", ws_size, (size_t)mk::WS_END); grid_blocks = -1; }
    }
    if (grid_blocks < 0) return;
    mk::Params p{};
    for (int i = 0; i < 18; ++i) p.in[i] = (const float*)d_in[i];
    p.out = (float*)d_out; p.ws = (unsigned char*)d_ws;
    void* args[] = {&p};
    hipError_t e = hipLaunchCooperativeKernel((const void*)mk::mega, dim3(grid_blocks), dim3(mk::NTHREADS), args, mk::LDS_BYTES, stream);
    if (e != hipSuccess) fprintf(stderr, "cooperative launch failed: %s (grid %d)\n", hipGetErrorString(e), grid_blocks);
}
```

```cpp
#include <hip/hip_runtime.h>
#include <hip/hip_cooperative_groups.h>
#include <math.h>
#include <stdint.h>
#include <cstdio>
namespace mk {
namespace cg = cooperative_groups;
#define LAS __attribute__((address_space(3)))
typedef unsigned short bf16;
typedef short bf16x8 __attribute__((ext_vector_type(8)));
typedef short s16x4 __attribute__((ext_vector_type(4)));
typedef float f32x4 __attribute__((ext_vector_type(4)));
typedef float f32x2 __attribute__((ext_vector_type(2)));
typedef float f32x16 __attribute__((ext_vector_type(16)));
typedef unsigned u32x4 __attribute__((ext_vector_type(4)));
typedef unsigned u32x2 __attribute__((ext_vector_type(2)));
typedef __bf16 bf16x2_t __attribute__((ext_vector_type(2)));
typedef __attribute__((address_space(1))) float GF;

constexpr int DM = 2048, NBATCH = 8, SEQ = 2048, NMETA = 16;
constexpr int HB = 4, MH = HB * SEQ, MHK = MH + 256;
constexpr int NIN = 15872;
constexpr int INW = 15680;
constexpr float EPS = 1e-6f, LOG2E = 1.4426950408889634f;
constexpr float QS_MLA = 0.07216878364870322f * LOG2E;
constexpr float QS_DIFF = 0.08838834764831845f * LOG2E;
constexpr int NWAVES = 8, NTHREADS = 512;
constexpr int T_CQ = 0, T_CKV = 3, T_KR = 5, T_ZA = 6, T_QD = 14, T_KD = 22, T_VD = 30, T_ZB = 38, T_GA = 46, T_GB = 54, T_END = 62;

constexpr size_t al(size_t x) { return (x + 4095) / 4096 * 4096; }
constexpr size_t WS_WIN = 0;
constexpr size_t WS_WUQ = WS_WIN + al((size_t)NIN * 2048 * 2);
constexpr size_t WS_WUKV = WS_WUQ + al((size_t)4096 * 768 * 2);
constexpr size_t WS_WA = WS_WUKV + al((size_t)4096 * 512 * 2);
constexpr size_t WS_WB = WS_WA + al((size_t)2048 * 2048 * 2);
constexpr size_t WS_WO = WS_WB + al((size_t)2048 * 2048 * 2);
constexpr size_t WS_UMETA = WS_WO + al((size_t)2048 * 2048 * 2);
constexpr size_t WS_TAB = WS_UMETA + al((size_t)256 * 2048 * 2);
constexpr size_t TAB_COS = 0, TAB_SIN = (size_t)2064 * 32 * 4, TAB_BIAS = 2 * TAB_SIN, TAB_LAM = TAB_BIAS + 8 * 260 * 4;
constexpr size_t WS_CQ = WS_TAB + al(TAB_LAM + 64);
constexpr size_t WS_CKV = WS_CQ + al((size_t)MHK * 768 * 2);
constexpr size_t WS_KR = WS_CKV + al((size_t)MHK * 512 * 2);
constexpr size_t WS_SSP = WS_KR + al((size_t)MHK * 64 * 2);
constexpr size_t SZ_ACT = al((size_t)MHK * 2048 * 2);
constexpr size_t WS_ZA = WS_SSP + al((size_t)MHK * 16 * 4);
constexpr size_t WS_QD = WS_ZA + SZ_ACT, WS_KD = WS_QD + SZ_ACT, WS_VD = WS_KD + SZ_ACT, WS_ZB = WS_VD + SZ_ACT, WS_SA = WS_ZB + SZ_ACT, WS_SB = WS_SA + SZ_ACT;
constexpr size_t WS_QM = WS_SB + SZ_ACT;
constexpr size_t WS_KM = WS_QM + al((size_t)MHK * 3072 * 2);
constexpr size_t WS_VM = WS_KM + al((size_t)MHK * 3072 * 2);
constexpr size_t WS_END = WS_VM + SZ_ACT;
constexpr size_t WS_MB = WS_VM;
constexpr size_t O1S_BYTES = (size_t)256 * 8 * 32 * 256 * 4;
static_assert(WS_WUKV - WS_WIN >= O1S_BYTES, "O1 stash of half 1 overlays WIN_T|WUQ_T");
constexpr size_t WS_CTL = WS_END, CTL_BYTES = 65536;
static_assert(WS_CTL + CTL_BYTES <= (size_t)512 * 1024 * 1024, "workspace");

constexpr int LDS_RING = 0, RING_BYTES = 131072;
constexpr int LDS_X = RING_BYTES;
constexpr int LDS_X2 = LDS_X + 8192;
constexpr int LDS_WSC = LDS_X2 + 1024;
constexpr int LDS_WSS = LDS_WSC + 2048;
constexpr int LDS_BT = LDS_WSS + 1024;
constexpr int LDS_MISC = LDS_BT + 1056;
constexpr int LDS_BYTES = 147456;

struct Params {
    const float* in[18];
    float* out; unsigned char* ws;
    int dbg, pad;
};

#define CAS __attribute__((address_space(4)))
typedef const float* cfp_t; typedef float* fp_t; typedef unsigned char* ucp_t;
__device__ __forceinline__ const float* kin(int k) { const volatile CAS cfp_t* kp = (const volatile CAS cfp_t*)__builtin_amdgcn_kernarg_segment_ptr(); return kp[k]; }
__device__ __forceinline__ float* kout() { const volatile CAS fp_t* kp = (const volatile CAS fp_t*)__builtin_amdgcn_kernarg_segment_ptr(); return kp[18]; }
__device__ __forceinline__ unsigned char* kws() { const volatile CAS ucp_t* kp = (const volatile CAS ucp_t*)__builtin_amdgcn_kernarg_segment_ptr(); return kp[19]; }
__device__ __forceinline__ unsigned char* wsp(unsigned char* ws, size_t off) { unsigned k = (unsigned)(off >> 12); asm volatile("" : "+s"(k)); return ws + ((size_t)k << 12); }
__device__ __forceinline__ int kdbg() { const volatile CAS int* kp = (const volatile CAS int*)__builtin_amdgcn_kernarg_segment_ptr(); return kp[40]; }
__device__ __forceinline__ unsigned cvtpk(float lo, float hi) { f32x2 v = {lo, hi}; bf16x2_t b = __builtin_convertvector(v, bf16x2_t); return __builtin_bit_cast(unsigned, b); }
__device__ __forceinline__ float bflo(unsigned u) { return __builtin_bit_cast(float, u << 16); }
__device__ __forceinline__ float bfhi(unsigned u) { return __builtin_bit_cast(float, u & 0xffff0000u); }
__device__ __forceinline__ float silu_f(float v) { return v * __builtin_amdgcn_rcpf(1.f + __expf(-v)); }
__device__ __forceinline__ float sigm_f(float v) { return __builtin_amdgcn_rcpf(1.f + __expf(-v)); }
__device__ __forceinline__ float wave_sum(float v) {
#pragma unroll
    for (int o = 1; o < 64; o <<= 1) v += __shfl_xor(v, o);
    return v;
}
__device__ __forceinline__ int crow(int r, int hi) { return (r & 3) + 8 * (r >> 2) + 4 * hi; }
__device__ __forceinline__ int opaque(int x) { asm volatile("" : "+v"(x)); return x; }
#define LDS_WAIT() asm volatile("s_waitcnt lgkmcnt(0)" ::: "memory")
#define SBAR() __builtin_amdgcn_sched_barrier(0)


#define XB_TMO      128
#define XB_XCNT(j)  (256  + 64 * (j))
#define XB_XSUB(j)  (1280 + 64 * (j))
#define XB_XGEN(j)  (2304 + 64 * (j))
#define XB_TOP      3328
#define XB_TOPGEN   3392
#define XB_SPIN_CAP (1u << 22)
__device__ __forceinline__ unsigned xb_ld(unsigned* p)              { return __hip_atomic_load(p, __ATOMIC_RELAXED, __HIP_MEMORY_SCOPE_AGENT); }
__device__ __forceinline__ unsigned xb_add(unsigned* p, unsigned v) { return __hip_atomic_fetch_add(p, v, __ATOMIC_RELAXED, __HIP_MEMORY_SCOPE_AGENT); }
__device__ __forceinline__ unsigned xb_xcc_id() { return (unsigned)__builtin_amdgcn_s_getreg((3 << 11) | 20) & 0xFu; }
#define XB_SPIN(cond, bar) do { unsigned _sp = 0; while (cond) { __builtin_amdgcn_s_sleep(1); \
    if ((++_sp & 255u) == 0u) { if (xb_ld(&(bar)[XB_TMO])) break; if (_sp > XB_SPIN_CAP) { atomicAdd(&(bar)[XB_TMO], 1u); break; } } } } while (0)
struct XcdBarrier { unsigned* bar; unsigned x; volatile LAS unsigned* st; };
__device__ __forceinline__ XcdBarrier xcd_barrier_post(unsigned* bar, volatile LAS unsigned* st) {
    XcdBarrier b; b.bar = bar; b.x = xb_xcc_id(); b.st = st;
    if (threadIdx.x == 0) (void)xb_add(&bar[XB_XCNT(b.x)], 1u);
    return b;
}
__device__ __forceinline__ void xcd_barrier_complete(unsigned* bar, unsigned x, unsigned& nloc, unsigned& nx) {
    const unsigned G = gridDim.x * gridDim.y * gridDim.z;
    unsigned sum, cnt, mine, sp = 0u;
    for (;;) {
        sum = 0u; cnt = 0u; mine = 0u;
#pragma unroll
        for (unsigned j = 0; j < 16; ++j) { const unsigned c = xb_ld(&bar[XB_XCNT(j)]); sum += c; cnt += (c > 0u) ? 1u : 0u; mine = (j == x) ? c : mine; }
        if (sum == G) break;
        __builtin_amdgcn_s_sleep(1);
        if ((++sp & 255u) == 0u) { if (xb_ld(&bar[XB_TMO])) break; if (sp > XB_SPIN_CAP) { atomicAdd(&bar[XB_TMO], 1u); break; } }
    }
    nloc = mine > 0u ? mine : 1u; nx = cnt > 0u ? cnt : 1u;
}
__device__ __forceinline__ void xcd_barrier(const XcdBarrier& b) {
    asm volatile("s_waitcnt vmcnt(0)" ::: "memory");
    __syncthreads();
    if (threadIdx.x == 0) {
        unsigned* bar = b.bar;
        __builtin_amdgcn_s_waitcnt(0);
        unsigned nloc = b.st[0], nx = b.st[1];
        if (nloc == 0u) { xcd_barrier_complete(bar, b.x, nloc, nx); b.st[0] = nloc; b.st[1] = nx; }
        const unsigned old = xb_add(&bar[XB_XSUB(b.x)], 1u);
        const unsigned gen = old / nloc;
        if (old + 1u == (gen + 1u) * nloc) {
            __builtin_amdgcn_fence(__ATOMIC_RELEASE, "agent");
            asm volatile("s_waitcnt vmcnt(0)" ::: "memory");
            const unsigned og = xb_add(&bar[XB_TOP], 1u);
            const unsigned tg = og / nx;
            if (og + 1u == (tg + 1u) * nx) xb_add(&bar[XB_TOPGEN], 1u);
            else XB_SPIN(xb_ld(&bar[XB_TOPGEN]) == tg, bar);
            __builtin_amdgcn_fence(__ATOMIC_ACQUIRE, "agent");
            xb_add(&bar[XB_XGEN(b.x)], 1u);
            asm volatile("s_waitcnt vmcnt(0)" ::: "memory");
        } else {
            XB_SPIN(xb_ld(&bar[XB_XGEN(b.x)]) == gen, bar);
            __builtin_amdgcn_fence(__ATOMIC_ACQUIRE, "agent");
            asm volatile("s_waitcnt vmcnt(0)" ::: "memory");
        }
    }
    __syncthreads();
}

constexpr int BM = 256, BK = 64, HALF = 128, HTB = HALF * BK * 2, NXCD = 8, WGM = 8;
__device__ __forceinline__ int lds_byte(int r, int c) { const int st = (r >> 4) * 2 + (c >> 5), rr = r & 15, cc = c & 31, ob = rr * 64 + cc * 2; return st * 1024 + (ob ^ (((ob >> 9) & 1) << 5)); }
__device__ __forceinline__ void stage_rc(int b, int& R, int& C) { const int st = b / 1024, sb = b % 1024, swz = sb ^ (((sb >> 9) & 1) << 5); R = (st >> 1) * 16 + swz / 64; C = (st & 1) * 32 + (swz % 64) / 2; }
__device__ __forceinline__ int perm32(int rho) { const int n = rho >> 4, i = rho & 15; return 8 * (i >> 2) + 4 * n + (i & 3); }

struct Unit { const char* A; const char* B; int pm, pn, kind; };
struct TileOrder {
    int nM, nN, nwg, G, c;
    __device__ void init(int nM_, int nN_, int G_, int c_) { nM = nM_; nN = nN_; nwg = nM * nN; G = G_; c = c_; }
    __device__ bool tile(int i, int& pm, int& pn) const {
        const long L = (long)i * G + c; if (L >= nwg) return false;
        int wgid = (int)L; { const int q = nwg / NXCD, r = nwg % NXCD, xcd = wgid % NXCD, off = wgid / NXCD; wgid = (xcd < r ? xcd * (q + 1) : r * (q + 1) + (xcd - r) * q) + off; }
        const int nig = WGM * nN, gid = wgid / nig, fm = gid * WGM, gsz = (nM - fm) < WGM ? (nM - fm) : WGM;
        pm = fm + ((wgid % nig) % gsz); pn = (wgid % nig) / gsz; return true;
    }
};

typedef f32x4 Acc[2][2][4][2];

template <class Epi, class Sched>
__device__ __forceinline__ void gemm_phase(LAS unsigned char* lds, const int lda, const int ldb, const int nt, const Sched& S, const Epi& E) {
    const int tid = opaque(threadIdx.x), wid = __builtin_amdgcn_readfirstlane(tid >> 6), lane = tid & 63, wr = wid >> 2, wc = wid & 3, fr = lane & 15, fq = lane >> 4;
    unsigned voffA[2], voffB[2];
#pragma unroll
    for (int i = 0; i < 2; ++i) { int R, C; stage_rc(tid * 16 + i * 8192, R, C); const int Rb = (R & ~31) + perm32(R & 31);
        voffA[i] = (unsigned)(R * lda + C) * 2u; voffB[i] = (unsigned)(Rb * ldb + C) * 2u; }
    const size_t kstep = (size_t)(BK * 2);
    const size_t hstepA = (size_t)HALF * lda * 2, hstepB = (size_t)HALF * ldb * 2;
    const unsigned ldsw = (unsigned)wid * 1024u;
    const int aoff = lds_byte(wr * 64 + fr, fq * 8), boff = lds_byte(wc * 32 + fr, fq * 8);
#define PG8_SA(b, h) (((b) * 2 + (h)) * HTB)
#define PG8_SB(b, h) ((4 + (b) * 2 + (h)) * HTB)
#define PG8_STAGE(bufoff, gbase, voff) do { _Pragma("unroll") for (int _i = 0; _i < 2; ++_i) \
        __builtin_amdgcn_global_load_lds((const unsigned*)((const char*)(gbase) + (voff)[_i]), (LAS unsigned*)(lds + (bufoff) + ldsw + _i * 8192), 16, 0, 0); } while (0)
#define PG8_LDA(dst, b, h) do { _Pragma("unroll") for (int m = 0; m < 4; ++m) _Pragma("unroll") for (int k = 0; k < 2; ++k) dst[m][k] = *(const LAS bf16x8*)(lds + PG8_SA(b, h) + aoff + m * 2048 + k * 1024); } while (0)
#define PG8_LDB(dst, b, h) do { _Pragma("unroll") for (int n = 0; n < 2; ++n) _Pragma("unroll") for (int k = 0; k < 2; ++k) dst[n][k] = *(const LAS bf16x8*)(lds + PG8_SB(b, h) + boff + n * 2048 + k * 1024); } while (0)
#define PG8_MMA(ai, bj, At, Bt) do { __builtin_amdgcn_s_setprio(1); _Pragma("unroll") for (int m = 0; m < 4; ++m) _Pragma("unroll") for (int n = 0; n < 2; ++n) _Pragma("unroll") for (int k = 0; k < 2; ++k) \
        acc[ai][bj][m][n] = __builtin_amdgcn_mfma_f32_16x16x32_bf16(Bt[n][k], At[m][k], acc[ai][bj][m][n], 0, 0, 0); __builtin_amdgcn_s_setprio(0); } while (0)
#define PG8_WAIT_V(n) asm volatile("s_waitcnt vmcnt(" #n ")" ::: "memory")
#define PG8_WAIT_L(n) asm volatile("s_waitcnt lgkmcnt(" #n ")" ::: "memory")
#define PG8_BAR __builtin_amdgcn_s_barrier()
#define PG8_SCHED __builtin_amdgcn_sched_barrier(0)
    Unit cur, nxt; int ui = 0;
    if (!S.next(0, cur)) return;
    Acc acc;
#pragma unroll
    for (int a = 0; a < 2; ++a)
#pragma unroll
        for (int b = 0; b < 2; ++b)
#pragma unroll
            for (int m = 0; m < 4; ++m)
#pragma unroll
                for (int n = 0; n < 2; ++n) acc[a][b][m][n] = (f32x4){0.f, 0.f, 0.f, 0.f};
    bf16x8 At[4][2], B0[2][2], B1[2][2];
    const char* cA = cur.A; const char* cB = cur.B;
    PG8_STAGE(PG8_SB(0, 0), cB, voffB); PG8_STAGE(PG8_SB(0, 1), cB + hstepB, voffB); PG8_STAGE(PG8_SA(0, 0), cA, voffA); PG8_STAGE(PG8_SA(0, 1), cA + hstepA, voffA);
    if (wr == 1) PG8_BAR;
    PG8_WAIT_V(2); PG8_BAR;
    PG8_STAGE(PG8_SB(1, 0), cB + kstep, voffB); PG8_STAGE(PG8_SA(1, 0), cA + kstep, voffA); PG8_STAGE(PG8_SB(1, 1), cB + hstepB + kstep, voffB);
    PG8_WAIT_V(6); PG8_BAR;
    for (;;) {
        const bool has_next = S.next(ui + 1, nxt);
        const char* nA = has_next ? nxt.A : cA; const char* nB = has_next ? nxt.B : cB;
        for (int t = 0; t < nt; t += 2) {
            const bool last = (t == nt - 2);
            const char* a1 = cA + (size_t)(t + 1) * kstep;
            const char* a2 = last ? nA : cA + (size_t)(t + 2) * kstep; const char* b2 = last ? nB : cB + (size_t)(t + 2) * kstep;
            const char* a3 = a2 + kstep; const char* b3 = b2 + kstep;
            PG8_LDB(B0, 0, 0); PG8_LDB(B1, 0, 1); PG8_SCHED; PG8_LDA(At, 0, 0); PG8_STAGE(PG8_SA(1, 1), a1 + hstepA, voffA);
            PG8_WAIT_V(8); PG8_WAIT_L(0); PG8_BAR; PG8_MMA(0, 0, At, B0); PG8_MMA(0, 1, At, B1); PG8_BAR; PG8_SCHED;
            PG8_LDA(At, 0, 1); PG8_STAGE(PG8_SB(0, 0), b2, voffB); PG8_STAGE(PG8_SB(0, 1), b2 + hstepB, voffB); PG8_STAGE(PG8_SA(0, 0), a2, voffA);
            PG8_WAIT_V(8); PG8_WAIT_L(0); PG8_BAR; PG8_MMA(1, 0, At, B0); PG8_MMA(1, 1, At, B1); PG8_BAR; PG8_SCHED;
            PG8_LDB(B0, 1, 0); PG8_LDB(B1, 1, 1); PG8_SCHED; PG8_LDA(At, 1, 0); PG8_STAGE(PG8_SA(0, 1), a2 + hstepA, voffA);
            PG8_WAIT_V(8); PG8_WAIT_L(0); PG8_BAR; PG8_MMA(0, 0, At, B0); PG8_MMA(0, 1, At, B1); PG8_BAR; PG8_SCHED;
            PG8_LDA(At, 1, 1); PG8_STAGE(PG8_SB(1, 0), b3, voffB); PG8_STAGE(PG8_SB(1, 1), b3 + hstepB, voffB); PG8_STAGE(PG8_SA(1, 0), a3, voffA);
            PG8_WAIT_V(8); PG8_WAIT_L(0); PG8_BAR; PG8_MMA(1, 0, At, B0); PG8_MMA(1, 1, At, B1); PG8_BAR; PG8_SCHED;
        }
        if (wr == 0) PG8_BAR;
        const bool keep = E(acc, cur, wr, wc, fr, fq, lds);
        if (!has_next) break;
        if (!keep) {
#pragma unroll
            for (int a = 0; a < 2; ++a)
#pragma unroll
                for (int b = 0; b < 2; ++b)
#pragma unroll
                    for (int m = 0; m < 4; ++m)
#pragma unroll
                        for (int n = 0; n < 2; ++n) acc[a][b][m][n] = (f32x4){0.f, 0.f, 0.f, 0.f};
        }
        cur = nxt; cA = nA; cB = nB; ++ui;
        if (wr == 1) PG8_BAR;
    }
    PG8_WAIT_V(0);
    PG8_BAR;
#undef PG8_SA
#undef PG8_SB
#undef PG8_STAGE
#undef PG8_LDA
#undef PG8_LDB
#undef PG8_MMA
#undef PG8_WAIT_V
#undef PG8_WAIT_L
#undef PG8_BAR
#undef PG8_SCHED
}

__device__ __forceinline__ void tile_half_ss(const Acc& acc, LAS unsigned char* lds, int wr, int wc, int fr, int fq, float (&ss)[2][4][2]) {
    LAS float* X = (LAS float*)(lds + LDS_X);
#pragma unroll
    for (int ai = 0; ai < 2; ++ai)
#pragma unroll
        for (int m = 0; m < 4; ++m)
#pragma unroll
            for (int bj = 0; bj < 2; ++bj) {
                const f32x4 a = acc[ai][bj][m][0], b = acc[ai][bj][m][1];
                float s = (a[0] * a[0] + a[1] * a[1]) + (a[2] * a[2] + a[3] * a[3]) + (b[0] * b[0] + b[1] * b[1]) + (b[2] * b[2] + b[3] * b[3]);
                s += __shfl_xor(s, 16); s += __shfl_xor(s, 32);
                if (fq == 0) X[((ai * 128 + wr * 64 + m * 16 + fr) * 2 + bj) * 4 + wc] = s;
            }
    LDS_WAIT(); __builtin_amdgcn_s_barrier(); asm volatile("" ::: "memory");
#pragma unroll
    for (int ai = 0; ai < 2; ++ai)
#pragma unroll
        for (int m = 0; m < 4; ++m)
#pragma unroll
            for (int bj = 0; bj < 2; ++bj) {
                const f32x4 v = *(const LAS f32x4*)(X + ((ai * 128 + wr * 64 + m * 16 + fr) * 2 + bj) * 4);
                ss[ai][m][bj] = (v[0] + v[1]) + (v[2] + v[3]);
            }
}
__device__ __forceinline__ u32x4 pack8(const f32x4 a, const f32x4 b) { u32x4 w; w.x = cvtpk(a[0], a[1]); w.y = cvtpk(a[2], a[3]); w.z = cvtpk(b[0], b[1]); w.w = cvtpk(b[2], b[3]); return w; }

struct EpiP1 {
    unsigned char* ws; const float* gqd; const float* gkd;
    __device__ __forceinline__ bool operator()(Acc& acc, const Unit& u, int wr, int wc, int fr, int fq, LAS unsigned char* lds) const {
        fr = opaque(fr); fq = opaque(fq);
        const int pn = u.pn; const int row0 = u.pm * 256 + wr * 64 + fr;
        const int colw = wc * 32 + 8 * fq;
        if (pn < T_KR) {
            float ss[2][4][2]; tile_half_ss(acc, lds, wr, wc, fr, fq, ss);
            const bool iscq = pn < T_CKV;
            bf16* dst = iscq ? (bf16*)(wsp(ws, WS_CQ)) : (bf16*)(wsp(ws, WS_CKV)); const int ld = iscq ? 768 : 512; const int c0 = iscq ? pn * 256 : (pn - T_CKV) * 256;
            const int chunk0 = iscq ? pn * 2 : 6 + (pn - T_CKV) * 2;
            float* ssp = (float*)(wsp(ws, WS_SSP));
#pragma unroll
            for (int ai = 0; ai < 2; ++ai)
#pragma unroll
                for (int m = 0; m < 4; ++m) { const int row = row0 + ai * 128 + m * 16;
#pragma unroll
                    for (int bj = 0; bj < 2; ++bj) {
                        *(u32x4*)(dst + (size_t)row * ld + c0 + bj * 128 + colw) = pack8(acc[ai][bj][m][0], acc[ai][bj][m][1]);
                        if (wc == 0 && fq == 0) ssp[(size_t)row * 16 + chunk0 + bj] = ss[ai][m][bj];
                    } }
            return false;
        }
        if (pn == T_KR) {
            if (wc < 2) { bf16* dst = (bf16*)(wsp(ws, WS_KR));
#pragma unroll
                for (int ai = 0; ai < 2; ++ai)
#pragma unroll
                    for (int m = 0; m < 4; ++m) { const int row = row0 + ai * 128 + m * 16; *(u32x4*)(dst + (size_t)row * 64 + colw) = pack8(acc[ai][0][m][0], acc[ai][0][m][1]); } }
            return false;
        }
        if (pn >= T_QD && pn < T_VD) {
            float ss[2][4][2]; tile_half_ss(acc, lds, wr, wc, fr, fq, ss);
            const bool isq = pn < T_KD; const float* g = isq ? gqd : gkd; const float post = isq ? QS_DIFF : 1.f;
            bf16* dst = isq ? (bf16*)(wsp(ws, WS_QD)) : (bf16*)(wsp(ws, WS_KD)); const int c0 = (isq ? pn - T_QD : pn - T_KD) * 256;
            const f32x4 g0 = *(const f32x4*)(g + colw), g1 = *(const f32x4*)(g + colw + 4);
#pragma unroll
            for (int ai = 0; ai < 2; ++ai)
#pragma unroll
                for (int m = 0; m < 4; ++m) { const int row = row0 + ai * 128 + m * 16;
#pragma unroll
                    for (int bj = 0; bj < 2; ++bj) { const float rs = __builtin_amdgcn_rsqf(ss[ai][m][bj] * (1.f / 128.f) + EPS) * post;
                        *(u32x4*)(dst + (size_t)row * 2048 + c0 + bj * 128 + colw) = pack8(acc[ai][bj][m][0] * g0 * rs, acc[ai][bj][m][1] * g1 * rs); } }
            return false;
        }
        int mode; bf16* dst; int c0;
        if (pn < T_QD) { mode = 1; dst = (bf16*)(wsp(ws, WS_ZA)); c0 = (pn - T_ZA) * 256; }
        else if (pn < T_ZB) { mode = 0; dst = (bf16*)(wsp(ws, WS_VD)); c0 = (pn - T_VD) * 256; }
        else if (pn < T_GA) { mode = 1; dst = (bf16*)(wsp(ws, WS_ZB)); c0 = (pn - T_ZB) * 256; }
        else if (pn < T_GB) { mode = 2; dst = (bf16*)(wsp(ws, WS_SA)); c0 = (pn - T_GA) * 256; }
        else { mode = 2; dst = (bf16*)(wsp(ws, WS_SB)); c0 = (pn - T_GB) * 256; }
#pragma unroll
        for (int ai = 0; ai < 2; ++ai)
#pragma unroll
            for (int m = 0; m < 4; ++m) { const int row = row0 + ai * 128 + m * 16;
#pragma unroll
                for (int bj = 0; bj < 2; ++bj) { f32x4 a = acc[ai][bj][m][0], b = acc[ai][bj][m][1];
                    if (mode == 1) {
#pragma unroll
                        for (int e = 0; e < 4; ++e) { a[e] = silu_f(a[e]); b[e] = silu_f(b[e]); } }
                    else if (mode == 2) {
#pragma unroll
                        for (int e = 0; e < 4; ++e) { a[e] = sigm_f(a[e]); b[e] = sigm_f(b[e]); } }
                    *(u32x4*)(dst + (size_t)row * 2048 + c0 + bj * 128 + colw) = pack8(a, b); } }
        return false;
    }
};
struct SchedP1 {
    TileOrder T; const char* U; const char* Umeta; const char* W;
    __device__ __forceinline__ bool next(int i, Unit& u) const {
        int pm, pn; if (!T.tile(i, pm, pn)) return false;
        u.pm = pm; u.pn = pn; u.kind = 0;
        u.A = (pm < 32) ? U + (size_t)pm * 256 * 2048 * 2 : Umeta; u.B = W + (size_t)pn * 256 * 2048 * 2; return true;
    }
};

__device__ __forceinline__ float ssp_rs(const float* ssp, int row, int c0, int n, float invw) {
    float s = 0.f; for (int c = 0; c < n; ++c) s += ssp[(size_t)row * 16 + c0 + c]; return __builtin_amdgcn_rsqf(s * invw + EPS);
}
struct EpiP2Q {
    unsigned char* ws; const float* gq;
    __device__ __forceinline__ bool operator()(Acc& acc, const Unit& u, int wr, int wc, int fr, int fq, LAS unsigned char* lds) const {
        fr = opaque(fr); fq = opaque(fq);
        const int h = u.pn; const int row0 = u.pm * 256 + wr * 64 + fr; const int colw = wc * 32 + 8 * fq;
        const float* ssp = (const float*)(wsp(ws, WS_SSP));
#pragma unroll
        for (int ai = 0; ai < 2; ++ai)
#pragma unroll
            for (int m = 0; m < 4; ++m) { const float rs = ssp_rs(ssp, row0 + ai * 128 + m * 16, 0, 6, 1.f / 768.f);
#pragma unroll
                for (int bj = 0; bj < 2; ++bj) { acc[ai][bj][m][0] *= rs; acc[ai][bj][m][1] *= rs; }
                if (m & 1) asm volatile("" ::: "memory"); }
        float ss[2][4][2]; tile_half_ss(acc, lds, wr, wc, fr, fq, ss);
        bf16* dst = (bf16*)(wsp(ws, WS_QM));
        { const f32x4 g0 = *(const f32x4*)(gq + colw), g1 = *(const f32x4*)(gq + colw + 4);
#pragma unroll
          for (int ai = 0; ai < 2; ++ai)
#pragma unroll
            for (int m = 0; m < 4; ++m) { const int row = row0 + ai * 128 + m * 16;
                const float rs = __builtin_amdgcn_rsqf((ss[ai][m][0] + ss[ai][m][1]) * (1.f / 192.f) + EPS) * QS_MLA;
                *(u32x4*)(dst + (size_t)row * 3072 + h * 192 + colw) = pack8(acc[ai][0][m][0] * g0 * rs, acc[ai][0][m][1] * g1 * rs); } }
        if (wc < 2) {
            const int ib = opaque(16 * wc + 4 * fq);
            const f32x4 gr1 = *(const f32x4*)(gq + 128 + ib), gr2 = *(const f32x4*)(gq + 160 + ib);
            const float* ctab = (const float*)(wsp(ws, WS_TAB) + TAB_COS); const float* stab = (const float*)(wsp(ws, WS_TAB) + TAB_SIN);
#pragma unroll
            for (int ai = 0; ai < 2; ++ai)
#pragma unroll
                for (int m = 0; m < 4; ++m) { const int row = row0 + ai * 128 + m * 16;
                    const float rs = __builtin_amdgcn_rsqf((ss[ai][m][0] + ss[ai][m][1]) * (1.f / 192.f) + EPS) * QS_MLA;
                    const int pos = NMETA + (row & (SEQ - 1));
                    const f32x4 c = *(const f32x4*)(ctab + pos * 32 + ib), sn = *(const f32x4*)(stab + pos * 32 + ib);
                    const f32x4 x1 = acc[ai][1][m][0] * gr1 * rs, x2 = acc[ai][1][m][1] * gr2 * rs;
                    *(u32x4*)(dst + (size_t)row * 3072 + h * 192 + 128 + colw) = pack8(x1 * c - x2 * sn, x2 * c + x1 * sn);
                    asm volatile("" ::: "memory"); }
        }
        return false;
    }
};
struct SchedP2Q {
    TileOrder T; const char* CQ; const char* W;
    __device__ __forceinline__ bool next(int i, Unit& u) const {
        int pm, pn; if (!T.tile(i, pm, pn)) return false;
        u.pm = pm; u.pn = pn; u.kind = 0; u.A = CQ + (size_t)pm * 256 * 768 * 2; u.B = W + (size_t)pn * 256 * 768 * 2; return true;
    }
};
struct EpiP2KV {
    unsigned char* ws; const float* gk;
    __device__ __forceinline__ bool operator()(Acc& acc, const Unit& u, int wr, int wc, int fr, int fq, LAS unsigned char* lds) const {
        fr = opaque(fr); fq = opaque(fq);
        const int h = u.pn; const int row0 = u.pm * 256 + wr * 64 + fr; const int colw = wc * 32 + 8 * fq;
        const float* ssp = (const float*)(wsp(ws, WS_SSP));
#pragma unroll
        for (int ai = 0; ai < 2; ++ai)
#pragma unroll
            for (int m = 0; m < 4; ++m) { const float rs = ssp_rs(ssp, row0 + ai * 128 + m * 16, 6, 4, 1.f / 512.f);
#pragma unroll
                for (int bj = 0; bj < 2; ++bj) { acc[ai][bj][m][0] *= rs; acc[ai][bj][m][1] *= rs; }
                if (m & 1) asm volatile("" ::: "memory"); }
        const int tid = opaque(threadIdx.x), rr = tid >> 1, hf = tid & 1; const int rrow = u.pm * 256 + rr;
        const bf16* kr = (const bf16*)(wsp(ws, WS_KR)) + (size_t)rrow * 64 + hf * 32;
        u32x4 kv[4]; float sr = 0.f;
#pragma unroll
        for (int j = 0; j < 4; ++j) { kv[j] = *(const u32x4*)(kr + j * 8);
#pragma unroll
            for (int e = 0; e < 4; ++e) { const float a = bflo(kv[j][e]), b = bfhi(kv[j][e]); sr += a * a + b * b; } }
        sr += __shfl_xor(sr, 1);
        LAS float* X2 = (LAS float*)(lds + LDS_X2);
        if (hf == 0) X2[rr] = sr;
        float ss[2][4][2]; tile_half_ss(acc, lds, wr, wc, fr, fq, ss);
        const f32x4 g0 = *(const f32x4*)(gk + colw), g1 = *(const f32x4*)(gk + colw + 4);
        bf16* kdst = (bf16*)(wsp(ws, WS_KM)); bf16* vdst = (bf16*)(wsp(ws, WS_VM));
#pragma unroll
        for (int ai = 0; ai < 2; ++ai)
#pragma unroll
            for (int m = 0; m < 4; ++m) { const int trow = ai * 128 + wr * 64 + m * 16 + fr; const int row = u.pm * 256 + trow;
                const float rs = __builtin_amdgcn_rsqf((ss[ai][m][0] + X2[trow]) * (1.f / 192.f) + EPS);
                *(u32x4*)(kdst + (size_t)row * 3072 + h * 192 + colw) = pack8(acc[ai][0][m][0] * g0 * rs, acc[ai][0][m][1] * g1 * rs);
                *(u32x4*)(vdst + (size_t)row * 2048 + h * 128 + colw) = pack8(acc[ai][1][m][0], acc[ai][1][m][1]); }
        { const LAS float* X = (const LAS float*)(lds + LDS_X); const f32x4 pv = *(const LAS f32x4*)(X + (rr * 2 + 0) * 4);
          const float rs = __builtin_amdgcn_rsqf(((pv[0] + pv[1]) + (pv[2] + pv[3]) + sr) * (1.f / 192.f) + EPS);
          const int pos = (u.pm < 32) ? NMETA + (rrow & (SEQ - 1)) : (rr < NMETA ? rr : 0);
          const float* ctab = (const float*)(wsp(ws, WS_TAB) + TAB_COS) + pos * 32; const float* stab = (const float*)(wsp(ws, WS_TAB) + TAB_SIN) + pos * 32;
#pragma unroll
          for (int j = 0; j < 4; ++j) { const int g = hf * 4 + j; const int i0 = 4 * g;
              const f32x4 c = *(const f32x4*)(ctab + i0), s = *(const f32x4*)(stab + i0), gg1 = *(const f32x4*)(gk + 128 + i0), gg2 = *(const f32x4*)(gk + 160 + i0);
              f32x4 x1 = {bflo(kv[j][0]), bfhi(kv[j][0]), bflo(kv[j][1]), bfhi(kv[j][1])}, x2 = {bflo(kv[j][2]), bfhi(kv[j][2]), bflo(kv[j][3]), bfhi(kv[j][3])};
              x1 = x1 * gg1 * rs; x2 = x2 * gg2 * rs;
              *(u32x4*)(kdst + (size_t)rrow * 3072 + h * 192 + 128 + g * 8) = pack8(x1 * c - x2 * s, x2 * c + x1 * s); } }
        return false;
    }
};
struct SchedP2KV {
    TileOrder T; const char* CKV; const char* W;
    __device__ __forceinline__ bool next(int i, Unit& u) const {
        int pm, pn; if (!T.tile(i, pm, pn)) return false;
        u.pm = pm; u.pn = pn; u.kind = 0; u.A = CKV + (size_t)pm * 256 * 512 * 2; u.B = W + (size_t)pn * 256 * 512 * 2; return true;
    }
};

struct EpiP4 {
    unsigned char* ws; int dbg;
    __device__ __forceinline__ bool operator()(Acc& acc, const Unit& u, int wr, int wc, int fr, int fq, LAS unsigned char* lds) const {
        fr = opaque(fr); fq = opaque(fq);
        const int row0 = u.pm * 256 + wr * 64 + fr; const int col0 = u.pn * 256 + wc * 32 + 8 * fq;
        const bf16* sa = (const bf16*)(wsp(ws, WS_SA)); const bf16* sb = (const bf16*)(wsp(ws, WS_SB)); bf16* mb = (bf16*)(wsp(ws, WS_MB));
#pragma unroll
        for (int ai = 0; ai < 2; ++ai)
#pragma unroll
            for (int m = 0; m < 4; ++m) { const int row = row0 + ai * 128 + m * 16;
#pragma unroll
                for (int bj = 0; bj < 2; ++bj) { const size_t off = (size_t)row * 2048 + col0 + bj * 128;
                    const u32x4 b = *(const u32x4*)(sb + off);
                    const f32x4 b0 = {bflo(b[0]), bfhi(b[0]), bflo(b[1]), bfhi(b[1])}, b1 = {bflo(b[2]), bfhi(b[2]), bflo(b[3]), bfhi(b[3])};
                    if (u.kind == 0) { const u32x4 a = *(const u32x4*)(sa + off);
                        const f32x4 a0 = {bflo(a[0]), bfhi(a[0]), bflo(a[1]), bfhi(a[1])}, a1 = {bflo(a[2]), bfhi(a[2]), bflo(a[3]), bfhi(a[3])};
                        if (dbg == 1) { *(u32x4*)(mb + off) = pack8(acc[ai][bj][m][0] * a0, acc[ai][bj][m][1] * a1); } else {
#pragma unroll
                        for (int e = 0; e < 4; ++e) { acc[ai][bj][m][0][e] *= a0[e] * __builtin_amdgcn_rcpf(b0[e]); acc[ai][bj][m][1][e] *= a1[e] * __builtin_amdgcn_rcpf(b1[e]); } } }
                    else *(u32x4*)(mb + off) = pack8(acc[ai][bj][m][0] * b0, acc[ai][bj][m][1] * b1); } }
        return u.kind == 0 && dbg != 1;
    }
};
struct SchedP4 {
    TileOrder T; const char* OA; const char* OB; const char* WA; const char* WB; int dbg;
    __device__ __forceinline__ bool next(int i, Unit& u) const {
        int pm, pn; const int ti = dbg ? i : (i >> 1), kd = dbg ? (dbg - 1) : (i & 1);
        if (!T.tile(ti, pm, pn)) return false;
        u.pm = pm; u.pn = pn; u.kind = kd;
        u.A = (kd ? OB : OA) + (size_t)pm * 256 * 2048 * 2; u.B = (kd ? WB : WA) + (size_t)pn * 256 * 2048 * 2; return true;
    }
};
struct EpiP5 {
    const float* x; float* out;
    __device__ __forceinline__ bool operator()(Acc& acc, const Unit& u, int wr, int wc, int fr, int fq, LAS unsigned char* lds) const {
        fr = opaque(fr); fq = opaque(fq);
        const int row0 = u.pm * 256 + wr * 64 + fr; const int col0 = u.pn * 256 + wc * 32 + 8 * fq;
#pragma unroll
        for (int ai = 0; ai < 2; ++ai)
#pragma unroll
            for (int m = 0; m < 4; ++m) { const int row = row0 + ai * 128 + m * 16;
#pragma unroll
                for (int bj = 0; bj < 2; ++bj) { const size_t off = (size_t)row * 2048 + col0 + bj * 128;
                    const f32x4 x0 = *(const f32x4*)(x + off), x1 = *(const f32x4*)(x + off + 4);
                    *(f32x4*)(out + off) = x0 + acc[ai][bj][m][0]; *(f32x4*)(out + off + 4) = x1 + acc[ai][bj][m][1]; } }
        return false;
    }
};
struct SchedP5 {
    TileOrder T; const char* MB; const char* WO;
    __device__ __forceinline__ bool next(int i, Unit& u) const {
        int pm, pn; if (!T.tile(i, pm, pn)) return false;
        u.pm = pm; u.pn = pn; u.kind = 0; u.A = MB + (size_t)pm * 256 * 2048 * 2; u.B = WO + (size_t)pn * 256 * 2048 * 2; return true;
    }
};

constexpr float NEGBIG = -1e30f;
constexpr float THR_L2 = 8.f * LOG2E;
template <int NCB> __device__ __forceinline__ int v_st(int k, int c) { const int kk = (k & ~0xC) | ((k & 4) << 1) | ((k & 8) >> 1); return ((kk >> 3) * NCB + (c >> 5)) * 512 + ((kk & 7) * 32 + (c & 31)) * 2; }
__device__ __forceinline__ int v_rd_base(int lane) { return ((lane & 3) << 3) | (((lane >> 2) & 3) << 6) | (((lane >> 4) & 1) << 5) | (((lane >> 5) & 1) << 8); }
template <int OFF> __device__ __forceinline__ s16x4 tr_read(int vb) { s16x4 r; asm volatile("ds_read_b64_tr_b16 %0, %1 offset:%2" : "=&v"(r) : "v"(vb), "i"(OFF) : "memory"); return r; }
template <int D0, int NCB> __device__ __forceinline__ void pv_one(f32x16& od, int vb, bf16x8 pa0, bf16x8 pa1, bf16x8 pa2, bf16x8 pa3) {
    constexpr int KS = NCB * 1024, HF = NCB * 512;
    const s16x4 l0 = tr_read<D0 * 512 + 0 * KS>(vb), h0 = tr_read<D0 * 512 + 0 * KS + HF>(vb), l1 = tr_read<D0 * 512 + 1 * KS>(vb), h1 = tr_read<D0 * 512 + 1 * KS + HF>(vb);
    const s16x4 l2 = tr_read<D0 * 512 + 2 * KS>(vb), h2 = tr_read<D0 * 512 + 2 * KS + HF>(vb), l3 = tr_read<D0 * 512 + 3 * KS>(vb), h3 = tr_read<D0 * 512 + 3 * KS + HF>(vb);
    asm volatile("s_waitcnt lgkmcnt(0)" ::: "memory"); SBAR();
#define PK(L, H) (bf16x8){L[0], L[1], L[2], L[3], H[0], H[1], H[2], H[3]}
    od = __builtin_amdgcn_mfma_f32_32x32x16_bf16(pa0, PK(l0, h0), od, 0, 0, 0);
    od = __builtin_amdgcn_mfma_f32_32x32x16_bf16(pa1, PK(l1, h1), od, 0, 0, 0);
    od = __builtin_amdgcn_mfma_f32_32x32x16_bf16(pa2, PK(l2, h2), od, 0, 0, 0);
    od = __builtin_amdgcn_mfma_f32_32x32x16_bf16(pa3, PK(l3, h3), od, 0, 0, 0);
#undef PK
}
template <int DV> struct PV;
template <> struct PV<128> { static __device__ __forceinline__ void run(f32x16* o, int vb, bf16x8 a, bf16x8 b, bf16x8 c, bf16x8 d) {
    pv_one<0, 4>(o[0], vb, a, b, c, d); pv_one<1, 4>(o[1], vb, a, b, c, d); pv_one<2, 4>(o[2], vb, a, b, c, d); pv_one<3, 4>(o[3], vb, a, b, c, d); } };

template <int DQK, int DV, bool BIAS>
__device__ __forceinline__ void attn_pass(f32x16 (&o)[DV / 32], float& l_out, const bf16* __restrict__ Q, int ldq, const bf16* __restrict__ Kr, const bf16* __restrict__ Km, int ldk,
                                          const bf16* __restrict__ Vr, const bf16* __restrict__ Vm, int ldv, int q0, LAS unsigned char* ldsb) {
    constexpr int CPRK = DQK / 8, NKP = 64 * DQK * 2 / 8192, NVP = 64 * DV * 2 / 8192, KB = 64 * DQK * 2, VB = 64 * DV * 2, ND0 = DV / 32, NQ = DQK / 16, NCB = DV / 32;
    constexpr int GS = 2, NG = NQ / GS;
    const int tid = opaque(threadIdx.x), lane = tid & 63, r32 = lane & 31, hi = lane >> 5; const int wid = __builtin_amdgcn_readfirstlane(tid >> 6);
    char* lds = (char*)ldsb;
    char* K_lds = lds; char* V_lds = lds + 2 * KB;
    float* wsc = (float*)(lds + LDS_WSC) + wid * 64; float* al_l = wsc + 32;
    const float* btab = (const float*)(lds + LDS_BT);
    const int qw0 = q0 + wid * 32;
    bf16x8 qr[NQ];
    { const bf16* Qw = Q + (size_t)(wid * 32 + r32) * ldq + hi * 8;
#pragma unroll
      for (int d0 = 0; d0 < NQ; ++d0) qr[d0] = *(const bf16x8*)(Qw + d0 * 16); }
    const int vb0 = (int)(uintptr_t)V_lds + v_rd_base(lane);
    unsigned ksrc[NKP], vsrc[NVP];
#pragma unroll
    for (int j = 0; j < NKP; ++j) { const int off = 8192 * j + 16 * tid, row = off / (DQK * 2), cpos = (off % (DQK * 2)) >> 4; ksrc[j] = (unsigned)(row * ldk + ((cpos ^ (row & 7)) << 3)); }
#pragma unroll
    for (int j = 0; j < NVP; ++j) { const int off = 8192 * j + 16 * tid, st = off >> 9, kk = (st / NCB) * 8 + ((off & 511) >> 6), c = (st % NCB) * 32 + ((off & 63) >> 1);
        const int k = (kk & ~0xC) | ((kk & 4) << 1) | ((kk & 8) >> 1); vsrc[j] = (unsigned)(k * ldv + c); }
    const unsigned ldsw = (unsigned)wid * 1024u;
#define DMA(t, b) do { const bf16* kp = (t) == 0 ? Km : Kr + (size_t)((t) - 1) * 64 * ldk; const bf16* vp = (t) == 0 ? Vm : Vr + (size_t)((t) - 1) * 64 * ldv; \
        _Pragma("unroll") for (int j = 0; j < NKP; ++j) __builtin_amdgcn_global_load_lds((const unsigned*)(kp + ksrc[j]), (LAS unsigned*)(ldsb + (b) * KB + 8192 * j + ldsw), 16, 0, 0); \
        _Pragma("unroll") for (int j = 0; j < NVP; ++j) __builtin_amdgcn_global_load_lds((const unsigned*)(vp + vsrc[j]), (LAS unsigned*)(ldsb + 2 * KB + (b) * VB + 8192 * j + ldsw), 16, 0, 0); } while (0)
    float m_reg = NEGBIG, l_reg = 0.f;
#pragma unroll
    for (int d = 0; d < ND0; ++d) o[d] = (f32x16){0.f, 0.f, 0.f, 0.f, 0.f, 0.f, 0.f, 0.f, 0.f, 0.f, 0.f, 0.f, 0.f, 0.f, 0.f, 0.f};
#define PK4(P, BASE, OUT) do { unsigned a0 = cvtpk(P[BASE + 0], P[BASE + 1]), a1 = cvtpk(P[BASE + 2], P[BASE + 3]), b0_ = cvtpk(P[BASE + 4], P[BASE + 5]), b1_ = cvtpk(P[BASE + 6], P[BASE + 7]); \
        auto r0 = __builtin_amdgcn_permlane32_swap(a0, b0_, false, false); auto r1 = __builtin_amdgcn_permlane32_swap(a1, b1_, false, false); \
        u32x4 w = {r0[0], r1[0], r0[1], r1[1]}; OUT = __builtin_bit_cast(bf16x8, w); } while (0)
#define LOADK(KF, G_) do { _Pragma("unroll") for (int s_ = 0; s_ < GS; ++s_) { const int cb = (((G_) * GS + s_) * 16 + hi * 8) * 2; \
        KF[2 * s_] = *(const bf16x8*)(Kb + r32 * (DQK * 2) + (cb ^ ((r32 & 7) << 4))); KF[2 * s_ + 1] = *(const bf16x8*)(Kb + (32 + r32) * (DQK * 2) + (cb ^ ((r32 & 7) << 4))); } } while (0)
#define MMAK(KF, G_) do { _Pragma("unroll") for (int s_ = 0; s_ < GS; ++s_) { \
        p0 = __builtin_amdgcn_mfma_f32_32x32x16_bf16(KF[2 * s_], qr[(G_) * GS + s_], p0, 0, 0, 0); p1 = __builtin_amdgcn_mfma_f32_32x32x16_bf16(KF[2 * s_ + 1], qr[(G_) * GS + s_], p1, 0, 0, 0); } } while (0)
#define STEP(META_, TR_, B_) do { \
        f32x16 p0, p1; \
        if (META_) { \
            _Pragma("unroll") for (int r = 0; r < 16; ++r) { p1[r] = NEGBIG; \
                if (r < 8) { if (BIAS) { int idx = crow(r, hi) - NMETA - (qw0 + r32) + 128; idx = idx < 0 ? 0 : idx; p0[r] = btab[idx]; } else p0[r] = 0.f; } \
                else p0[r] = NEGBIG; } \
        } else if (BIAS) { \
            const int d = 64 * (TR_) - qw0; \
            if (d <= -154 || d >= 122) { const float bv = btab[d < 0 ? 0 : 256]; \
                _Pragma("unroll") for (int r = 0; r < 16; ++r) { p0[r] = bv; p1[r] = bv; } } \
            else { \
                _Pragma("unroll") for (int r = 0; r < 16; ++r) { int i0 = d + crow(r, hi) - r32 + 128, i1 = i0 + 32; \
                    i0 = i0 < 0 ? 0 : (i0 > 256 ? 256 : i0); i1 = i1 < 0 ? 0 : (i1 > 256 ? 256 : i1); p0[r] = btab[i0]; p1[r] = btab[i1]; } } \
        } else { \
            _Pragma("unroll") for (int r = 0; r < 16; ++r) { p0[r] = 0.f; p1[r] = 0.f; } \
        } \
        { const char* Kb = K_lds + (B_) * KB; bf16x8 kfa[2 * GS], kfb[2 * GS]; \
          LOADK(kfa, 0); \
          _Pragma("unroll") for (int g = 0; g < NG; g += 2) { \
              SBAR(); if (g + 1 < NG) LOADK(kfb, g + 1); MMAK(kfa, g); \
              SBAR(); if (g + 2 < NG) LOADK(kfa, g + 2); if (g + 1 < NG) MMAK(kfb, g + 1); } } \
        float pmax = p0[0]; \
        _Pragma("unroll") for (int r = 1; r < 16; ++r) pmax = fmaxf(pmax, p0[r]); \
        _Pragma("unroll") for (int r = 0; r < 16; ++r) pmax = fmaxf(pmax, p1[r]); \
        { auto rr = __builtin_amdgcn_permlane32_swap(__float_as_uint(pmax), __float_as_uint(pmax), false, false); pmax = fmaxf(__uint_as_float(rr[0]), __uint_as_float(rr[1])); } \
        float alpha = 1.f; \
        if (!__all(pmax - m_reg <= THR_L2)) { const float mn = fmaxf(m_reg, pmax); alpha = __builtin_amdgcn_exp2f(m_reg - mn); m_reg = mn; \
            if (hi == 0) al_l[r32] = alpha; asm volatile("s_waitcnt lgkmcnt(0)" ::: "memory"); \
            _Pragma("unroll") for (int d = 0; d < ND0; ++d) \
                _Pragma("unroll") for (int r = 0; r < 16; ++r) o[d][r] *= al_l[crow(r, hi)]; } \
        float ps = 0.f; \
        _Pragma("unroll") for (int r = 0; r < 16; ++r) { p0[r] = __builtin_amdgcn_exp2f(p0[r] - m_reg); ps += p0[r]; } \
        _Pragma("unroll") for (int r = 0; r < 16; ++r) { p1[r] = __builtin_amdgcn_exp2f(p1[r] - m_reg); ps += p1[r]; } \
        { auto rr = __builtin_amdgcn_permlane32_swap(__float_as_uint(ps), __float_as_uint(ps), false, false); ps = __uint_as_float(rr[0]) + __uint_as_float(rr[1]); } \
        l_reg = l_reg * alpha + ps; \
        bf16x8 pa0, pa1, pa2, pa3; \
        PK4(p0, 0, pa0); PK4(p0, 8, pa1); PK4(p1, 0, pa2); PK4(p1, 8, pa3); \
        SBAR(); \
        PV<DV>::run(o, vb0 + (B_) * VB, pa0, pa1, pa2, pa3); } while (0)
#define XSTEP(META_, TR_, B_) STEP(META_, TR_, B_)
    DMA(0, 0); __syncthreads();
    DMA(1, 1); XSTEP(true, 0, 0); __syncthreads();
#pragma unroll 1
    for (int t = 1; t < 33; t += 2) {
        DMA(t + 1, 0); XSTEP(false, t - 1, 1); __syncthreads();
        if (t + 2 < 33) DMA(t + 2, 1);
        XSTEP(false, t, 0); __syncthreads();
    }
#undef XSTEP
#undef STEP
#undef PK4
#undef LOADK
#undef MMAK
#undef DMA
    l_out = l_reg;
}

__device__ __forceinline__ void mla_unit(unsigned char* ws, int bl, int h, int qb, LAS unsigned char* ldsb, bool nostore = false) {
    const int tid = opaque(threadIdx.x); int lane = tid & 63, r32 = lane & 31, hi = lane >> 5; const int wid = __builtin_amdgcn_readfirstlane(tid >> 6);
    char* lds = (char*)ldsb; float* wsc = (float*)(lds + LDS_WSC) + wid * 64;
    const size_t rb = (size_t)bl * SEQ; const int q0 = qb * 256;
    const bf16* QM = (const bf16*)(wsp(ws, WS_QM)); const bf16* KM = (const bf16*)(wsp(ws, WS_KM)); const bf16* VM = (const bf16*)(wsp(ws, WS_VM));
    f32x16 o[4]; float l;
    attn_pass<192, 128, false>(o, l, QM + (rb + q0) * 3072 + h * 192, 3072, KM + rb * 3072 + h * 192, KM + (size_t)MH * 3072 + h * 192, 3072,
                               VM + rb * 2048 + h * 128, VM + (size_t)MH * 2048 + h * 128, 2048, q0, ldsb);
    lane = opaque(lane); r32 = lane & 31; hi = lane >> 5;
    if (hi == 0) wsc[r32] = l; LDS_WAIT();
    bf16* stg = (bf16*)(lds + wid * 8192);
#pragma unroll
    for (int r = 0; r < 16; ++r) { const float rl = __builtin_amdgcn_rcpf(wsc[crow(r, hi)]); const int orow = crow(r, hi);
#pragma unroll
        for (int d0 = 0; d0 < 4; ++d0) { const unsigned w = cvtpk(o[d0][r] * rl, 0.f); stg[orow * 128 + d0 * 32 + r32] = (bf16)(w & 0xffffu); } }
    LDS_WAIT();
    bf16* zp = (bf16*)(wsp(ws, WS_ZA)) + (rb + q0 + wid * 32 + (lane >> 4)) * 2048 + h * 128 + (lane & 15) * 8; const bf16* sp = stg + (lane >> 4) * 128 + (lane & 15) * 8;
#pragma unroll
    for (int i = 0; i < 8; ++i, zp += 4 * 2048, sp += 4 * 128) { asm volatile("" : "+v"(zp));
        const u32x4 s = *(const u32x4*)sp; const u32x4 z = *(const u32x4*)zp; u32x4 w;
#pragma unroll
        for (int e = 0; e < 4; ++e) w[e] = cvtpk(bflo(s[e]) * bflo(z[e]), bfhi(s[e]) * bfhi(z[e]));
        if (!nostore) *(u32x4*)zp = w; }
    __syncthreads();
}
__device__ __forceinline__ void diff_unit(unsigned char* ws, float* o1s, const float* subln, int bl, int h, int qb, LAS unsigned char* ldsb, bool nostore = false) {
    const int tid = opaque(threadIdx.x); int lane = tid & 63, r32 = lane & 31, hi = lane >> 5; const int wid = __builtin_amdgcn_readfirstlane(tid >> 6);
    char* lds = (char*)ldsb; float* wsc = (float*)(lds + LDS_WSC) + wid * 64; float* wss = (float*)(lds + LDS_WSS) + wid * 32;
    const size_t rb = (size_t)bl * SEQ; const int q0 = qb * 256;
    const bf16* QD = (const bf16*)(wsp(ws, WS_QD)); const bf16* KD = (const bf16*)(wsp(ws, WS_KD)); const bf16* VD = (const bf16*)(wsp(ws, WS_VD));
    { float* bt = (float*)(lds + LDS_BT); const float* src = (const float*)(wsp(ws, WS_TAB) + TAB_BIAS) + h * 260; for (int i = tid; i < 257; i += NTHREADS) bt[i] = src[i]; }
    __syncthreads();
    const float lam = *(const float*)(wsp(ws, WS_TAB) + TAB_LAM);
#pragma unroll 1
    for (int pass = 0; pass < 4; ++pass) {
        const int mp = pass >> 1, vh = pass & 1;
        f32x16 o[4]; float l;
        attn_pass<128, 128, true>(o, l, QD + (rb + q0) * 2048 + h * 256 + mp * 128, 2048, KD + rb * 2048 + h * 256 + mp * 128, KD + (size_t)MH * 2048 + h * 256 + mp * 128, 2048,
                                  VD + rb * 2048 + h * 256 + vh * 128, VD + (size_t)MH * 2048 + h * 256 + vh * 128, 2048, q0, ldsb);
        lane = opaque(lane); r32 = lane & 31; hi = lane >> 5;
        if (hi == 0) wsc[r32] = l; LDS_WAIT();
        GF* st = (GF*)o1s + ((size_t)blockIdx.x * 8 + wid) * (32 * 256) + vh * 128 + r32;
        if (mp == 0) {
#pragma unroll
            for (int r = 0; r < 16; ++r) { const float rl = __builtin_amdgcn_rcpf(wsc[crow(r, hi)]); GF* sp = st + crow(r, hi) * 256;
#pragma unroll
                for (int d0 = 0; d0 < 4; ++d0) sp[d0 * 32] = o[d0][r] * rl; }
        } else {
#pragma unroll
            for (int r = 0; r < 16; ++r) { const float rl = __builtin_amdgcn_rcpf(wsc[crow(r, hi)]); GF* sp = st + crow(r, hi) * 256; float sq = 0.f;
#pragma unroll
                for (int d0 = 0; d0 < 4; ++d0) { const float y = sp[d0 * 32] - lam * (o[d0][r] * rl); sp[d0 * 32] = y; sq += y * y; }
                sq += __shfl_xor(sq, 1); sq += __shfl_xor(sq, 2); sq += __shfl_xor(sq, 4); sq += __shfl_xor(sq, 8); sq += __shfl_xor(sq, 16);
                if (r32 == 0) { if (vh == 0) wss[crow(r, hi)] = sq; else wss[crow(r, hi)] += sq; } }
        }
        asm volatile("s_waitcnt vmcnt(0) lgkmcnt(0)" ::: "memory");
    }
    { const GF* yp = (const GF*)o1s + ((size_t)blockIdx.x * 8 + wid) * (32 * 256) + (lane >> 5) * 256 + (lane & 31) * 8;
      bf16* zp = (bf16*)(wsp(ws, WS_ZB)) + (rb + q0 + wid * 32 + (lane >> 5)) * 2048 + h * 256 + (lane & 31) * 8;
      const f32x4 g0 = *(const f32x4*)(subln + (lane & 31) * 8), g1 = *(const f32x4*)(subln + (lane & 31) * 8 + 4);
#pragma unroll 4
      for (int i = 0; i < 16; ++i, zp += 2 * 2048, yp += 2 * 256) {
          const float rsn = __builtin_amdgcn_rsqf(wss[2 * i + (lane >> 5)] * (1.f / 256.f) + EPS) * 0.8f;
          const f32x4 y0 = *(const __attribute__((address_space(1))) f32x4*)yp, y1 = *(const __attribute__((address_space(1))) f32x4*)(yp + 4); const u32x4 z = *(const u32x4*)zp; u32x4 w;
          w[0] = cvtpk(y0[0] * rsn * g0[0] * bflo(z[0]), y0[1] * rsn * g0[1] * bfhi(z[0])); w[1] = cvtpk(y0[2] * rsn * g0[2] * bflo(z[1]), y0[3] * rsn * g0[3] * bfhi(z[1]));
          w[2] = cvtpk(y1[0] * rsn * g1[0] * bflo(z[2]), y1[1] * rsn * g1[1] * bfhi(z[2])); w[3] = cvtpk(y1[2] * rsn * g1[2] * bflo(z[3]), y1[3] * rsn * g1[3] * bfhi(z[3]));
          if (!nostore) *(u32x4*)zp = w; } }
    __syncthreads();
}

template <class Map>
__device__ __forceinline__ void transpose_item(const float* __restrict__ W, int Nsrc, int K, bf16* __restrict__ WT, LAS float* scr, int item, int lane, const float* __restrict__ gain, Map map) {
    const int nkb = K / 64, nb = item / nkb, kb = item % nkb, k0 = 64 * kb, n0 = 32 * nb;
    const int sc = map(n0 + (lane & 31));
#pragma unroll 8
    for (int i = 0; i < 32; ++i) { const int kk = 2 * i + (lane >> 5); float v = (sc >= 0) ? W[(size_t)(k0 + kk) * Nsrc + sc] : 0.f; if (gain) v *= gain[k0 + kk]; scr[kk * 33 + (lane & 31)] = v; }
    LDS_WAIT(); asm volatile("" ::: "memory");
    const int c = lane & 7;
#pragma unroll
    for (int j = 0; j < 4; ++j) { const int n = (lane >> 3) + 8 * j; const LAS float* s = scr + (8 * c) * 33 + n;
        u32x4 o; o.x = cvtpk(s[0 * 33], s[1 * 33]); o.y = cvtpk(s[2 * 33], s[3 * 33]); o.z = cvtpk(s[4 * 33], s[5 * 33]); o.w = cvtpk(s[6 * 33], s[7 * 33]);
        *(u32x4*)(WT + (size_t)(n0 + n) * K + k0 + 8 * c) = o; }
    LDS_WAIT(); asm volatile("" ::: "memory");
}
__device__ __forceinline__ int rope_orig(int c) { return 32 * ((c >> 2) & 1) + 4 * (c >> 3) + (c & 3); }
struct MapWin { __device__ int operator()(int n) const { if (n < 1280) return n; if (n < 1536) { const int c = n - 1280; return c < 64 ? 1280 + rope_orig(c) : -1; } return n - 192; } };
struct MapWuq { __device__ int operator()(int n) const { const int h = n >> 8, c = n & 255; if (c < 128) return h * 192 + c; if (c < 192) return h * 192 + 128 + rope_orig(c - 128); return -1; } };
struct MapId { __device__ int operator()(int n) const { return n; } };

__device__ __forceinline__ int t5_bucket(int rel) {
    const int n = rel < 0 ? -rel : rel; int b;
    if (n < 8) b = n; else b = 8 + (n >= 12) + (n >= 16) + (n >= 23) + (n >= 32) + (n >= 46) + (n >= 64) + (n >= 91);
    return b + (rel > 0 ? 16 : 0);
}
__device__ __forceinline__ void rms_row_bf16(const float* __restrict__ xrow, const float* __restrict__ g, bf16* __restrict__ orow, int lane) {
    u32x2* o8 = (u32x2*)orow + lane;
    if (!xrow) {
#pragma unroll
        for (int j = 0; j < 8; ++j) o8[64 * j] = (u32x2){0u, 0u};
        return; }
    const f32x4* xr = (const f32x4*)xrow + lane; const f32x4* gr = (const f32x4*)g + lane;
    f32x4 v[8]; float s = 0.f;
#pragma unroll
    for (int j = 0; j < 8; ++j) { v[j] = xr[64 * j]; s += (v[j][0] * v[j][0] + v[j][1] * v[j][1]) + (v[j][2] * v[j][2] + v[j][3] * v[j][3]); }
    const float rs = __builtin_amdgcn_rsqf(wave_sum(s) * (1.f / 2048.f) + EPS);
#pragma unroll
    for (int j = 0; j < 8; ++j) { const f32x4 gg = gr[64 * j]; const f32x4 y = v[j] * rs * gg; o8[64 * j] = (u32x2){cvtpk(y[0], y[1]), cvtpk(y[2], y[3])}; }
}
__device__ __forceinline__ void p0_prologue(LAS unsigned char* ldsb, int vcu, int G) {
    const int tid = opaque(threadIdx.x), lane = tid & 63; const int wave = __builtin_amdgcn_readfirstlane(tid >> 6);
    LAS float* scr = (LAS float*)(ldsb + wave * 16384);
    const int gw = vcu * NWAVES + wave, NGW = G * NWAVES;
    unsigned char* ws = kws();
    constexpr int I_WIN = (NIN / 32) * 32, I_WUQ = 128 * 12, I_WUKV = 128 * 8, I_SQ = 64 * 32;
    constexpr int NITEMS = I_WIN + I_WUQ + I_WUKV + 3 * I_SQ;
    for (int it = gw; it < NITEMS; it += NGW) {
        int r = it;
        if (r < I_WIN) { transpose_item(kin(4), INW, 2048, (bf16*)(wsp(ws, WS_WIN)), scr, r, lane, nullptr, MapWin()); continue; } r -= I_WIN;
        if (r < I_WUQ) { transpose_item(kin(7), 3072, 768, (bf16*)(wsp(ws, WS_WUQ)), scr, r, lane, kin(5), MapWuq()); continue; } r -= I_WUQ;
        if (r < I_WUKV) { transpose_item(kin(8), 4096, 512, (bf16*)(wsp(ws, WS_WUKV)), scr, r, lane, kin(6), MapId()); continue; } r -= I_WUKV;
        if (r < I_SQ) { transpose_item(kin(15), 2048, 2048, (bf16*)(wsp(ws, WS_WA)), scr, r, lane, nullptr, MapId()); continue; } r -= I_SQ;
        if (r < I_SQ) { transpose_item(kin(16), 2048, 2048, (bf16*)(wsp(ws, WS_WB)), scr, r, lane, nullptr, MapId()); continue; } r -= I_SQ;
        transpose_item(kin(17), 2048, 2048, (bf16*)(wsp(ws, WS_WO)), scr, r, lane, nullptr, MapId());
    }
    bf16* ureal = (bf16*)((unsigned char*)kout() + (size_t)64 * 1024 * 1024); bf16* umeta = (bf16*)(wsp(ws, WS_UMETA));
    for (int m = gw; m < NBATCH * SEQ + 256; m += NGW) {
        if (m < NBATCH * SEQ) rms_row_bf16(kin(0) + (size_t)m * DM, kin(3), ureal + (size_t)m * DM, lane);
        else { const int j = m - NBATCH * SEQ; rms_row_bf16(j < NMETA ? kin(1) + (size_t)j * DM : nullptr, kin(3), umeta + (size_t)j * DM, lane); }
    }
    const int gt = vcu * NTHREADS + tid, NGT = G * NTHREADS;
    float* ctab = (float*)(wsp(ws, WS_TAB) + TAB_COS); float* stab = (float*)(wsp(ws, WS_TAB) + TAB_SIN); float* btab = (float*)(wsp(ws, WS_TAB) + TAB_BIAS);
    for (int i = gt; i < 2064 * 32; i += NGT) { const int pos = i >> 5, k = i & 31; const float inv = powf(10000.f, -(float)k / 32.f); const float ang = (float)pos * inv; ctab[i] = cosf(ang); stab[i] = sinf(ang); }
    for (int i = gt; i < 8 * 257; i += NGT) { const int h = i / 257, j = i % 257; btab[h * 260 + j] = kin(2)[t5_bucket(j - 128) * 8 + h] * LOG2E; }
    if (vcu == 0 && wave == 0) { const float* dl = kin(13);
        float a = dl[lane] * dl[128 + lane] + dl[64 + lane] * dl[192 + lane], b = dl[256 + lane] * dl[384 + lane] + dl[320 + lane] * dl[448 + lane];
        a = wave_sum(a); b = wave_sum(b); if (lane == 0) *(float*)(wsp(ws, WS_TAB) + TAB_LAM) = __expf(a) - __expf(b) + 0.2f; }
}

#ifndef MK_PH_LO
#define MK_PH_LO 0
#define MK_PH_HI 99
#endif
#ifndef MK_ONLY
#define MK_ON(n) 1
#else
#define MK_ON(n) (MK_ONLY == (n))
#endif
#ifndef MK_REPEAT
#define MK_REPEAT -1
#endif
#define MK_REP(n) ((MK_REPEAT == (n)) ? 2 : ((n) == 9 ? 0 : 1))
#define WSL() kws()
template <int half> __device__ __forceinline__ void run_half(LAS unsigned char* lds, const XcdBarrier& xb, int G, int bx, int vcu) {
        unsigned char* ws;
        for (int rep = 0; rep < MK_REP(1); ++rep) { ws = WSL(); if (MK_ON(1)) { SchedP1 S; S.T.init(33, 62, G, bx); S.U = (const char*)kout() + (size_t)64 * 1024 * 1024 + (size_t)half * MH * 2048 * 2; S.Umeta = (const char*)(wsp(ws, WS_UMETA)); S.W = (const char*)(wsp(ws, WS_WIN));
          EpiP1 E{ws, kin(11), kin(12)};
          gemm_phase(lds, 2048, 2048, 32, S, E); } }
        xcd_barrier(xb);
        for (int rep = 0; rep < MK_REP(2); ++rep) { ws = WSL(); if (MK_ON(2)) { SchedP2Q S; S.T.init(32, 16, G, bx); S.CQ = (const char*)(wsp(ws, WS_CQ)); S.W = (const char*)(wsp(ws, WS_WUQ)); EpiP2Q E{ws, kin(9)};
          gemm_phase(lds, 768, 768, 12, S, E); }
        ws = WSL(); if (MK_ON(3)) { SchedP2KV S; S.T.init(33, 16, G, bx); S.CKV = (const char*)(wsp(ws, WS_CKV)); S.W = (const char*)(wsp(ws, WS_WUKV)); EpiP2KV E{ws, kin(10)};
          gemm_phase(lds, 512, 512, 8, S, E); } }
        xcd_barrier(xb);
        for (int rep = 0; rep < MK_REP(3); ++rep) { const bool ns = (rep + 1 < MK_REP(3)); ws = WSL(); { const int x = vcu >> 5, v = vcu & 31;
          float* o1s = half == 0 ? kout() : (float*)(wsp(ws, WS_WIN));
          if (G == 256) {
              if (MK_ON(4)) for (int i = 0; i < 2; ++i) { const int pair = 8 * x + 4 * i + (v >> 3); mla_unit(ws, pair >> 4, pair & 15, v & 7, lds, ns); }
              if (MK_ON(5)) { const int pair = 4 * x + (v >> 3); diff_unit(ws, o1s, kin(14), pair >> 3, pair & 7, v & 7, lds, ns); }
          } else {
              if (MK_ON(4)) for (int uidx = bx; uidx < 512; uidx += G) mla_unit(ws, uidx >> 7, (uidx >> 3) & 15, uidx & 7, lds, ns);
              if (MK_ON(5)) for (int uidx = bx; uidx < 256; uidx += G) diff_unit(ws, o1s, kin(14), uidx >> 6, (uidx >> 3) & 7, uidx & 7, lds, ns);
          } } }
        xcd_barrier(xb);
        for (int rep = 0; rep < MK_REP(6); ++rep) { ws = WSL(); if (MK_ON(6)) { SchedP4 S; S.T.init(32, 8, G, bx); S.OA = (const char*)(wsp(ws, WS_ZA)); S.OB = (const char*)(wsp(ws, WS_ZB)); S.WA = (const char*)(wsp(ws, WS_WA)); S.WB = (const char*)(wsp(ws, WS_WB)); S.dbg = kdbg();
          EpiP4 E{ws, kdbg()}; gemm_phase(lds, 2048, 2048, 32, S, E); } }
        xcd_barrier(xb);
        for (int rep = 0; rep < MK_REP(7); ++rep) { ws = WSL(); if (MK_ON(7)) { SchedP5 S; S.T.init(32, 8, G, bx); S.MB = (const char*)(wsp(ws, WS_MB)); S.WO = (const char*)(wsp(ws, WS_WO));
          EpiP5 E{kin(0) + (size_t)half * MH * DM, kout() + (size_t)half * MH * DM}; gemm_phase(lds, 2048, 2048, 32, S, E); } }
    }
__global__ void __launch_bounds__(NTHREADS, 2) mega(Params p) {
    extern __shared__ __attribute__((aligned(16))) unsigned char lds_raw[];
    LAS unsigned char* lds = (LAS unsigned char*)lds_raw;
    cg::grid_group grid = cg::this_grid();
    const int G = gridDim.x, bx = blockIdx.x; const int vcu = (G % 8 == 0) ? (bx % 8) * (G / 8) + bx / 8 : bx;
    if (threadIdx.x < 2) ((LAS unsigned*)(lds + LDS_MISC))[threadIdx.x] = 0u;
    __syncthreads();
    const XcdBarrier xb = xcd_barrier_post((unsigned*)(kws() + WS_CTL) + 4096, (volatile LAS unsigned*)(lds + LDS_MISC));
    for (int rep = 0; rep < MK_REP(0); ++rep) { if (MK_ON(0)) p0_prologue(lds, vcu, G); }
    grid.sync();
    for (int rep = 0; rep < MK_REP(9); ++rep) xcd_barrier(xb);
    run_half<0>(lds, xb, G, bx, vcu);
    run_half<1>(lds, xb, G, bx, vcu);
}
}
extern "C" void kernel_launch(void* const* d_in, const int* in_sizes, int n_in, void* d_out, int out_size, void* d_ws, size_t ws_size, hipStream_t stream) {
    static int grid_blocks = 0;
    if (!grid_blocks) {
        int dev = 0, cus = 0, per_cu = 0;
        (void)hipGetDevice(&dev);
        (void)hipDeviceGetAttribute(&cus, hipDeviceAttributeMultiprocessorCount, dev);
        (void)hipFuncSetAttribute((const void*)mk::mega, hipFuncAttributeMaxDynamicSharedMemorySize, mk::LDS_BYTES);
        (void)hipOccupancyMaxActiveBlocksPerMultiprocessor(&per_cu, (const void*)mk::mega, mk::NTHREADS, mk::LDS_BYTES);
        if (per_cu < 1) per_cu = 1;
        grid_blocks = cus * per_cu;
        if (ws_size < mk::WS_CTL + mk::CTL_BYTES) { fprintf(stderr, "kernel_launch: workspace too small: %zu < %zu\n", ws_size, (size_t)mk::WS_END); grid_blocks = -1; }
    }
    if (grid_blocks < 0) return;
    (void)hipMemsetAsync((char*)d_ws + mk::WS_CTL, 0, mk::CTL_BYTES, stream);
    mk::Params p{};
    for (int i = 0; i < 18; ++i) p.in[i] = (const float*)d_in[i];
    p.out = (float*)d_out; p.ws = (unsigned char*)d_ws;
    void* args[] = {&p};
    hipError_t e = hipLaunchCooperativeKernel((const void*)mk::mega, dim3(grid_blocks), dim3(mk::NTHREADS), args, mk::LDS_BYTES, stream);
    if (e != hipSuccess) fprintf(stderr, "cooperative launch failed: %s (grid %d)\n", hipGetErrorString(e), grid_blocks);
}
```

```cpp
#include <hip/hip_runtime.h>
#include <hip/hip_cooperative_groups.h>
#include <math.h>
#include <stdint.h>
#include <cstdio>
namespace mk {
namespace cg = cooperative_groups;
#define LAS __attribute__((address_space(3)))
typedef unsigned short bf16;
typedef short bf16x8 __attribute__((ext_vector_type(8)));
typedef short s16x4 __attribute__((ext_vector_type(4)));
typedef float f32x4 __attribute__((ext_vector_type(4)));
typedef float f32x2 __attribute__((ext_vector_type(2)));
typedef float f32x16 __attribute__((ext_vector_type(16)));
typedef unsigned u32x4 __attribute__((ext_vector_type(4)));
typedef unsigned u32x2 __attribute__((ext_vector_type(2)));
typedef __bf16 bf16x2_t __attribute__((ext_vector_type(2)));
typedef __attribute__((address_space(1))) float GF;

constexpr int DM = 2048, NBATCH = 8, SEQ = 2048, NMETA = 16;
constexpr int HB = 4, MH = HB * SEQ, MHK = MH + 256;
constexpr int NIN = 15872;
constexpr int INW = 15680;
constexpr float EPS = 1e-6f, LOG2E = 1.4426950408889634f;
constexpr float QS_MLA = 0.07216878364870322f * LOG2E;
constexpr float QS_DIFF = 0.08838834764831845f * LOG2E;
constexpr int NWAVES = 8, NTHREADS = 512;
constexpr int T_CQ = 0, T_CKV = 3, T_KR = 5, T_ZA = 6, T_QD = 14, T_KD = 22, T_VD = 30, T_ZB = 38, T_GA = 46, T_GB = 54, T_END = 62;

constexpr size_t al(size_t x) { return (x + 4095) / 4096 * 4096; }
constexpr size_t WS_WIN = 0;
constexpr size_t WS_WUQ = WS_WIN + al((size_t)NIN * 2048 * 2);
constexpr size_t WS_WUKV = WS_WUQ + al((size_t)4096 * 768 * 2);
constexpr size_t WS_WA = WS_WUKV + al((size_t)4096 * 512 * 2);
constexpr size_t WS_WB = WS_WA + al((size_t)2048 * 2048 * 2);
constexpr size_t WS_WO = WS_WB + al((size_t)2048 * 2048 * 2);
constexpr size_t WS_UMETA = WS_WO + al((size_t)2048 * 2048 * 2);
constexpr size_t WS_TAB = WS_UMETA + al((size_t)256 * 2048 * 2);
constexpr size_t TAB_COS = 0, TAB_SIN = (size_t)2064 * 32 * 4, TAB_BIAS = 2 * TAB_SIN, TAB_LAM = TAB_BIAS + 8 * 260 * 4;
constexpr size_t WS_CQ = WS_TAB + al(TAB_LAM + 64);
constexpr size_t WS_CKV = WS_CQ + al((size_t)MHK * 768 * 2);
constexpr size_t WS_KR = WS_CKV + al((size_t)MHK * 512 * 2);
constexpr size_t WS_SSP = WS_KR + al((size_t)MHK * 64 * 2);
constexpr size_t SZ_ACT = al((size_t)MHK * 2048 * 2);
constexpr size_t WS_ZA = WS_SSP + al((size_t)MHK * 16 * 4);
constexpr size_t WS_QD = WS_ZA + SZ_ACT, WS_KD = WS_QD + SZ_ACT, WS_VD = WS_KD + SZ_ACT, WS_ZB = WS_VD + SZ_ACT, WS_SA = WS_ZB + SZ_ACT, WS_SB = WS_SA + SZ_ACT;
constexpr size_t WS_QM = WS_SB + SZ_ACT;
constexpr size_t WS_KM = WS_QM + al((size_t)MHK * 3072 * 2);
constexpr size_t WS_VM = WS_KM + al((size_t)MHK * 3072 * 2);
constexpr size_t WS_END = WS_VM + SZ_ACT;
constexpr size_t WS_MB = WS_VM;
constexpr size_t O1S_BYTES = (size_t)256 * 8 * 32 * 256 * 4;
static_assert(WS_WUKV - WS_WIN >= O1S_BYTES, "O1 stash of half 1 overlays WIN_T|WUQ_T");
constexpr size_t WS_CTL = WS_END, CTL_BYTES = 65536;
static_assert(WS_CTL + CTL_BYTES <= (size_t)512 * 1024 * 1024, "workspace");

constexpr int LDS_RING = 0, RING_BYTES = 131072;
constexpr int LDS_X = RING_BYTES;
constexpr int LDS_X2 = LDS_X + 8192;
constexpr int LDS_WSC = LDS_X2 + 1024;
constexpr int LDS_WSS = LDS_WSC + 2048;
constexpr int LDS_BT = LDS_WSS + 1024;
constexpr int LDS_MISC = LDS_BT + 1056;
constexpr int LDS_BYTES = 147456;

struct Params {
    const float* in[18];
    float* out; unsigned char* ws;
    int dbg, pad;
};

#define CAS __attribute__((address_space(4)))
typedef const float* cfp_t; typedef float* fp_t; typedef unsigned char* ucp_t;
__device__ __forceinline__ const float* kin(int k) { const volatile CAS cfp_t* kp = (const volatile CAS cfp_t*)__builtin_amdgcn_kernarg_segment_ptr(); return kp[k]; }
__device__ __forceinline__ float* kout() { const volatile CAS fp_t* kp = (const volatile CAS fp_t*)__builtin_amdgcn_kernarg_segment_ptr(); return kp[18]; }
__device__ __forceinline__ unsigned char* kws() { const volatile CAS ucp_t* kp = (const volatile CAS ucp_t*)__builtin_amdgcn_kernarg_segment_ptr(); return kp[19]; }
__device__ __forceinline__ unsigned char* wsp(unsigned char* ws, size_t off) { unsigned k = (unsigned)(off >> 12); asm volatile("" : "+s"(k)); return ws + ((size_t)k << 12); }
__device__ __forceinline__ int kdbg() { const volatile CAS int* kp = (const volatile CAS int*)__builtin_amdgcn_kernarg_segment_ptr(); return kp[40]; }
__device__ __forceinline__ unsigned cvtpk(float lo, float hi) { f32x2 v = {lo, hi}; bf16x2_t b = __builtin_convertvector(v, bf16x2_t); return __builtin_bit_cast(unsigned, b); }
__device__ __forceinline__ float bflo(unsigned u) { return __builtin_bit_cast(float, u << 16); }
__device__ __forceinline__ float bfhi(unsigned u) { return __builtin_bit_cast(float, u & 0xffff0000u); }
__device__ __forceinline__ float silu_f(float v) { return v * __builtin_amdgcn_rcpf(1.f + __expf(-v)); }
__device__ __forceinline__ float sigm_f(float v) { return __builtin_amdgcn_rcpf(1.f + __expf(-v)); }
__device__ __forceinline__ float wave_sum(float v) {
#pragma unroll
    for (int o = 1; o < 64; o <<= 1) v += __shfl_xor(v, o);
    return v;
}
__device__ __forceinline__ int crow(int r, int hi) { return (r & 3) + 8 * (r >> 2) + 4 * hi; }
__device__ __forceinline__ int opaque(int x) { asm volatile("" : "+v"(x)); return x; }
#define LDS_WAIT() asm volatile("s_waitcnt lgkmcnt(0)" ::: "memory")
#define SBAR() __builtin_amdgcn_sched_barrier(0)


#define XB_TMO      128
#define XB_XCNT(j)  (256  + 64 * (j))
#define XB_XSUB(j)  (1280 + 64 * (j))
#define XB_XGEN(j)  (2304 + 64 * (j))
#define XB_TOP      3328
#define XB_TOPGEN   3392
#define XB_SPIN_CAP (1u << 22)
__device__ __forceinline__ unsigned xb_ld(unsigned* p)              { return __hip_atomic_load(p, __ATOMIC_RELAXED, __HIP_MEMORY_SCOPE_AGENT); }
__device__ __forceinline__ unsigned xb_add(unsigned* p, unsigned v) { return __hip_atomic_fetch_add(p, v, __ATOMIC_RELAXED, __HIP_MEMORY_SCOPE_AGENT); }
__device__ __forceinline__ unsigned xb_xcc_id() { return (unsigned)__builtin_amdgcn_s_getreg((3 << 11) | 20) & 0xFu; }
#define XB_SPIN(cond, bar) do { unsigned _sp = 0; while (cond) { __builtin_amdgcn_s_sleep(1); \
    if ((++_sp & 255u) == 0u) { if (xb_ld(&(bar)[XB_TMO])) break; if (_sp > XB_SPIN_CAP) { atomicAdd(&(bar)[XB_TMO], 1u); break; } } } } while (0)
struct XcdBarrier { unsigned* bar; unsigned x; volatile LAS unsigned* st; };
__device__ __forceinline__ XcdBarrier xcd_barrier_post(unsigned* bar, volatile LAS unsigned* st) {
    XcdBarrier b; b.bar = bar; b.x = xb_xcc_id(); b.st = st;
    if (threadIdx.x == 0) (void)xb_add(&bar[XB_XCNT(b.x)], 1u);
    return b;
}
__device__ __forceinline__ void xcd_barrier_complete(unsigned* bar, unsigned x, unsigned& nloc, unsigned& nx) {
    const unsigned G = gridDim.x * gridDim.y * gridDim.z;
    unsigned sum, cnt, mine, sp = 0u;
    for (;;) {
        sum = 0u; cnt = 0u; mine = 0u;
#pragma unroll
        for (unsigned j = 0; j < 16; ++j) { const unsigned c = xb_ld(&bar[XB_XCNT(j)]); sum += c; cnt += (c > 0u) ? 1u : 0u; mine = (j == x) ? c : mine; }
        if (sum == G) break;
        __builtin_amdgcn_s_sleep(1);
        if ((++sp & 255u) == 0u) { if (xb_ld(&bar[XB_TMO])) break; if (sp > XB_SPIN_CAP) { atomicAdd(&bar[XB_TMO], 1u); break; } }
    }
    nloc = mine > 0u ? mine : 1u; nx = cnt > 0u ? cnt : 1u;
}
__device__ __forceinline__ void xcd_barrier(const XcdBarrier& b) {
    asm volatile("s_waitcnt vmcnt(0)" ::: "memory");
    __syncthreads();
    if (threadIdx.x == 0) {
        unsigned* bar = b.bar;
        __builtin_amdgcn_s_waitcnt(0);
        unsigned nloc = b.st[0], nx = b.st[1];
        if (nloc == 0u) { xcd_barrier_complete(bar, b.x, nloc, nx); b.st[0] = nloc; b.st[1] = nx; }
        const unsigned old = xb_add(&bar[XB_XSUB(b.x)], 1u);
        const unsigned gen = old / nloc;
        if (old + 1u == (gen + 1u) * nloc) {
            __builtin_amdgcn_fence(__ATOMIC_RELEASE, "agent");
            asm volatile("s_waitcnt vmcnt(0)" ::: "memory");
            const unsigned og = xb_add(&bar[XB_TOP], 1u);
            const unsigned tg = og / nx;
            if (og + 1u == (tg + 1u) * nx) xb_add(&bar[XB_TOPGEN], 1u);
            else XB_SPIN(xb_ld(&bar[XB_TOPGEN]) == tg, bar);
            __builtin_amdgcn_fence(__ATOMIC_ACQUIRE, "agent");
            xb_add(&bar[XB_XGEN(b.x)], 1u);
            asm volatile("s_waitcnt vmcnt(0)" ::: "memory");
        } else {
            XB_SPIN(xb_ld(&bar[XB_XGEN(b.x)]) == gen, bar);
            __builtin_amdgcn_fence(__ATOMIC_ACQUIRE, "agent");
            asm volatile("s_waitcnt vmcnt(0)" ::: "memory");
        }
    }
    __syncthreads();
}

constexpr int BM = 256, BK = 64, HALF = 128, HTB = HALF * BK * 2, NXCD = 8, WGM = 8;
__device__ __forceinline__ int lds_byte(int r, int c) { const int st = (r >> 4) * 2 + (c >> 5), rr = r & 15, cc = c & 31, ob = rr * 64 + cc * 2; return st * 1024 + (ob ^ (((ob >> 9) & 1) << 5)); }
__device__ __forceinline__ void stage_rc(int b, int& R, int& C) { const int st = b / 1024, sb = b % 1024, swz = sb ^ (((sb >> 9) & 1) << 5); R = (st >> 1) * 16 + swz / 64; C = (st & 1) * 32 + (swz % 64) / 2; }
__device__ __forceinline__ int perm32(int rho) { const int n = rho >> 4, i = rho & 15; return 8 * (i >> 2) + 4 * n + (i & 3); }

struct Unit { const char* A; const char* B; int pm, pn, kind; };
struct TileOrder {
    int nM, nN, nwg, G, c;
    __device__ void init(int nM_, int nN_, int G_, int c_) { nM = nM_; nN = nN_; nwg = nM * nN; G = G_; c = c_; }
    __device__ bool tile(int i, int& pm, int& pn) const {
        const long L = (long)i * G + c; if (L >= nwg) return false;
        int wgid = (int)L; { const int q = nwg / NXCD, r = nwg % NXCD, xcd = wgid % NXCD, off = wgid / NXCD; wgid = (xcd < r ? xcd * (q + 1) : r * (q + 1) + (xcd - r) * q) + off; }
        const int nig = WGM * nN, gid = wgid / nig, fm = gid * WGM, gsz = (nM - fm) < WGM ? (nM - fm) : WGM;
        pm = fm + ((wgid % nig) % gsz); pn = (wgid % nig) / gsz; return true;
    }
};

typedef f32x4 Acc[2][2][4][2];

template <class Epi, class Sched>
__device__ __forceinline__ void gemm_phase(LAS unsigned char* lds, const int lda, const int ldb, const int nt, const Sched& S, const Epi& E) {
    const int tid = opaque(threadIdx.x), wid = __builtin_amdgcn_readfirstlane(tid >> 6), lane = tid & 63, wr = wid >> 2, wc = wid & 3, fr = lane & 15, fq = lane >> 4;
    unsigned voffA[2], voffB[2];
#pragma unroll
    for (int i = 0; i < 2; ++i) { int R, C; stage_rc(tid * 16 + i * 8192, R, C); const int Rb = (R & ~31) + perm32(R & 31);
        voffA[i] = (unsigned)(R * lda + C) * 2u; voffB[i] = (unsigned)(Rb * ldb + C) * 2u; }
    const size_t kstep = (size_t)(BK * 2);
    const size_t hstepA = (size_t)HALF * lda * 2, hstepB = (size_t)HALF * ldb * 2;
    const unsigned ldsw = (unsigned)wid * 1024u;
    const int aoff = lds_byte(wr * 64 + fr, fq * 8), boff = lds_byte(wc * 32 + fr, fq * 8);
#define PG8_SA(b, h) (((b) * 2 + (h)) * HTB)
#define PG8_SB(b, h) ((4 + (b) * 2 + (h)) * HTB)
#define PG8_STAGE(bufoff, gbase, voff) do { _Pragma("unroll") for (int _i = 0; _i < 2; ++_i) \
        __builtin_amdgcn_global_load_lds((const unsigned*)((const char*)(gbase) + (voff)[_i]), (LAS unsigned*)(lds + (bufoff) + ldsw + _i * 8192), 16, 0, 0); } while (0)
#define PG8_LDA(dst, b, h) do { _Pragma("unroll") for (int m = 0; m < 4; ++m) _Pragma("unroll") for (int k = 0; k < 2; ++k) dst[m][k] = *(const LAS bf16x8*)(lds + PG8_SA(b, h) + aoff + m * 2048 + k * 1024); } while (0)
#define PG8_LDB(dst, b, h) do { _Pragma("unroll") for (int n = 0; n < 2; ++n) _Pragma("unroll") for (int k = 0; k < 2; ++k) dst[n][k] = *(const LAS bf16x8*)(lds + PG8_SB(b, h) + boff + n * 2048 + k * 1024); } while (0)
#define PG8_MMA(ai, bj, At, Bt) do { __builtin_amdgcn_s_setprio(1); _Pragma("unroll") for (int m = 0; m < 4; ++m) _Pragma("unroll") for (int n = 0; n < 2; ++n) _Pragma("unroll") for (int k = 0; k < 2; ++k) \
        acc[ai][bj][m][n] = __builtin_amdgcn_mfma_f32_16x16x32_bf16(Bt[n][k], At[m][k], acc[ai][bj][m][n], 0, 0, 0); __builtin_amdgcn_s_setprio(0); } while (0)
#define PG8_WAIT_V(n) asm volatile("s_waitcnt vmcnt(" #n ")" ::: "memory")
#define PG8_WAIT_L(n) asm volatile("s_waitcnt lgkmcnt(" #n ")" ::: "memory")
#define PG8_BAR __builtin_amdgcn_s_barrier()
#define PG8_SCHED __builtin_amdgcn_sched_barrier(0)
    Unit cur, nxt; int ui = 0;
    if (!S.next(0, cur)) return;
    Acc acc;
#pragma unroll
    for (int a = 0; a < 2; ++a)
#pragma unroll
        for (int b = 0; b < 2; ++b)
#pragma unroll
            for (int m = 0; m < 4; ++m)
#pragma unroll
                for (int n = 0; n < 2; ++n) acc[a][b][m][n] = (f32x4){0.f, 0.f, 0.f, 0.f};
    bf16x8 At[4][2], B0[2][2], B1[2][2];
    const char* cA = cur.A; const char* cB = cur.B;
    PG8_STAGE(PG8_SB(0, 0), cB, voffB); PG8_STAGE(PG8_SB(0, 1), cB + hstepB, voffB); PG8_STAGE(PG8_SA(0, 0), cA, voffA); PG8_STAGE(PG8_SA(0, 1), cA + hstepA, voffA);
    if (wr == 1) PG8_BAR;
    PG8_WAIT_V(2); PG8_BAR;
    PG8_STAGE(PG8_SB(1, 0), cB + kstep, voffB); PG8_STAGE(PG8_SA(1, 0), cA + kstep, voffA); PG8_STAGE(PG8_SB(1, 1), cB + hstepB + kstep, voffB);
    PG8_WAIT_V(6); PG8_BAR;
    for (;;) {
        const bool has_next = S.next(ui + 1, nxt);
        const char* nA = has_next ? nxt.A : cA; const char* nB = has_next ? nxt.B : cB;
        for (int t = 0; t < nt; t += 2) {
            const bool last = (t == nt - 2);
            const char* a1 = cA + (size_t)(t + 1) * kstep;
            const char* a2 = last ? nA : cA + (size_t)(t + 2) * kstep; const char* b2 = last ? nB : cB + (size_t)(t + 2) * kstep;
            const char* a3 = a2 + kstep; const char* b3 = b2 + kstep;
            PG8_LDB(B0, 0, 0); PG8_LDB(B1, 0, 1); PG8_SCHED; PG8_LDA(At, 0, 0); PG8_STAGE(PG8_SA(1, 1), a1 + hstepA, voffA);
            PG8_WAIT_V(8); PG8_WAIT_L(0); PG8_BAR; PG8_MMA(0, 0, At, B0); PG8_MMA(0, 1, At, B1); PG8_BAR; PG8_SCHED;
            PG8_LDA(At, 0, 1); PG8_STAGE(PG8_SB(0, 0), b2, voffB); PG8_STAGE(PG8_SB(0, 1), b2 + hstepB, voffB); PG8_STAGE(PG8_SA(0, 0), a2, voffA);
            PG8_WAIT_V(8); PG8_WAIT_L(0); PG8_BAR; PG8_MMA(1, 0, At, B0); PG8_MMA(1, 1, At, B1); PG8_BAR; PG8_SCHED;
            PG8_LDB(B0, 1, 0); PG8_LDB(B1, 1, 1); PG8_SCHED; PG8_LDA(At, 1, 0); PG8_STAGE(PG8_SA(0, 1), a2 + hstepA, voffA);
            PG8_WAIT_V(8); PG8_WAIT_L(0); PG8_BAR; PG8_MMA(0, 0, At, B0); PG8_MMA(0, 1, At, B1); PG8_BAR; PG8_SCHED;
            PG8_LDA(At, 1, 1); PG8_STAGE(PG8_SB(1, 0), b3, voffB); PG8_STAGE(PG8_SB(1, 1), b3 + hstepB, voffB); PG8_STAGE(PG8_SA(1, 0), a3, voffA);
            PG8_WAIT_V(8); PG8_WAIT_L(0); PG8_BAR; PG8_MMA(1, 0, At, B0); PG8_MMA(1, 1, At, B1); PG8_BAR; PG8_SCHED;
        }
        if (wr == 0) PG8_BAR;
        const bool keep = E(acc, cur, wr, wc, fr, fq, lds);
        if (!has_next) break;
        if (!keep) {
#pragma unroll
            for (int a = 0; a < 2; ++a)
#pragma unroll
                for (int b = 0; b < 2; ++b)
#pragma unroll
                    for (int m = 0; m < 4; ++m)
#pragma unroll
                        for (int n = 0; n < 2; ++n) acc[a][b][m][n] = (f32x4){0.f, 0.f, 0.f, 0.f};
        }
        cur = nxt; cA = nA; cB = nB; ++ui;
        if (wr == 1) PG8_BAR;
    }
    PG8_WAIT_V(0);
    PG8_BAR;
#undef PG8_SA
#undef PG8_SB
#undef PG8_STAGE
#undef PG8_LDA
#undef PG8_LDB
#undef PG8_MMA
#undef PG8_WAIT_V
#undef PG8_WAIT_L
#undef PG8_BAR
#undef PG8_SCHED
}

__device__ __forceinline__ void tile_half_ss(const Acc& acc, LAS unsigned char* lds, int wr, int wc, int fr, int fq, float (&ss)[2][4][2]) {
    LAS float* X = (LAS float*)(lds + LDS_X);
#pragma unroll
    for (int ai = 0; ai < 2; ++ai)
#pragma unroll
        for (int m = 0; m < 4; ++m)
#pragma unroll
            for (int bj = 0; bj < 2; ++bj) {
                const f32x4 a = acc[ai][bj][m][0], b = acc[ai][bj][m][1];
                float s = (a[0] * a[0] + a[1] * a[1]) + (a[2] * a[2] + a[3] * a[3]) + (b[0] * b[0] + b[1] * b[1]) + (b[2] * b[2] + b[3] * b[3]);
                s += __shfl_xor(s, 16); s += __shfl_xor(s, 32);
                if (fq == 0) X[((ai * 128 + wr * 64 + m * 16 + fr) * 2 + bj) * 4 + wc] = s;
            }
    LDS_WAIT(); __builtin_amdgcn_s_barrier(); asm volatile("" ::: "memory");
#pragma unroll
    for (int ai = 0; ai < 2; ++ai)
#pragma unroll
        for (int m = 0; m < 4; ++m)
#pragma unroll
            for (int bj = 0; bj < 2; ++bj) {
                const f32x4 v = *(const LAS f32x4*)(X + ((ai * 128 + wr * 64 + m * 16 + fr) * 2 + bj) * 4);
                ss[ai][m][bj] = (v[0] + v[1]) + (v[2] + v[3]);
            }
}
__device__ __forceinline__ u32x4 pack8(const f32x4 a, const f32x4 b) { u32x4 w; w.x = cvtpk(a[0], a[1]); w.y = cvtpk(a[2], a[3]); w.z = cvtpk(b[0], b[1]); w.w = cvtpk(b[2], b[3]); return w; }

struct EpiP1 {
    unsigned char* ws; const float* gqd; const float* gkd;
    __device__ __forceinline__ bool operator()(Acc& acc, const Unit& u, int wr, int wc, int fr, int fq, LAS unsigned char* lds) const {
        fr = opaque(fr); fq = opaque(fq);
        const int pn = u.pn; const int row0 = u.pm * 256 + wr * 64 + fr;
        const int colw = wc * 32 + 8 * fq;
        if (pn < T_KR) {
            float ss[2][4][2]; tile_half_ss(acc, lds, wr, wc, fr, fq, ss);
            const bool iscq = pn < T_CKV;
            bf16* dst = iscq ? (bf16*)(wsp(ws, WS_CQ)) : (bf16*)(wsp(ws, WS_CKV)); const int ld = iscq ? 768 : 512; const int c0 = iscq ? pn * 256 : (pn - T_CKV) * 256;
            const int chunk0 = iscq ? pn * 2 : 6 + (pn - T_CKV) * 2;
            float* ssp = (float*)(wsp(ws, WS_SSP));
#pragma unroll
            for (int ai = 0; ai < 2; ++ai)
#pragma unroll
                for (int m = 0; m < 4; ++m) { const int row = row0 + ai * 128 + m * 16;
#pragma unroll
                    for (int bj = 0; bj < 2; ++bj) {
                        *(u32x4*)(dst + (size_t)row * ld + c0 + bj * 128 + colw) = pack8(acc[ai][bj][m][0], acc[ai][bj][m][1]);
                        if (wc == 0 && fq == 0) ssp[(size_t)row * 16 + chunk0 + bj] = ss[ai][m][bj];
                    } }
            return false;
        }
        if (pn == T_KR) {
            if (wc < 2) { bf16* dst = (bf16*)(wsp(ws, WS_KR));
#pragma unroll
                for (int ai = 0; ai < 2; ++ai)
#pragma unroll
                    for (int m = 0; m < 4; ++m) { const int row = row0 + ai * 128 + m * 16; *(u32x4*)(dst + (size_t)row * 64 + colw) = pack8(acc[ai][0][m][0], acc[ai][0][m][1]); } }
            return false;
        }
        if (pn >= T_QD && pn < T_VD) {
            float ss[2][4][2]; tile_half_ss(acc, lds, wr, wc, fr, fq, ss);
            const bool isq = pn < T_KD; const float* g = isq ? gqd : gkd; const float post = isq ? QS_DIFF : 1.f;
            bf16* dst = isq ? (bf16*)(wsp(ws, WS_QD)) : (bf16*)(wsp(ws, WS_KD)); const int c0 = (isq ? pn - T_QD : pn - T_KD) * 256;
            const f32x4 g0 = *(const f32x4*)(g + colw), g1 = *(const f32x4*)(g + colw + 4);
#pragma unroll
            for (int ai = 0; ai < 2; ++ai)
#pragma unroll
                for (int m = 0; m < 4; ++m) { const int row = row0 + ai * 128 + m * 16;
#pragma unroll
                    for (int bj = 0; bj < 2; ++bj) { const float rs = __builtin_amdgcn_rsqf(ss[ai][m][bj] * (1.f / 128.f) + EPS) * post;
                        *(u32x4*)(dst + (size_t)row * 2048 + c0 + bj * 128 + colw) = pack8(acc[ai][bj][m][0] * g0 * rs, acc[ai][bj][m][1] * g1 * rs); } }
            return false;
        }
        int mode; bf16* dst; int c0;
        if (pn < T_QD) { mode = 1; dst = (bf16*)(wsp(ws, WS_ZA)); c0 = (pn - T_ZA) * 256; }
        else if (pn < T_ZB) { mode = 0; dst = (bf16*)(wsp(ws, WS_VD)); c0 = (pn - T_VD) * 256; }
        else if (pn < T_GA) { mode = 1; dst = (bf16*)(wsp(ws, WS_ZB)); c0 = (pn - T_ZB) * 256; }
        else if (pn < T_GB) { mode = 2; dst = (bf16*)(wsp(ws, WS_SA)); c0 = (pn - T_GA) * 256; }
        else { mode = 2; dst = (bf16*)(wsp(ws, WS_SB)); c0 = (pn - T_GB) * 256; }
#pragma unroll
        for (int ai = 0; ai < 2; ++ai)
#pragma unroll
            for (int m = 0; m < 4; ++m) { const int row = row0 + ai * 128 + m * 16;
#pragma unroll
                for (int bj = 0; bj < 2; ++bj) { f32x4 a = acc[ai][bj][m][0], b = acc[ai][bj][m][1];
                    if (mode == 1) {
#pragma unroll
                        for (int e = 0; e < 4; ++e) { a[e] = silu_f(a[e]); b[e] = silu_f(b[e]); } }
                    else if (mode == 2) {
#pragma unroll
                        for (int e = 0; e < 4; ++e) { a[e] = sigm_f(a[e]); b[e] = sigm_f(b[e]); } }
                    *(u32x4*)(dst + (size_t)row * 2048 + c0 + bj * 128 + colw) = pack8(a, b); } }
        return false;
    }
};
struct SchedP1 {
    TileOrder T; const char* U; const char* Umeta; const char* W;
    __device__ __forceinline__ bool next(int i, Unit& u) const {
        int pm, pn; if (!T.tile(i, pm, pn)) return false;
        u.pm = pm; u.pn = pn; u.kind = 0;
        u.A = (pm < 32) ? U + (size_t)pm * 256 * 2048 * 2 : Umeta; u.B = W + (size_t)pn * 256 * 2048 * 2; return true;
    }
};

__device__ __forceinline__ float ssp_rs(const float* ssp, int row, int c0, int n, float invw) {
    float s = 0.f; for (int c = 0; c < n; ++c) s += ssp[(size_t)row * 16 + c0 + c]; return __builtin_amdgcn_rsqf(s * invw + EPS);
}
struct EpiP2Q {
    unsigned char* ws; const float* gq;
    __device__ __forceinline__ bool operator()(Acc& acc, const Unit& u, int wr, int wc, int fr, int fq, LAS unsigned char* lds) const {
        fr = opaque(fr); fq = opaque(fq);
        const int h = u.pn; const int row0 = u.pm * 256 + wr * 64 + fr; const int colw = wc * 32 + 8 * fq;
        const float* ssp = (const float*)(wsp(ws, WS_SSP));
#pragma unroll
        for (int ai = 0; ai < 2; ++ai)
#pragma unroll
            for (int m = 0; m < 4; ++m) { const float rs = ssp_rs(ssp, row0 + ai * 128 + m * 16, 0, 6, 1.f / 768.f);
#pragma unroll
                for (int bj = 0; bj < 2; ++bj) { acc[ai][bj][m][0] *= rs; acc[ai][bj][m][1] *= rs; }
                if (m & 1) asm volatile("" ::: "memory"); }
        float ss[2][4][2]; tile_half_ss(acc, lds, wr, wc, fr, fq, ss);
        bf16* dst = (bf16*)(wsp(ws, WS_QM));
        { const f32x4 g0 = *(const f32x4*)(gq + colw), g1 = *(const f32x4*)(gq + colw + 4);
#pragma unroll
          for (int ai = 0; ai < 2; ++ai)
#pragma unroll
            for (int m = 0; m < 4; ++m) { const int row = row0 + ai * 128 + m * 16;
                const float rs = __builtin_amdgcn_rsqf((ss[ai][m][0] + ss[ai][m][1]) * (1.f / 192.f) + EPS) * QS_MLA;
                *(u32x4*)(dst + (size_t)row * 3072 + h * 192 + colw) = pack8(acc[ai][0][m][0] * g0 * rs, acc[ai][0][m][1] * g1 * rs); } }
        if (wc < 2) {
            const int ib = opaque(16 * wc + 4 * fq);
            const f32x4 gr1 = *(const f32x4*)(gq + 128 + ib), gr2 = *(const f32x4*)(gq + 160 + ib);
            const float* ctab = (const float*)(wsp(ws, WS_TAB) + TAB_COS); const float* stab = (const float*)(wsp(ws, WS_TAB) + TAB_SIN);
#pragma unroll
            for (int ai = 0; ai < 2; ++ai)
#pragma unroll
                for (int m = 0; m < 4; ++m) { const int row = row0 + ai * 128 + m * 16;
                    const float rs = __builtin_amdgcn_rsqf((ss[ai][m][0] + ss[ai][m][1]) * (1.f / 192.f) + EPS) * QS_MLA;
                    const int pos = NMETA + (row & (SEQ - 1));
                    const f32x4 c = *(const f32x4*)(ctab + pos * 32 + ib), sn = *(const f32x4*)(stab + pos * 32 + ib);
                    const f32x4 x1 = acc[ai][1][m][0] * gr1 * rs, x2 = acc[ai][1][m][1] * gr2 * rs;
                    *(u32x4*)(dst + (size_t)row * 3072 + h * 192 + 128 + colw) = pack8(x1 * c - x2 * sn, x2 * c + x1 * sn);
                    asm volatile("" ::: "memory"); }
        }
        return false;
    }
};
struct SchedP2Q {
    TileOrder T; const char* CQ; const char* W;
    __device__ __forceinline__ bool next(int i, Unit& u) const {
        int pm, pn; if (!T.tile(i, pm, pn)) return false;
        u.pm = pm; u.pn = pn; u.kind = 0; u.A = CQ + (size_t)pm * 256 * 768 * 2; u.B = W + (size_t)pn * 256 * 768 * 2; return true;
    }
};
struct EpiP2KV {
    unsigned char* ws; const float* gk;
    __device__ __forceinline__ bool operator()(Acc& acc, const Unit& u, int wr, int wc, int fr, int fq, LAS unsigned char* lds) const {
        fr = opaque(fr); fq = opaque(fq);
        const int h = u.pn; const int row0 = u.pm * 256 + wr * 64 + fr; const int colw = wc * 32 + 8 * fq;
        const float* ssp = (const float*)(wsp(ws, WS_SSP));
#pragma unroll
        for (int ai = 0; ai < 2; ++ai)
#pragma unroll
            for (int m = 0; m < 4; ++m) { const float rs = ssp_rs(ssp, row0 + ai * 128 + m * 16, 6, 4, 1.f / 512.f);
#pragma unroll
                for (int bj = 0; bj < 2; ++bj) { acc[ai][bj][m][0] *= rs; acc[ai][bj][m][1] *= rs; }
                if (m & 1) asm volatile("" ::: "memory"); }
        const int tid = opaque(threadIdx.x), rr = tid >> 1, hf = tid & 1; const int rrow = u.pm * 256 + rr;
        const bf16* kr = (const bf16*)(wsp(ws, WS_KR)) + (size_t)rrow * 64 + hf * 32;
        u32x4 kv[4]; float sr = 0.f;
#pragma unroll
        for (int j = 0; j < 4; ++j) { kv[j] = *(const u32x4*)(kr + j * 8);
#pragma unroll
            for (int e = 0; e < 4; ++e) { const float a = bflo(kv[j][e]), b = bfhi(kv[j][e]); sr += a * a + b * b; } }
        sr += __shfl_xor(sr, 1);
        LAS float* X2 = (LAS float*)(lds + LDS_X2);
        if (hf == 0) X2[rr] = sr;
        float ss[2][4][2]; tile_half_ss(acc, lds, wr, wc, fr, fq, ss);
        const f32x4 g0 = *(const f32x4*)(gk + colw), g1 = *(const f32x4*)(gk + colw + 4);
        bf16* kdst = (bf16*)(wsp(ws, WS_KM)); bf16* vdst = (bf16*)(wsp(ws, WS_VM));
#pragma unroll
        for (int ai = 0; ai < 2; ++ai)
#pragma unroll
            for (int m = 0; m < 4; ++m) { const int trow = ai * 128 + wr * 64 + m * 16 + fr; const int row = u.pm * 256 + trow;
                const float rs = __builtin_amdgcn_rsqf((ss[ai][m][0] + X2[trow]) * (1.f / 192.f) + EPS);
                *(u32x4*)(kdst + (size_t)row * 3072 + h * 192 + colw) = pack8(acc[ai][0][m][0] * g0 * rs, acc[ai][0][m][1] * g1 * rs);
                *(u32x4*)(vdst + (size_t)row * 2048 + h * 128 + colw) = pack8(acc[ai][1][m][0], acc[ai][1][m][1]); }
        { const LAS float* X = (const LAS float*)(lds + LDS_X); const f32x4 pv = *(const LAS f32x4*)(X + (rr * 2 + 0) * 4);
          const float rs = __builtin_amdgcn_rsqf(((pv[0] + pv[1]) + (pv[2] + pv[3]) + sr) * (1.f / 192.f) + EPS);
          const int pos = (u.pm < 32) ? NMETA + (rrow & (SEQ - 1)) : (rr < NMETA ? rr : 0);
          const float* ctab = (const float*)(wsp(ws, WS_TAB) + TAB_COS) + pos * 32; const float* stab = (const float*)(wsp(ws, WS_TAB) + TAB_SIN) + pos * 32;
#pragma unroll
          for (int j = 0; j < 4; ++j) { const int g = hf * 4 + j; const int i0 = 4 * g;
              const f32x4 c = *(const f32x4*)(ctab + i0), s = *(const f32x4*)(stab + i0), gg1 = *(const f32x4*)(gk + 128 + i0), gg2 = *(const f32x4*)(gk + 160 + i0);
              f32x4 x1 = {bflo(kv[j][0]), bfhi(kv[j][0]), bflo(kv[j][1]), bfhi(kv[j][1])}, x2 = {bflo(kv[j][2]), bfhi(kv[j][2]), bflo(kv[j][3]), bfhi(kv[j][3])};
              x1 = x1 * gg1 * rs; x2 = x2 * gg2 * rs;
              *(u32x4*)(kdst + (size_t)rrow * 3072 + h * 192 + 128 + g * 8) = pack8(x1 * c - x2 * s, x2 * c + x1 * s); } }
        return false;
    }
};
struct SchedP2KV {
    TileOrder T; const char* CKV; const char* W;
    __device__ __forceinline__ bool next(int i, Unit& u) const {
        int pm, pn; if (!T.tile(i, pm, pn)) return false;
        u.pm = pm; u.pn = pn; u.kind = 0; u.A = CKV + (size_t)pm * 256 * 512 * 2; u.B = W + (size_t)pn * 256 * 512 * 2; return true;
    }
};

struct EpiP4 {
    unsigned char* ws; int dbg;
    __device__ __forceinline__ bool operator()(Acc& acc, const Unit& u, int wr, int wc, int fr, int fq, LAS unsigned char* lds) const {
        fr = opaque(fr); fq = opaque(fq);
        const int row0 = u.pm * 256 + wr * 64 + fr; const int col0 = u.pn * 256 + wc * 32 + 8 * fq;
        const bf16* sa = (const bf16*)(wsp(ws, WS_SA)); const bf16* sb = (const bf16*)(wsp(ws, WS_SB)); bf16* mb = (bf16*)(wsp(ws, WS_MB));
#pragma unroll
        for (int ai = 0; ai < 2; ++ai)
#pragma unroll
            for (int m = 0; m < 4; ++m) { const int row = row0 + ai * 128 + m * 16;
#pragma unroll
                for (int bj = 0; bj < 2; ++bj) { const size_t off = (size_t)row * 2048 + col0 + bj * 128;
                    const u32x4 b = *(const u32x4*)(sb + off);
                    const f32x4 b0 = {bflo(b[0]), bfhi(b[0]), bflo(b[1]), bfhi(b[1])}, b1 = {bflo(b[2]), bfhi(b[2]), bflo(b[3]), bfhi(b[3])};
                    if (u.kind == 0) { const u32x4 a = *(const u32x4*)(sa + off);
                        const f32x4 a0 = {bflo(a[0]), bfhi(a[0]), bflo(a[1]), bfhi(a[1])}, a1 = {bflo(a[2]), bfhi(a[2]), bflo(a[3]), bfhi(a[3])};
                        if (dbg == 1) { *(u32x4*)(mb + off) = pack8(acc[ai][bj][m][0] * a0, acc[ai][bj][m][1] * a1); } else {
#pragma unroll
                        for (int e = 0; e < 4; ++e) { acc[ai][bj][m][0][e] *= a0[e] * __builtin_amdgcn_rcpf(b0[e]); acc[ai][bj][m][1][e] *= a1[e] * __builtin_amdgcn_rcpf(b1[e]); } } }
                    else *(u32x4*)(mb + off) = pack8(acc[ai][bj][m][0] * b0, acc[ai][bj][m][1] * b1); } }
        return u.kind == 0 && dbg != 1;
    }
};
struct SchedP4 {
    TileOrder T; const char* OA; const char* OB; const char* WA; const char* WB; int dbg;
    __device__ __forceinline__ bool next(int i, Unit& u) const {
        int pm, pn; const int ti = dbg ? i : (i >> 1), kd = dbg ? (dbg - 1) : (i & 1);
        if (!T.tile(ti, pm, pn)) return false;
        u.pm = pm; u.pn = pn; u.kind = kd;
        u.A = (kd ? OB : OA) + (size_t)pm * 256 * 2048 * 2; u.B = (kd ? WB : WA) + (size_t)pn * 256 * 2048 * 2; return true;
    }
};
struct EpiP5 {
    const float* x; float* out;
    __device__ __forceinline__ bool operator()(Acc& acc, const Unit& u, int wr, int wc, int fr, int fq, LAS unsigned char* lds) const {
        fr = opaque(fr); fq = opaque(fq);
        const int row0 = u.pm * 256 + wr * 64 + fr; const int col0 = u.pn * 256 + wc * 32 + 8 * fq;
#pragma unroll
        for (int ai = 0; ai < 2; ++ai)
#pragma unroll
            for (int m = 0; m < 4; ++m) { const int row = row0 + ai * 128 + m * 16;
#pragma unroll
                for (int bj = 0; bj < 2; ++bj) { const size_t off = (size_t)row * 2048 + col0 + bj * 128;
                    const f32x4 x0 = *(const f32x4*)(x + off), x1 = *(const f32x4*)(x + off + 4);
                    *(f32x4*)(out + off) = x0 + acc[ai][bj][m][0]; *(f32x4*)(out + off + 4) = x1 + acc[ai][bj][m][1]; } }
        return false;
    }
};
struct SchedP5 {
    TileOrder T; const char* MB; const char* WO;
    __device__ __forceinline__ bool next(int i, Unit& u) const {
        int pm, pn; if (!T.tile(i, pm, pn)) return false;
        u.pm = pm; u.pn = pn; u.kind = 0; u.A = MB + (size_t)pm * 256 * 2048 * 2; u.B = WO + (size_t)pn * 256 * 2048 * 2; return true;
    }
};

constexpr float NEGBIG = -1e30f;
constexpr float THR_L2 = 8.f * LOG2E;
template <int NCB> __device__ __forceinline__ int v_st(int k, int c) { const int kk = (k & ~0xC) | ((k & 4) << 1) | ((k & 8) >> 1); return ((kk >> 3) * NCB + (c >> 5)) * 512 + ((kk & 7) * 32 + (c & 31)) * 2; }
__device__ __forceinline__ int v_rd_base(int lane) { return ((lane & 3) << 3) | (((lane >> 2) & 3) << 6) | (((lane >> 4) & 1) << 5) | (((lane >> 5) & 1) << 8); }
typedef short v4i16_t __attribute__((ext_vector_type(4)));
typedef LAS const char* lds_cptr;
__device__ __forceinline__ s16x4 vtr(lds_cptr p) { return __builtin_bit_cast(s16x4, __builtin_amdgcn_ds_read_tr16_b64_v4i16((LAS v4i16_t*)p)); }
template <int NCB> __device__ __forceinline__ void pv_all(f32x16* o, lds_cptr vp, bf16x8 pa0, bf16x8 pa1, bf16x8 pa2, bf16x8 pa3) {
    constexpr int KS = NCB * 1024, HF = NCB * 512;
#pragma unroll
    for (int d0 = 0; d0 < NCB; ++d0) {
        const s16x4 l0 = vtr(vp + d0 * 512 + 0 * KS), h0 = vtr(vp + d0 * 512 + 0 * KS + HF), l1 = vtr(vp + d0 * 512 + 1 * KS), h1 = vtr(vp + d0 * 512 + 1 * KS + HF);
        const s16x4 l2 = vtr(vp + d0 * 512 + 2 * KS), h2 = vtr(vp + d0 * 512 + 2 * KS + HF), l3 = vtr(vp + d0 * 512 + 3 * KS), h3 = vtr(vp + d0 * 512 + 3 * KS + HF);
#define PK(L, H) (bf16x8){L[0], L[1], L[2], L[3], H[0], H[1], H[2], H[3]}
        o[d0] = __builtin_amdgcn_mfma_f32_32x32x16_bf16(pa0, PK(l0, h0), o[d0], 0, 0, 0);
        o[d0] = __builtin_amdgcn_mfma_f32_32x32x16_bf16(pa1, PK(l1, h1), o[d0], 0, 0, 0);
        o[d0] = __builtin_amdgcn_mfma_f32_32x32x16_bf16(pa2, PK(l2, h2), o[d0], 0, 0, 0);
        o[d0] = __builtin_amdgcn_mfma_f32_32x32x16_bf16(pa3, PK(l3, h3), o[d0], 0, 0, 0);
#undef PK
    }
}

template <int DQK, int DV, bool BIAS, int VAR = 0>
__device__ __forceinline__ void attn_pass(f32x16 (&o)[DV / 32], float& l_out, const bf16* __restrict__ Q, int ldq, const bf16* __restrict__ Kr, const bf16* __restrict__ Km, int ldk,
                                          const bf16* __restrict__ Vr, const bf16* __restrict__ Vm, int ldv, int q0, LAS unsigned char* ldsb) {
    constexpr int NKP = 64 * DQK * 2 / 8192, NVP = 64 * DV * 2 / 8192, KB = 64 * DQK * 2, VB = 64 * DV * 2, ND0 = DV / 32, NQ = DQK / 16, NCB = DV / 32;
    const int tid = opaque(threadIdx.x), lane = tid & 63, r32 = lane & 31, hi = lane >> 5; const int wid = __builtin_amdgcn_readfirstlane(tid >> 6);
    char* lds = (char*)ldsb;
    float* wsc = (float*)(lds + LDS_WSC) + wid * 64; float* al_l = wsc + 32;
    const float* btab = (const float*)(lds + LDS_BT);
    const int qw0 = q0 + wid * 32;
    bf16x8 qr[NQ];
    { const bf16* Qw = Q + (size_t)(wid * 32 + r32) * ldq + hi * 8;
#pragma unroll
      for (int d0 = 0; d0 < NQ; ++d0) qr[d0] = *(const bf16x8*)(Qw + d0 * 16); }
    const lds_cptr vp0 = (lds_cptr)ldsb + 3 * KB + v_rd_base(lane);
#define KXW(row) ((DQK == 128) ? ((row) & 15) : (((row) >> 1) & 7))
    constexpr int NKO = (DQK == 128) ? 8 : 4;
    int koff[NKO];
#pragma unroll
    for (int d0 = 0; d0 < NKO; ++d0) koff[d0] = r32 * (DQK * 2) + (((2 * d0 + hi) ^ KXW(r32)) << 4);
#define KOFF(d0) (koff[(d0) % NKO] + ((d0) / NKO) * (NKO * 32))
    unsigned ksrc[NKP], vsrc[NVP];
#pragma unroll
    for (int j = 0; j < NKP; ++j) { const int off = 8192 * j + 16 * tid, row = off / (DQK * 2), cpos = (off % (DQK * 2)) >> 4; ksrc[j] = (unsigned)(row * ldk + ((cpos ^ KXW(row)) << 3)); }
#pragma unroll
    for (int j = 0; j < NVP; ++j) { const int off = 8192 * j + 16 * tid, st = off >> 9, kk = (st / NCB) * 8 + ((off & 511) >> 6), c = (st % NCB) * 32 + ((off & 63) >> 1);
        const int k = (kk & ~0xC) | ((kk & 4) << 1) | ((kk & 8) >> 1); vsrc[j] = (unsigned)(k * ldv + c); }
    const unsigned ldsw = (unsigned)wid * 1024u;
#define DMA_K(t, KO_) do { const bf16* kp = (t) == 0 ? Km : Kr + (size_t)((VAR == 1 ? ((t) & 1) + 1 : (t)) - 1) * 64 * ldk; \
        _Pragma("unroll") for (int j = 0; j < NKP; ++j) __builtin_amdgcn_global_load_lds((const unsigned*)(kp + ksrc[j]), (LAS unsigned*)(ldsb + (KO_) + 8192 * j + ldsw), 16, 0, 0); } while (0)
#define DMA_V(t, VO_) do { const bf16* vp = (t) == 0 ? Vm : Vr + (size_t)((VAR == 1 ? ((t) & 1) + 1 : (t)) - 1) * 64 * ldv; \
        _Pragma("unroll") for (int j = 0; j < NVP; ++j) __builtin_amdgcn_global_load_lds((const unsigned*)(vp + vsrc[j]), (LAS unsigned*)(ldsb + 3 * KB + (VO_) + 8192 * j + ldsw), 16, 0, 0); } while (0)
#define WAITBAR_N() do { if (VAR == 2) asm volatile("s_waitcnt vmcnt(%0) lgkmcnt(0)" :: "n"(NKP + NVP) : "memory"); else if (VAR == 3) asm volatile("s_waitcnt lgkmcnt(0)\n\ts_barrier" ::: "memory"); else asm volatile("s_waitcnt vmcnt(%0) lgkmcnt(0)\n\ts_barrier" :: "n"(NKP + NVP) : "memory"); } while (0)
#define WAITBAR_0() do { if (VAR == 2) asm volatile("s_waitcnt vmcnt(0) lgkmcnt(0)" ::: "memory"); else asm volatile("s_waitcnt vmcnt(0) lgkmcnt(0)\n\ts_barrier" ::: "memory"); } while (0)
    float mhat = 0.f, l_reg = 0.f, ccur = 0.f;
    f32x16 negm;
#pragma unroll
    for (int r = 0; r < 16; ++r) negm[r] = 0.f;
#pragma unroll
    for (int d = 0; d < ND0; ++d) o[d] = (f32x16){0.f, 0.f, 0.f, 0.f, 0.f, 0.f, 0.f, 0.f, 0.f, 0.f, 0.f, 0.f, 0.f, 0.f, 0.f, 0.f};
#define PK4(P, BASE, OUT) do { unsigned a0 = cvtpk(P[BASE + 0], P[BASE + 1]), a1 = cvtpk(P[BASE + 2], P[BASE + 3]), b0_ = cvtpk(P[BASE + 4], P[BASE + 5]), b1_ = cvtpk(P[BASE + 6], P[BASE + 7]); \
        auto r0 = __builtin_amdgcn_permlane32_swap(a0, b0_, false, false); auto r1 = __builtin_amdgcn_permlane32_swap(a1, b1_, false, false); \
        u32x4 w = {r0[0], r1[0], r0[1], r1[1]}; OUT = __builtin_bit_cast(bf16x8, w); } while (0)
#define LOADV(VV, D0) do { _Pragma("unroll") for (int ks_ = 0; ks_ < 4; ++ks_) { VV[2 * ks_] = vtr(vp_ + (D0) * 512 + ks_ * (NCB * 1024)); VV[2 * ks_ + 1] = vtr(vp_ + (D0) * 512 + ks_ * (NCB * 1024) + NCB * 512); } } while (0)
#define VFRAG(VV, ks_) (bf16x8){VV[2 * (ks_)][0], VV[2 * (ks_)][1], VV[2 * (ks_)][2], VV[2 * (ks_)][3], VV[2 * (ks_) + 1][0], VV[2 * (ks_) + 1][1], VV[2 * (ks_) + 1][2], VV[2 * (ks_) + 1][3]}
#define MMAV(VV, D0) do { o[D0] = __builtin_amdgcn_mfma_f32_32x32x16_bf16(pa0, VFRAG(VV, 0), o[D0], 0, 0, 0); if (VAR != 7) { o[D0] = __builtin_amdgcn_mfma_f32_32x32x16_bf16(pa1, VFRAG(VV, 1), o[D0], 0, 0, 0); \
        o[D0] = __builtin_amdgcn_mfma_f32_32x32x16_bf16(pa2, VFRAG(VV, 2), o[D0], 0, 0, 0); o[D0] = __builtin_amdgcn_mfma_f32_32x32x16_bf16(pa3, VFRAG(VV, 3), o[D0], 0, 0, 0); } else { asm volatile("" :: "v"(VV[2]), "v"(VV[3]), "v"(VV[4]), "v"(VV[5]), "v"(VV[6]), "v"(VV[7]), "v"(pa1), "v"(pa2), "v"(pa3)); } } while (0)
#define STEP(MODE_, TR_, KO_, VO_, DMA_STMT) do { \
        f32x16 p0, p1; \
        bool cinit = true;        \
        if ((MODE_) == 0) { cinit = false; \
            float neg_ = NEGBIG, zer_ = 0.f; asm volatile("" : "+v"(neg_), "+v"(zer_)); \
            _Pragma("unroll") for (int r = 0; r < 16; ++r) { p1[r] = neg_; \
                if (r < 8) { if (BIAS) { int idx = crow(r, hi) - NMETA - (qw0 + r32) + 128; idx = idx < 0 ? 0 : idx; p0[r] = btab[idx]; } else p0[r] = zer_; } \
                else p0[r] = neg_; } \
        } else if (BIAS) { \
            const int d = 64 * (TR_) - qw0; \
            if (d <= -154 || d >= 122) { const float cn = btab[d < 0 ? 0 : 256] - mhat; \
                if (__any(cn != ccur)) { ccur = cn; _Pragma("unroll") for (int r = 0; r < 16; ++r) negm[r] = cn; } } \
            else { cinit = false; const int ib = d + 4 * hi - r32 + 128; \
                _Pragma("unroll") for (int r = 0; r < 16; ++r) { int i0 = ib + (r & 3) + 8 * (r >> 2), i1 = i0 + 32; \
                    i0 = i0 < 0 ? 0 : (i0 > 256 ? 256 : i0); i1 = i1 < 0 ? 0 : (i1 > 256 ? 256 : i1); p0[r] = btab[i0] - mhat; p1[r] = btab[i1] - mhat; \
                    if ((r & 3) == 3) asm volatile("" ::: "memory"); } } \
        } \
        { const LAS char* Kb = (const LAS char*)ldsb + (KO_); bf16x8 kp[3][2]; \
          kp[0][0] = *(const LAS bf16x8*)(Kb + KOFF(0)); kp[0][1] = *(const LAS bf16x8*)(Kb + KOFF(0) + 32 * (DQK * 2)); \
          kp[1][0] = *(const LAS bf16x8*)(Kb + KOFF(1)); kp[1][1] = *(const LAS bf16x8*)(Kb + KOFF(1) + 32 * (DQK * 2)); \
          _Pragma("unroll") for (int d0 = 0; d0 < NQ; ++d0) { \
              SBAR(); \
              if (d0 + 2 < NQ) { if (VAR != 6) { kp[(d0 + 2) % 3][0] = *(const LAS bf16x8*)(Kb + KOFF(d0 + 2)); kp[(d0 + 2) % 3][1] = *(const LAS bf16x8*)(Kb + KOFF(d0 + 2) + 32 * (DQK * 2)); } else { kp[(d0 + 2) % 3][0] = kp[d0 % 3][0]; kp[(d0 + 2) % 3][1] = kp[d0 % 3][1]; } } \
              if (d0 == 0 && cinit) { p0 = __builtin_amdgcn_mfma_f32_32x32x16_bf16(kp[0][0], qr[0], negm, 0, 0, 0); p1 = __builtin_amdgcn_mfma_f32_32x32x16_bf16(kp[0][1], qr[0], negm, 0, 0, 0); } \
              else if (VAR != 7 || d0 == 0) { p0 = __builtin_amdgcn_mfma_f32_32x32x16_bf16(kp[d0 % 3][0], qr[d0], p0, 0, 0, 0); p1 = __builtin_amdgcn_mfma_f32_32x32x16_bf16(kp[d0 % 3][1], qr[d0], p1, 0, 0, 0); } \
              else { asm volatile("" :: "v"(kp[d0 % 3][0]), "v"(kp[d0 % 3][1])); } } \
          SBAR(); } \
        const lds_cptr vp_ = vp0 + (VO_); s16x4 va[8], vb[8]; \
        LOADV(va, 0); SBAR(); \
        DMA_STMT; SBAR(); \
          \
        float rm = fmaxf(fmaxf(p0[0], p0[1]), p1[0]); \
        _Pragma("unroll") for (int r = 2; r < 16; r += 2) rm = fmaxf(fmaxf(rm, p0[r]), p0[r + 1]); \
        _Pragma("unroll") for (int r = 1; r < 16; r += 2) rm = fmaxf(fmaxf(rm, p1[r]), p1[(r + 1) & 15]); \
        { auto rr = __builtin_amdgcn_permlane32_swap(__float_as_uint(rm), __float_as_uint(rm), false, false); rm = fmaxf(__uint_as_float(rr[0]), __uint_as_float(rr[1])); } \
        if ((MODE_) == 0 || __builtin_expect(__any(rm > THR_L2), 0)) { \
            const float dl = (MODE_) == 0 ? rm : fmaxf(rm, 0.f); mhat += dl; ccur -= dl; \
            _Pragma("unroll") for (int r = 0; r < 16; ++r) { p0[r] -= dl; p1[r] -= dl; negm[r] = ccur; } \
            if ((MODE_) != 0) { const float f = __builtin_amdgcn_exp2f(-dl); l_reg *= f; \
                if (hi == 0) al_l[r32] = f; asm volatile("s_waitcnt lgkmcnt(0)" ::: "memory"); \
                _Pragma("unroll") for (int d = 0; d < ND0; ++d) _Pragma("unroll") for (int r = 0; r < 16; ++r) o[d][r] *= al_l[crow(r, hi)]; } } \
        float ps = 0.f; \
        if (VAR != 4) { \
        _Pragma("unroll") for (int r = 0; r < 16; ++r) { p0[r] = __builtin_amdgcn_exp2f(p0[r]); ps += p0[r]; } \
        _Pragma("unroll") for (int r = 0; r < 16; ++r) { p1[r] = __builtin_amdgcn_exp2f(p1[r]); ps += p1[r]; } } \
        { auto rr = __builtin_amdgcn_permlane32_swap(__float_as_uint(ps), __float_as_uint(ps), false, false); ps = __uint_as_float(rr[0]) + __uint_as_float(rr[1]); } \
        l_reg += ps; \
        bf16x8 pa0, pa1, pa2, pa3; \
        PK4(p0, 0, pa0); PK4(p0, 8, pa1); PK4(p1, 0, pa2); PK4(p1, 8, pa3); \
        if (VAR != 5) { \
        _Pragma("unroll") for (int d0 = 0; d0 < NCB; d0 += 2) { \
            SBAR(); if (d0 + 1 < NCB) LOADV(vb, d0 + 1); MMAV(va, d0); \
            SBAR(); if (d0 + 2 < NCB) LOADV(va, d0 + 2); if (d0 + 1 < NCB) MMAV(vb, d0 + 1); } \
        } else { asm volatile("" :: "v"(pa0), "v"(pa1), "v"(pa2), "v"(pa3), "v"(va[0]), "v"(va[7])); } \
        SBAR(); } while (0)
    int kc = 0, kn = KB, kf = 2 * KB, vc = 0, vn = VB, vf = 2 * VB;
#define ROT() do { const int a_ = kc; kc = kn; kn = kf; kf = a_; const int b_ = vc; vc = vn; vn = vf; vf = b_; } while (0)
    DMA_K(0, 0); DMA_V(0, 0); DMA_K(1, KB); DMA_V(1, VB); WAITBAR_0();
    STEP(0, 0, kc, vc, { DMA_K(2, kf); DMA_V(2, vf); }); WAITBAR_N(); ROT();
#pragma unroll 1
    for (int t = 1; t <= 30; ++t) { STEP(1, t - 1, kc, vc, { if (VAR != 3) { DMA_K(t + 2, kf); DMA_V(t + 2, vf); } }); WAITBAR_N(); ROT(); }
    STEP(1, 30, kc, vc, {}); WAITBAR_0(); ROT();
    STEP(1, 31, kc, vc, {});
    __syncthreads();
#undef ROT
#undef STEP
#undef LOADV
#undef VFRAG
#undef MMAV
#undef KXW
#undef KOFF
#undef PK4
#undef DMA_K
#undef DMA_V
#undef WAITBAR_N
#undef WAITBAR_0
    l_out = l_reg;
}

template <int VAR = 0> __device__ __forceinline__ void mla_unit(unsigned char* ws, int bl, int h, int qb, LAS unsigned char* ldsb, bool nostore = false) {
    const int tid = opaque(threadIdx.x); int lane = tid & 63, r32 = lane & 31, hi = lane >> 5; const int wid = __builtin_amdgcn_readfirstlane(tid >> 6);
    char* lds = (char*)ldsb; float* wsc = (float*)(lds + LDS_WSC) + wid * 64;
    const size_t rb = (size_t)bl * SEQ; const int q0 = qb * 256;
    const bf16* QM = (const bf16*)(wsp(ws, WS_QM)); const bf16* KM = (const bf16*)(wsp(ws, WS_KM)); const bf16* VM = (const bf16*)(wsp(ws, WS_VM));
    f32x16 o[4]; float l;
    attn_pass<192, 128, false, VAR>(o, l, QM + (rb + q0) * 3072 + h * 192, 3072, KM + rb * 3072 + h * 192, KM + (size_t)MH * 3072 + h * 192, 3072,
                               VM + rb * 2048 + h * 128, VM + (size_t)MH * 2048 + h * 128, 2048, q0, ldsb);
    lane = opaque(lane); r32 = lane & 31; hi = lane >> 5;
    if (hi == 0) wsc[r32] = l; LDS_WAIT();
    bf16* stg = (bf16*)(lds + wid * 8192);
#pragma unroll
    for (int r = 0; r < 16; ++r) { const float rl = __builtin_amdgcn_rcpf(wsc[crow(r, hi)]); const int orow = crow(r, hi);
#pragma unroll
        for (int d0 = 0; d0 < 4; ++d0) { const unsigned w = cvtpk(o[d0][r] * rl, 0.f); stg[orow * 128 + d0 * 32 + r32] = (bf16)(w & 0xffffu); } }
    LDS_WAIT();
    bf16* zp = (bf16*)(wsp(ws, WS_ZA)) + (rb + q0 + wid * 32 + (lane >> 4)) * 2048 + h * 128 + (lane & 15) * 8; const bf16* sp = stg + (lane >> 4) * 128 + (lane & 15) * 8;
#pragma unroll
    for (int i = 0; i < 8; ++i, zp += 4 * 2048, sp += 4 * 128) { asm volatile("" : "+v"(zp));
        const u32x4 s = *(const u32x4*)sp; const u32x4 z = *(const u32x4*)zp; u32x4 w;
#pragma unroll
        for (int e = 0; e < 4; ++e) w[e] = cvtpk(bflo(s[e]) * bflo(z[e]), bfhi(s[e]) * bfhi(z[e]));
        if (!nostore) *(u32x4*)zp = w; }
    __syncthreads();
}
template <int VAR = 0> __device__ __forceinline__ void diff_unit(unsigned char* ws, float* o1s, const float* subln, int bl, int h, int qb, LAS unsigned char* ldsb, bool nostore = false) {
    const int tid = opaque(threadIdx.x); int lane = tid & 63, r32 = lane & 31, hi = lane >> 5; const int wid = __builtin_amdgcn_readfirstlane(tid >> 6);
    char* lds = (char*)ldsb; float* wsc = (float*)(lds + LDS_WSC) + wid * 64; float* wss = (float*)(lds + LDS_WSS) + wid * 32;
    const size_t rb = (size_t)bl * SEQ; const int q0 = qb * 256;
    const bf16* QD = (const bf16*)(wsp(ws, WS_QD)); const bf16* KD = (const bf16*)(wsp(ws, WS_KD)); const bf16* VD = (const bf16*)(wsp(ws, WS_VD));
    { float* bt = (float*)(lds + LDS_BT); const float* src = (const float*)(wsp(ws, WS_TAB) + TAB_BIAS) + h * 260; for (int i = tid; i < 257; i += NTHREADS) bt[i] = src[i]; }
    __syncthreads();
    const float lam = *(const float*)(wsp(ws, WS_TAB) + TAB_LAM);
#pragma unroll 1
    for (int pass = 0; pass < 4; ++pass) {
        const int mp = pass >> 1, vh = pass & 1;
        f32x16 o[4]; float l;
        attn_pass<128, 128, true, VAR>(o, l, QD + (rb + q0) * 2048 + h * 256 + mp * 128, 2048, KD + rb * 2048 + h * 256 + mp * 128, KD + (size_t)MH * 2048 + h * 256 + mp * 128, 2048,
                                  VD + rb * 2048 + h * 256 + vh * 128, VD + (size_t)MH * 2048 + h * 256 + vh * 128, 2048, q0, ldsb);
        lane = opaque(lane); r32 = lane & 31; hi = lane >> 5;
        if (hi == 0) wsc[r32] = l; LDS_WAIT();
        GF* st = (GF*)o1s + ((size_t)blockIdx.x * 8 + wid) * (32 * 256) + vh * 128 + r32;
        if (mp == 0) {
#pragma unroll
            for (int r = 0; r < 16; ++r) { const float rl = __builtin_amdgcn_rcpf(wsc[crow(r, hi)]); GF* sp = st + crow(r, hi) * 256;
#pragma unroll
                for (int d0 = 0; d0 < 4; ++d0) sp[d0 * 32] = o[d0][r] * rl; }
        } else {
#pragma unroll
            for (int r = 0; r < 16; ++r) { const float rl = __builtin_amdgcn_rcpf(wsc[crow(r, hi)]); GF* sp = st + crow(r, hi) * 256; float sq = 0.f;
#pragma unroll
                for (int d0 = 0; d0 < 4; ++d0) { const float y = sp[d0 * 32] - lam * (o[d0][r] * rl); sp[d0 * 32] = y; sq += y * y; }
                sq += __shfl_xor(sq, 1); sq += __shfl_xor(sq, 2); sq += __shfl_xor(sq, 4); sq += __shfl_xor(sq, 8); sq += __shfl_xor(sq, 16);
                if (r32 == 0) { if (vh == 0) wss[crow(r, hi)] = sq; else wss[crow(r, hi)] += sq; } }
        }
        asm volatile("s_waitcnt vmcnt(0) lgkmcnt(0)" ::: "memory");
    }
    { const GF* yp = (const GF*)o1s + ((size_t)blockIdx.x * 8 + wid) * (32 * 256) + (lane >> 5) * 256 + (lane & 31) * 8;
      bf16* zp = (bf16*)(wsp(ws, WS_ZB)) + (rb + q0 + wid * 32 + (lane >> 5)) * 2048 + h * 256 + (lane & 31) * 8;
      const f32x4 g0 = *(const f32x4*)(subln + (lane & 31) * 8), g1 = *(const f32x4*)(subln + (lane & 31) * 8 + 4);
#pragma unroll 4
      for (int i = 0; i < 16; ++i, zp += 2 * 2048, yp += 2 * 256) {
          const float rsn = __builtin_amdgcn_rsqf(wss[2 * i + (lane >> 5)] * (1.f / 256.f) + EPS) * 0.8f;
          const f32x4 y0 = *(const __attribute__((address_space(1))) f32x4*)yp, y1 = *(const __attribute__((address_space(1))) f32x4*)(yp + 4); const u32x4 z = *(const u32x4*)zp; u32x4 w;
          w[0] = cvtpk(y0[0] * rsn * g0[0] * bflo(z[0]), y0[1] * rsn * g0[1] * bfhi(z[0])); w[1] = cvtpk(y0[2] * rsn * g0[2] * bflo(z[1]), y0[3] * rsn * g0[3] * bfhi(z[1]));
          w[2] = cvtpk(y1[0] * rsn * g1[0] * bflo(z[2]), y1[1] * rsn * g1[1] * bfhi(z[2])); w[3] = cvtpk(y1[2] * rsn * g1[2] * bflo(z[3]), y1[3] * rsn * g1[3] * bfhi(z[3]));
          if (!nostore) *(u32x4*)zp = w; } }
    __syncthreads();
}

template <class Map>
__device__ __forceinline__ void transpose_item(const float* __restrict__ W, int Nsrc, int K, bf16* __restrict__ WT, LAS float* scr, int item, int lane, const float* __restrict__ gain, Map map) {
    const int nkb = K / 64, nb = item / nkb, kb = item % nkb, k0 = 64 * kb, n0 = 32 * nb;
    const int sc = map(n0 + (lane & 31));
#pragma unroll 8
    for (int i = 0; i < 32; ++i) { const int kk = 2 * i + (lane >> 5); float v = (sc >= 0) ? W[(size_t)(k0 + kk) * Nsrc + sc] : 0.f; if (gain) v *= gain[k0 + kk]; scr[kk * 33 + (lane & 31)] = v; }
    LDS_WAIT(); asm volatile("" ::: "memory");
    const int c = lane & 7;
#pragma unroll
    for (int j = 0; j < 4; ++j) { const int n = (lane >> 3) + 8 * j; const LAS float* s = scr + (8 * c) * 33 + n;
        u32x4 o; o.x = cvtpk(s[0 * 33], s[1 * 33]); o.y = cvtpk(s[2 * 33], s[3 * 33]); o.z = cvtpk(s[4 * 33], s[5 * 33]); o.w = cvtpk(s[6 * 33], s[7 * 33]);
        *(u32x4*)(WT + (size_t)(n0 + n) * K + k0 + 8 * c) = o; }
    LDS_WAIT(); asm volatile("" ::: "memory");
}
__device__ __forceinline__ int rope_orig(int c) { return 32 * ((c >> 2) & 1) + 4 * (c >> 3) + (c & 3); }
struct MapWin { __device__ int operator()(int n) const { if (n < 1280) return n; if (n < 1536) { const int c = n - 1280; return c < 64 ? 1280 + rope_orig(c) : -1; } return n - 192; } };
struct MapWuq { __device__ int operator()(int n) const { const int h = n >> 8, c = n & 255; if (c < 128) return h * 192 + c; if (c < 192) return h * 192 + 128 + rope_orig(c - 128); return -1; } };
struct MapId { __device__ int operator()(int n) const { return n; } };

__device__ __forceinline__ int t5_bucket(int rel) {
    const int n = rel < 0 ? -rel : rel; int b;
    if (n < 8) b = n; else b = 8 + (n >= 12) + (n >= 16) + (n >= 23) + (n >= 32) + (n >= 46) + (n >= 64) + (n >= 91);
    return b + (rel > 0 ? 16 : 0);
}
__device__ __forceinline__ void rms_row_bf16(const float* __restrict__ xrow, const float* __restrict__ g, bf16* __restrict__ orow, int lane) {
    u32x2* o8 = (u32x2*)orow + lane;
    if (!xrow) {
#pragma unroll
        for (int j = 0; j < 8; ++j) o8[64 * j] = (u32x2){0u, 0u};
        return; }
    const f32x4* xr = (const f32x4*)xrow + lane; const f32x4* gr = (const f32x4*)g + lane;
    f32x4 v[8]; float s = 0.f;
#pragma unroll
    for (int j = 0; j < 8; ++j) { v[j] = xr[64 * j]; s += (v[j][0] * v[j][0] + v[j][1] * v[j][1]) + (v[j][2] * v[j][2] + v[j][3] * v[j][3]); }
    const float rs = __builtin_amdgcn_rsqf(wave_sum(s) * (1.f / 2048.f) + EPS);
#pragma unroll
    for (int j = 0; j < 8; ++j) { const f32x4 gg = gr[64 * j]; const f32x4 y = v[j] * rs * gg; o8[64 * j] = (u32x2){cvtpk(y[0], y[1]), cvtpk(y[2], y[3])}; }
}
__device__ __forceinline__ void p0_prologue(LAS unsigned char* ldsb, int vcu, int G) {
    const int tid = opaque(threadIdx.x), lane = tid & 63; const int wave = __builtin_amdgcn_readfirstlane(tid >> 6);
    LAS float* scr = (LAS float*)(ldsb + wave * 16384);
    const int gw = vcu * NWAVES + wave, NGW = G * NWAVES;
    unsigned char* ws = kws();
    constexpr int I_WIN = (NIN / 32) * 32, I_WUQ = 128 * 12, I_WUKV = 128 * 8, I_SQ = 64 * 32;
    constexpr int NITEMS = I_WIN + I_WUQ + I_WUKV + 3 * I_SQ;
    for (int it = gw; it < NITEMS; it += NGW) {
        int r = it;
        if (r < I_WIN) { transpose_item(kin(4), INW, 2048, (bf16*)(wsp(ws, WS_WIN)), scr, r, lane, nullptr, MapWin()); continue; } r -= I_WIN;
        if (r < I_WUQ) { transpose_item(kin(7), 3072, 768, (bf16*)(wsp(ws, WS_WUQ)), scr, r, lane, kin(5), MapWuq()); continue; } r -= I_WUQ;
        if (r < I_WUKV) { transpose_item(kin(8), 4096, 512, (bf16*)(wsp(ws, WS_WUKV)), scr, r, lane, kin(6), MapId()); continue; } r -= I_WUKV;
        if (r < I_SQ) { transpose_item(kin(15), 2048, 2048, (bf16*)(wsp(ws, WS_WA)), scr, r, lane, nullptr, MapId()); continue; } r -= I_SQ;
        if (r < I_SQ) { transpose_item(kin(16), 2048, 2048, (bf16*)(wsp(ws, WS_WB)), scr, r, lane, nullptr, MapId()); continue; } r -= I_SQ;
        transpose_item(kin(17), 2048, 2048, (bf16*)(wsp(ws, WS_WO)), scr, r, lane, nullptr, MapId());
    }
    bf16* ureal = (bf16*)((unsigned char*)kout() + (size_t)64 * 1024 * 1024); bf16* umeta = (bf16*)(wsp(ws, WS_UMETA));
    for (int m = gw; m < NBATCH * SEQ + 256; m += NGW) {
        if (m < NBATCH * SEQ) rms_row_bf16(kin(0) + (size_t)m * DM, kin(3), ureal + (size_t)m * DM, lane);
        else { const int j = m - NBATCH * SEQ; rms_row_bf16(j < NMETA ? kin(1) + (size_t)j * DM : nullptr, kin(3), umeta + (size_t)j * DM, lane); }
    }
    const int gt = vcu * NTHREADS + tid, NGT = G * NTHREADS;
    float* ctab = (float*)(wsp(ws, WS_TAB) + TAB_COS); float* stab = (float*)(wsp(ws, WS_TAB) + TAB_SIN); float* btab = (float*)(wsp(ws, WS_TAB) + TAB_BIAS);
    for (int i = gt; i < 2064 * 32; i += NGT) { const int pos = i >> 5, k = i & 31; const float inv = powf(10000.f, -(float)k / 32.f); const float ang = (float)pos * inv; ctab[i] = cosf(ang); stab[i] = sinf(ang); }
    for (int i = gt; i < 8 * 257; i += NGT) { const int h = i / 257, j = i % 257; btab[h * 260 + j] = kin(2)[t5_bucket(j - 128) * 8 + h] * LOG2E; }
    if (vcu == 0 && wave == 0) { const float* dl = kin(13);
        float a = dl[lane] * dl[128 + lane] + dl[64 + lane] * dl[192 + lane], b = dl[256 + lane] * dl[384 + lane] + dl[320 + lane] * dl[448 + lane];
        a = wave_sum(a); b = wave_sum(b); if (lane == 0) *(float*)(wsp(ws, WS_TAB) + TAB_LAM) = __expf(a) - __expf(b) + 0.2f; }
}

#ifndef MK_PH_LO
#define MK_PH_LO 0
#define MK_PH_HI 99
#endif
#ifndef MK_ONLY
#define MK_ON(n) 1
#else
#define MK_ON(n) (MK_ONLY == (n))
#endif
#ifndef MK_REPEAT
#define MK_REPEAT -1
#endif
#define MK_REP(n) ((MK_REPEAT == (n)) ? 2 : ((n) == 9 ? 0 : 1))
#define WSL() kws()
template <int half> __device__ __forceinline__ void run_half(LAS unsigned char* lds, const XcdBarrier& xb, int G, int bx, int vcu) {
        unsigned char* ws;
        for (int rep = 0; rep < MK_REP(1); ++rep) { ws = WSL(); if (MK_ON(1)) { SchedP1 S; S.T.init(33, 62, G, bx); S.U = (const char*)kout() + (size_t)64 * 1024 * 1024 + (size_t)half * MH * 2048 * 2; S.Umeta = (const char*)(wsp(ws, WS_UMETA)); S.W = (const char*)(wsp(ws, WS_WIN));
          EpiP1 E{ws, kin(11), kin(12)};
          gemm_phase(lds, 2048, 2048, 32, S, E); } }
        xcd_barrier(xb);
        for (int rep = 0; rep < MK_REP(2); ++rep) { ws = WSL(); if (MK_ON(2)) { SchedP2Q S; S.T.init(32, 16, G, bx); S.CQ = (const char*)(wsp(ws, WS_CQ)); S.W = (const char*)(wsp(ws, WS_WUQ)); EpiP2Q E{ws, kin(9)};
          gemm_phase(lds, 768, 768, 12, S, E); }
        ws = WSL(); if (MK_ON(3)) { SchedP2KV S; S.T.init(33, 16, G, bx); S.CKV = (const char*)(wsp(ws, WS_CKV)); S.W = (const char*)(wsp(ws, WS_WUKV)); EpiP2KV E{ws, kin(10)};
          gemm_phase(lds, 512, 512, 8, S, E); } }
        xcd_barrier(xb);
        for (int rep = 0; rep < ((MK_REPEAT >= 3 && MK_REPEAT <= 5) ? 2 : 1); ++rep) { const bool ns = (rep == 0) && (MK_REPEAT >= 3 && MK_REPEAT <= 5); const bool do_mla = !ns || MK_REPEAT != 5, do_diff = !ns || MK_REPEAT != 4; ws = WSL(); { const int x = vcu >> 5, v = vcu & 31;
          float* o1s = half == 0 ? kout() : (float*)(wsp(ws, WS_WIN));
          if (G == 256) {
#ifdef MK_VARIANT
              if (ns) { if (do_mla) for (int i = 0; i < 2; ++i) { const int pair = 8 * x + 4 * i + (v >> 3); mla_unit<MK_VARIANT>(ws, pair >> 4, pair & 15, v & 7, lds, true); }
                        if (do_diff) { const int pair = 4 * x + (v >> 3); diff_unit<MK_VARIANT>(ws, o1s, kin(14), pair >> 3, pair & 7, v & 7, lds, true); } } else
#endif
              {
              if (MK_ON(4) && do_mla) for (int i = 0; i < 2; ++i) { const int pair = 8 * x + 4 * i + (v >> 3); mla_unit(ws, pair >> 4, pair & 15, v & 7, lds, ns); }
              if (MK_ON(5) && do_diff) { const int pair = 4 * x + (v >> 3); diff_unit(ws, o1s, kin(14), pair >> 3, pair & 7, v & 7, lds, ns); }
              }
          } else {
              if (MK_ON(4)) for (int uidx = bx; uidx < 512; uidx += G) mla_unit(ws, uidx >> 7, (uidx >> 3) & 15, uidx & 7, lds, ns);
              if (MK_ON(5)) for (int uidx = bx; uidx < 256; uidx += G) diff_unit(ws, o1s, kin(14), uidx >> 6, (uidx >> 3) & 7, uidx & 7, lds, ns);
          } } }
        xcd_barrier(xb);
        for (int rep = 0; rep < MK_REP(6); ++rep) { ws = WSL(); if (MK_ON(6)) { SchedP4 S; S.T.init(32, 8, G, bx); S.OA = (const char*)(wsp(ws, WS_ZA)); S.OB = (const char*)(wsp(ws, WS_ZB)); S.WA = (const char*)(wsp(ws, WS_WA)); S.WB = (const char*)(wsp(ws, WS_WB)); S.dbg = kdbg();
          EpiP4 E{ws, kdbg()}; gemm_phase(lds, 2048, 2048, 32, S, E); } }
        xcd_barrier(xb);
        for (int rep = 0; rep < MK_REP(7); ++rep) { ws = WSL(); if (MK_ON(7)) { SchedP5 S; S.T.init(32, 8, G, bx); S.MB = (const char*)(wsp(ws, WS_MB)); S.WO = (const char*)(wsp(ws, WS_WO));
          EpiP5 E{kin(0) + (size_t)half * MH * DM, kout() + (size_t)half * MH * DM}; gemm_phase(lds, 2048, 2048, 32, S, E); } }
    }
__global__ void __launch_bounds__(NTHREADS, 2) mega(Params p) {
    extern __shared__ __attribute__((aligned(16))) unsigned char lds_raw[];
    LAS unsigned char* lds = (LAS unsigned char*)lds_raw;
    cg::grid_group grid = cg::this_grid();
    const int G = gridDim.x, bx = blockIdx.x; const int vcu = (G % 8 == 0) ? (bx % 8) * (G / 8) + bx / 8 : bx;
    if (threadIdx.x < 4) ((LAS unsigned*)(lds + LDS_MISC))[threadIdx.x] = 0u;
    __syncthreads();
    const XcdBarrier xb = xcd_barrier_post((unsigned*)(kws() + WS_CTL) + 4096, (volatile LAS unsigned*)(lds + LDS_MISC));
    { unsigned* xr = (unsigned*)(kws() + WS_CTL) + 8192;
      if (threadIdx.x == 0) ((LAS unsigned*)(lds + LDS_MISC))[2] = xb_add(&xr[64 * (xb.x & 15)], 1u); }
    for (int rep = 0; rep < MK_REP(0); ++rep) { if (MK_ON(0)) p0_prologue(lds, vcu, G); }
    grid.sync();
    for (int rep = 0; rep < MK_REP(9); ++rep) xcd_barrier(xb);
    int lb = bx;
    { unsigned* xr = (unsigned*)(kws() + WS_CTL) + 8192; bool ok = (G % 8 == 0) && xb.x < 8u;
      for (int j = 0; j < 8; ++j) ok = ok && (xb_ld(&xr[64 * j]) == (unsigned)(G / 8));
      const int rank = (int)((volatile LAS unsigned*)(lds + LDS_MISC))[2];
      if (ok) lb = rank * 8 + (int)xb.x; }
    lb = __builtin_amdgcn_readfirstlane(lb);
    const int vcu2 = (G % 8 == 0) ? (lb % 8) * (G / 8) + lb / 8 : lb;
    run_half<0>(lds, xb, G, lb, vcu2);
    run_half<1>(lds, xb, G, lb, vcu2);
}
}
extern "C" void kernel_launch(void* const* d_in, const int* in_sizes, int n_in, void* d_out, int out_size, void* d_ws, size_t ws_size, hipStream_t stream) {
    static int grid_blocks = 0;
    if (!grid_blocks) {
        int dev = 0, cus = 0, per_cu = 0;
        (void)hipGetDevice(&dev);
        (void)hipDeviceGetAttribute(&cus, hipDeviceAttributeMultiprocessorCount, dev);
        (void)hipFuncSetAttribute((const void*)mk::mega, hipFuncAttributeMaxDynamicSharedMemorySize, mk::LDS_BYTES);
        (void)hipOccupancyMaxActiveBlocksPerMultiprocessor(&per_cu, (const void*)mk::mega, mk::NTHREADS, mk::LDS_BYTES);
        if (per_cu < 1) per_cu = 1;
        grid_blocks = cus * per_cu;
        if (ws_size < mk::WS_CTL + mk::CTL_BYTES) { fprintf(stderr, "kernel_launch: workspace too small: %zu < %zu\n", ws_size, (size_t)mk::WS_END); grid_blocks = -1; }
    }
    if (grid_blocks < 0) return;
    (void)hipMemsetAsync((char*)d_ws + mk::WS_CTL, 0, mk::CTL_BYTES, stream);
    mk::Params p{};
    for (int i = 0; i < 18; ++i) p.in[i] = (const float*)d_in[i];
    p.out = (float*)d_out; p.ws = (unsigned char*)d_ws;
    void* args[] = {&p};
    hipError_t e = hipLaunchCooperativeKernel((const void*)mk::mega, dim3(grid_blocks), dim3(mk::NTHREADS), args, mk::LDS_BYTES, stream);
    if (e != hipSuccess) fprintf(stderr, "cooperative launch failed: %s (grid %d)\n", hipGetErrorString(e), grid_blocks);
}
```

```cpp
#include <hip/hip_runtime.h>
#include <hip/hip_cooperative_groups.h>
#include <math.h>
#include <stdint.h>
#include <cstdio>
namespace mk {
namespace cg = cooperative_groups;
#define LAS __attribute__((address_space(3)))
typedef unsigned short bf16;
typedef short bf16x8 __attribute__((ext_vector_type(8)));
typedef short s16x4 __attribute__((ext_vector_type(4)));
typedef float f32x4 __attribute__((ext_vector_type(4)));
typedef float f32x2 __attribute__((ext_vector_type(2)));
typedef float f32x16 __attribute__((ext_vector_type(16)));
typedef unsigned u32x4 __attribute__((ext_vector_type(4)));
typedef unsigned u32x2 __attribute__((ext_vector_type(2)));
typedef __bf16 bf16x2_t __attribute__((ext_vector_type(2)));
typedef __attribute__((address_space(1))) float GF;

constexpr int DM = 2048, NBATCH = 8, SEQ = 2048, NMETA = 16;
constexpr int HB = 4, MH = HB * SEQ, MHK = MH + 256;
constexpr int NIN = 15872;
constexpr int INW = 15680;
constexpr float EPS = 1e-6f, LOG2E = 1.4426950408889634f;
constexpr float QS_MLA = 0.07216878364870322f * LOG2E;
constexpr float QS_DIFF = 0.08838834764831845f * LOG2E;
constexpr int NWAVES = 8, NTHREADS = 512;
constexpr int T_CQ = 0, T_CKV = 3, T_KR = 5, T_ZA = 6, T_QD = 14, T_KD = 22, T_VD = 30, T_ZB = 38, T_GA = 46, T_GB = 54, T_END = 62;

constexpr size_t al(size_t x) { return (x + 4095) / 4096 * 4096; }
constexpr size_t WS_WIN = 0;
constexpr size_t WS_WUQ = WS_WIN + al((size_t)NIN * 2048 * 2);
constexpr size_t WS_WUKV = WS_WUQ + al((size_t)4096 * 768 * 2);
constexpr size_t WS_WA = WS_WUKV + al((size_t)4096 * 512 * 2);
constexpr size_t WS_WB = WS_WA + al((size_t)2048 * 2048 * 2);
constexpr size_t WS_WO = WS_WB + al((size_t)2048 * 2048 * 2);
constexpr size_t WS_UMETA = WS_WO + al((size_t)2048 * 2048 * 2);
constexpr size_t WS_TAB = WS_UMETA + al((size_t)256 * 2048 * 2);
constexpr size_t TAB_COS = 0, TAB_SIN = (size_t)2064 * 32 * 4, TAB_BIAS = 2 * TAB_SIN, TAB_LAM = TAB_BIAS + 8 * 260 * 4;
constexpr size_t WS_CQ = WS_TAB + al(TAB_LAM + 64);
constexpr size_t WS_CKV = WS_CQ + al((size_t)MHK * 768 * 2);
constexpr size_t WS_KR = WS_CKV + al((size_t)MHK * 512 * 2);
constexpr size_t WS_SSP = WS_KR + al((size_t)MHK * 64 * 2);
constexpr size_t SZ_ACT = al((size_t)MHK * 2048 * 2);
constexpr size_t WS_ZA = WS_SSP + al((size_t)MHK * 16 * 4);
constexpr size_t WS_QD = WS_ZA + SZ_ACT, WS_KD = WS_QD + SZ_ACT, WS_VD = WS_KD + SZ_ACT, WS_ZB = WS_VD + SZ_ACT, WS_SA = WS_ZB + SZ_ACT, WS_SB = WS_SA + SZ_ACT;
constexpr size_t WS_QM = WS_SB + SZ_ACT;
constexpr size_t WS_KM = WS_QM + al((size_t)MHK * 3072 * 2);
constexpr size_t WS_VM = WS_KM + al((size_t)MHK * 3072 * 2);
constexpr size_t WS_END = WS_VM + SZ_ACT;
constexpr size_t WS_MB = WS_VM;
constexpr size_t O1S_BYTES = (size_t)256 * 8 * 32 * 256 * 4;
static_assert(WS_WUKV - WS_WIN >= O1S_BYTES, "O1 stash of half 1 overlays WIN_T|WUQ_T");
constexpr size_t WS_CTL = WS_END, CTL_BYTES = 65536;
static_assert(WS_CTL + CTL_BYTES <= (size_t)512 * 1024 * 1024, "workspace");

constexpr int LDS_RING = 0, RING_BYTES = 131072;
constexpr int LDS_X = RING_BYTES;
constexpr int LDS_X2 = LDS_X + 8192;
constexpr int LDS_WSC = LDS_X2 + 1024;
constexpr int LDS_WSS = LDS_WSC + 2048;
constexpr int LDS_BT = LDS_WSS + 1024;
constexpr int LDS_MISC = LDS_BT + 1056;
constexpr int LDS_BYTES = 147456;

struct Params {
    const float* in[18];
    float* out; unsigned char* ws;
    int dbg, pad;
};

#define CAS __attribute__((address_space(4)))
typedef const float* cfp_t; typedef float* fp_t; typedef unsigned char* ucp_t;
__device__ __forceinline__ const float* kin(int k) { const volatile CAS cfp_t* kp = (const volatile CAS cfp_t*)__builtin_amdgcn_kernarg_segment_ptr(); return kp[k]; }
__device__ __forceinline__ float* kout() { const volatile CAS fp_t* kp = (const volatile CAS fp_t*)__builtin_amdgcn_kernarg_segment_ptr(); return kp[18]; }
__device__ __forceinline__ unsigned char* kws() { const volatile CAS ucp_t* kp = (const volatile CAS ucp_t*)__builtin_amdgcn_kernarg_segment_ptr(); return kp[19]; }
__device__ __forceinline__ unsigned char* wsp(unsigned char* ws, size_t off) { unsigned k = (unsigned)(off >> 12); asm volatile("" : "+s"(k)); return ws + ((size_t)k << 12); }
__device__ __forceinline__ int kdbg() { const volatile CAS int* kp = (const volatile CAS int*)__builtin_amdgcn_kernarg_segment_ptr(); return kp[40]; }
__device__ __forceinline__ unsigned cvtpk(float lo, float hi) { f32x2 v = {lo, hi}; bf16x2_t b = __builtin_convertvector(v, bf16x2_t); return __builtin_bit_cast(unsigned, b); }
__device__ __forceinline__ float bflo(unsigned u) { return __builtin_bit_cast(float, u << 16); }
__device__ __forceinline__ float bfhi(unsigned u) { return __builtin_bit_cast(float, u & 0xffff0000u); }
__device__ __forceinline__ float silu_f(float v) { return v * __builtin_amdgcn_rcpf(1.f + __expf(-v)); }
__device__ __forceinline__ float sigm_f(float v) { return __builtin_amdgcn_rcpf(1.f + __expf(-v)); }
__device__ __forceinline__ float wave_sum(float v) {
#pragma unroll
    for (int o = 1; o < 64; o <<= 1) v += __shfl_xor(v, o);
    return v;
}
__device__ __forceinline__ int crow(int r, int hi) { return (r & 3) + 8 * (r >> 2) + 4 * hi; }
__device__ __forceinline__ int opaque(int x) { asm volatile("" : "+v"(x)); return x; }
#define LDS_WAIT() asm volatile("s_waitcnt lgkmcnt(0)" ::: "memory")
#define SBAR() __builtin_amdgcn_sched_barrier(0)


#define XB_TMO      128
#define XB_XCNT(j)  (256  + 64 * (j))
#define XB_XSUB(j)  (1280 + 64 * (j))
#define XB_XGEN(j)  (2304 + 64 * (j))
#define XB_TOP      3328
#define XB_TOPGEN   3392
#define XB_SPIN_CAP (1u << 22)
__device__ __forceinline__ unsigned xb_ld(unsigned* p)              { return __hip_atomic_load(p, __ATOMIC_RELAXED, __HIP_MEMORY_SCOPE_AGENT); }
__device__ __forceinline__ unsigned xb_add(unsigned* p, unsigned v) { return __hip_atomic_fetch_add(p, v, __ATOMIC_RELAXED, __HIP_MEMORY_SCOPE_AGENT); }
__device__ __forceinline__ unsigned xb_xcc_id() { return (unsigned)__builtin_amdgcn_s_getreg((3 << 11) | 20) & 0xFu; }
#define XB_SPIN(cond, bar) do { unsigned _sp = 0; while (cond) { __builtin_amdgcn_s_sleep(1); \
    if ((++_sp & 255u) == 0u) { if (xb_ld(&(bar)[XB_TMO])) break; if (_sp > XB_SPIN_CAP) { atomicAdd(&(bar)[XB_TMO], 1u); break; } } } } while (0)
struct XcdBarrier { unsigned* bar; unsigned x; volatile LAS unsigned* st; };
__device__ __forceinline__ XcdBarrier xcd_barrier_post(unsigned* bar, volatile LAS unsigned* st) {
    XcdBarrier b; b.bar = bar; b.x = xb_xcc_id(); b.st = st;
    if (threadIdx.x == 0) (void)xb_add(&bar[XB_XCNT(b.x)], 1u);
    return b;
}
__device__ __forceinline__ void xcd_barrier_complete(unsigned* bar, unsigned x, unsigned& nloc, unsigned& nx) {
    const unsigned G = gridDim.x * gridDim.y * gridDim.z;
    unsigned sum, cnt, mine, sp = 0u;
    for (;;) {
        sum = 0u; cnt = 0u; mine = 0u;
#pragma unroll
        for (unsigned j = 0; j < 16; ++j) { const unsigned c = xb_ld(&bar[XB_XCNT(j)]); sum += c; cnt += (c > 0u) ? 1u : 0u; mine = (j == x) ? c : mine; }
        if (sum == G) break;
        __builtin_amdgcn_s_sleep(1);
        if ((++sp & 255u) == 0u) { if (xb_ld(&bar[XB_TMO])) break; if (sp > XB_SPIN_CAP) { atomicAdd(&bar[XB_TMO], 1u); break; } }
    }
    nloc = mine > 0u ? mine : 1u; nx = cnt > 0u ? cnt : 1u;
}
__device__ __forceinline__ void xcd_barrier(const XcdBarrier& b) {
    asm volatile("s_waitcnt vmcnt(0)" ::: "memory");
    __syncthreads();
    if (threadIdx.x == 0) {
        unsigned* bar = b.bar;
        __builtin_amdgcn_s_waitcnt(0);
        unsigned nloc = b.st[0], nx = b.st[1];
        if (nloc == 0u) { xcd_barrier_complete(bar, b.x, nloc, nx); b.st[0] = nloc; b.st[1] = nx; }
        const unsigned old = xb_add(&bar[XB_XSUB(b.x)], 1u);
        const unsigned gen = old / nloc;
        if (old + 1u == (gen + 1u) * nloc) {
            __builtin_amdgcn_fence(__ATOMIC_RELEASE, "agent");
            asm volatile("s_waitcnt vmcnt(0)" ::: "memory");
            const unsigned og = xb_add(&bar[XB_TOP], 1u);
            const unsigned tg = og / nx;
            if (og + 1u == (tg + 1u) * nx) xb_add(&bar[XB_TOPGEN], 1u);
            else XB_SPIN(xb_ld(&bar[XB_TOPGEN]) == tg, bar);
            __builtin_amdgcn_fence(__ATOMIC_ACQUIRE, "agent");
            xb_add(&bar[XB_XGEN(b.x)], 1u);
            asm volatile("s_waitcnt vmcnt(0)" ::: "memory");
        } else {
            XB_SPIN(xb_ld(&bar[XB_XGEN(b.x)]) == gen, bar);
            __builtin_amdgcn_fence(__ATOMIC_ACQUIRE, "agent");
            asm volatile("s_waitcnt vmcnt(0)" ::: "memory");
        }
    }
    __syncthreads();
}

constexpr int BM = 256, BK = 64, HALF = 128, HTB = HALF * BK * 2, NXCD = 8, WGM = 8;
__device__ __forceinline__ int lds_byte(int r, int c) { const int st = (r >> 4) * 2 + (c >> 5), rr = r & 15, cc = c & 31, ob = rr * 64 + cc * 2; return st * 1024 + (ob ^ (((ob >> 9) & 1) << 5)); }
__device__ __forceinline__ void stage_rc(int b, int& R, int& C) { const int st = b / 1024, sb = b % 1024, swz = sb ^ (((sb >> 9) & 1) << 5); R = (st >> 1) * 16 + swz / 64; C = (st & 1) * 32 + (swz % 64) / 2; }
__device__ __forceinline__ int perm32(int rho) { const int n = rho >> 4, i = rho & 15; return 8 * (i >> 2) + 4 * n + (i & 3); }

struct Unit { const char* A; const char* B; int pm, pn, kind; };
struct TileOrder {
    int nM, nN, nwg, G, c;
    __device__ void init(int nM_, int nN_, int G_, int c_) { nM = nM_; nN = nN_; nwg = nM * nN; G = G_; c = c_; }
    __device__ bool tile(int i, int& pm, int& pn) const {
        const long L = (long)i * G + c; if (L >= nwg) return false;
        int wgid = (int)L; { const int q = nwg / NXCD, r = nwg % NXCD, xcd = wgid % NXCD, off = wgid / NXCD; wgid = (xcd < r ? xcd * (q + 1) : r * (q + 1) + (xcd - r) * q) + off; }
        const int nig = WGM * nN, gid = wgid / nig, fm = gid * WGM, gsz = (nM - fm) < WGM ? (nM - fm) : WGM;
        pm = fm + ((wgid % nig) % gsz); pn = (wgid % nig) / gsz; return true;
    }
};

typedef f32x4 Acc[2][2][4][2];

template <class Epi, class Sched>
__device__ __forceinline__ void gemm_phase(LAS unsigned char* lds, const int lda, const int ldb, const int nt, const Sched& S, const Epi& E) {
    const int tid = opaque(threadIdx.x), wid = __builtin_amdgcn_readfirstlane(tid >> 6), lane = tid & 63, wr = wid >> 2, wc = wid & 3, fr = lane & 15, fq = lane >> 4;
    unsigned voffA[2], voffB[2];
#pragma unroll
    for (int i = 0; i < 2; ++i) { int R, C; stage_rc(tid * 16 + i * 8192, R, C); const int Rb = (R & ~31) + perm32(R & 31);
        voffA[i] = (unsigned)(R * lda + C) * 2u; voffB[i] = (unsigned)(Rb * ldb + C) * 2u; }
    const size_t kstep = (size_t)(BK * 2);
    const size_t hstepA = (size_t)HALF * lda * 2, hstepB = (size_t)HALF * ldb * 2;
    const unsigned ldsw = (unsigned)wid * 1024u;
    const int aoff = lds_byte(wr * 64 + fr, fq * 8), boff = lds_byte(wc * 32 + fr, fq * 8);
#define PG8_SA(b, h) (((b) * 2 + (h)) * HTB)
#define PG8_SB(b, h) ((4 + (b) * 2 + (h)) * HTB)
#define PG8_STAGE(bufoff, gbase, voff) do { _Pragma("unroll") for (int _i = 0; _i < 2; ++_i) \
        __builtin_amdgcn_global_load_lds((const unsigned*)((const char*)(gbase) + (voff)[_i]), (LAS unsigned*)(lds + (bufoff) + ldsw + _i * 8192), 16, 0, 0); } while (0)
#define PG8_LDA(dst, b, h) do { _Pragma("unroll") for (int m = 0; m < 4; ++m) _Pragma("unroll") for (int k = 0; k < 2; ++k) dst[m][k] = *(const LAS bf16x8*)(lds + PG8_SA(b, h) + aoff + m * 2048 + k * 1024); } while (0)
#define PG8_LDB(dst, b, h) do { _Pragma("unroll") for (int n = 0; n < 2; ++n) _Pragma("unroll") for (int k = 0; k < 2; ++k) dst[n][k] = *(const LAS bf16x8*)(lds + PG8_SB(b, h) + boff + n * 2048 + k * 1024); } while (0)
#define PG8_MMA(ai, bj, At, Bt) do { __builtin_amdgcn_s_setprio(1); _Pragma("unroll") for (int m = 0; m < 4; ++m) _Pragma("unroll") for (int n = 0; n < 2; ++n) _Pragma("unroll") for (int k = 0; k < 2; ++k) \
        acc[ai][bj][m][n] = __builtin_amdgcn_mfma_f32_16x16x32_bf16(Bt[n][k], At[m][k], acc[ai][bj][m][n], 0, 0, 0); __builtin_amdgcn_s_setprio(0); } while (0)
#define PG8_WAIT_V(n) asm volatile("s_waitcnt vmcnt(" #n ")" ::: "memory")
#define PG8_WAIT_L(n) asm volatile("s_waitcnt lgkmcnt(" #n ")" ::: "memory")
#define PG8_BAR __builtin_amdgcn_s_barrier()
#define PG8_SCHED __builtin_amdgcn_sched_barrier(0)
    Unit cur, nxt; int ui = 0;
    if (!S.next(0, cur)) return;
    Acc acc;
#pragma unroll
    for (int a = 0; a < 2; ++a)
#pragma unroll
        for (int b = 0; b < 2; ++b)
#pragma unroll
            for (int m = 0; m < 4; ++m)
#pragma unroll
                for (int n = 0; n < 2; ++n) acc[a][b][m][n] = (f32x4){0.f, 0.f, 0.f, 0.f};
    bf16x8 At[4][2], B0[2][2], B1[2][2];
    const char* cA = cur.A; const char* cB = cur.B;
    PG8_STAGE(PG8_SB(0, 0), cB, voffB); PG8_STAGE(PG8_SB(0, 1), cB + hstepB, voffB); PG8_STAGE(PG8_SA(0, 0), cA, voffA); PG8_STAGE(PG8_SA(0, 1), cA + hstepA, voffA);
    if (wr == 1) PG8_BAR;
    PG8_WAIT_V(2); PG8_BAR;
    PG8_STAGE(PG8_SB(1, 0), cB + kstep, voffB); PG8_STAGE(PG8_SA(1, 0), cA + kstep, voffA); PG8_STAGE(PG8_SB(1, 1), cB + hstepB + kstep, voffB);
    PG8_WAIT_V(6); PG8_BAR;
    for (;;) {
        const bool has_next = S.next(ui + 1, nxt);
        const char* nA = has_next ? nxt.A : cA; const char* nB = has_next ? nxt.B : cB;
        for (int t = 0; t < nt; t += 2) {
            const bool last = (t == nt - 2);
            const char* a1 = cA + (size_t)(t + 1) * kstep;
            const char* a2 = last ? nA : cA + (size_t)(t + 2) * kstep; const char* b2 = last ? nB : cB + (size_t)(t + 2) * kstep;
            const char* a3 = a2 + kstep; const char* b3 = b2 + kstep;
            PG8_LDB(B0, 0, 0); PG8_LDB(B1, 0, 1); PG8_SCHED; PG8_LDA(At, 0, 0); PG8_STAGE(PG8_SA(1, 1), a1 + hstepA, voffA);
            PG8_WAIT_V(8); PG8_WAIT_L(0); PG8_BAR; PG8_MMA(0, 0, At, B0); PG8_MMA(0, 1, At, B1); PG8_BAR; PG8_SCHED;
            PG8_LDA(At, 0, 1); PG8_STAGE(PG8_SB(0, 0), b2, voffB); PG8_STAGE(PG8_SB(0, 1), b2 + hstepB, voffB); PG8_STAGE(PG8_SA(0, 0), a2, voffA);
            PG8_WAIT_V(8); PG8_WAIT_L(0); PG8_BAR; PG8_MMA(1, 0, At, B0); PG8_MMA(1, 1, At, B1); PG8_BAR; PG8_SCHED;
            PG8_LDB(B0, 1, 0); PG8_LDB(B1, 1, 1); PG8_SCHED; PG8_LDA(At, 1, 0); PG8_STAGE(PG8_SA(0, 1), a2 + hstepA, voffA);
            PG8_WAIT_V(8); PG8_WAIT_L(0); PG8_BAR; PG8_MMA(0, 0, At, B0); PG8_MMA(0, 1, At, B1); PG8_BAR; PG8_SCHED;
            PG8_LDA(At, 1, 1); PG8_STAGE(PG8_SB(1, 0), b3, voffB); PG8_STAGE(PG8_SB(1, 1), b3 + hstepB, voffB); PG8_STAGE(PG8_SA(1, 0), a3, voffA);
            PG8_WAIT_V(8); PG8_WAIT_L(0); PG8_BAR; PG8_MMA(1, 0, At, B0); PG8_MMA(1, 1, At, B1); PG8_BAR; PG8_SCHED;
        }
        if (wr == 0) PG8_BAR;
        const bool keep = E(acc, cur, wr, wc, fr, fq, lds);
        if (!has_next) break;
        if (!keep) {
#pragma unroll
            for (int a = 0; a < 2; ++a)
#pragma unroll
                for (int b = 0; b < 2; ++b)
#pragma unroll
                    for (int m = 0; m < 4; ++m)
#pragma unroll
                        for (int n = 0; n < 2; ++n) acc[a][b][m][n] = (f32x4){0.f, 0.f, 0.f, 0.f};
        }
        cur = nxt; cA = nA; cB = nB; ++ui;
        if (wr == 1) PG8_BAR;
    }
    PG8_WAIT_V(0);
    PG8_BAR;
#undef PG8_SA
#undef PG8_SB
#undef PG8_STAGE
#undef PG8_LDA
#undef PG8_LDB
#undef PG8_MMA
#undef PG8_WAIT_V
#undef PG8_WAIT_L
#undef PG8_BAR
#undef PG8_SCHED
}

__device__ __forceinline__ void tile_half_ss(const Acc& acc, LAS unsigned char* lds, int wr, int wc, int fr, int fq, float (&ss)[2][4][2]) {
    LAS float* X = (LAS float*)(lds + LDS_X);
#pragma unroll
    for (int ai = 0; ai < 2; ++ai)
#pragma unroll
        for (int m = 0; m < 4; ++m)
#pragma unroll
            for (int bj = 0; bj < 2; ++bj) {
                const f32x4 a = acc[ai][bj][m][0], b = acc[ai][bj][m][1];
                float s = (a[0] * a[0] + a[1] * a[1]) + (a[2] * a[2] + a[3] * a[3]) + (b[0] * b[0] + b[1] * b[1]) + (b[2] * b[2] + b[3] * b[3]);
                s += __shfl_xor(s, 16); s += __shfl_xor(s, 32);
                if (fq == 0) X[((ai * 128 + wr * 64 + m * 16 + fr) * 2 + bj) * 4 + wc] = s;
            }
    LDS_WAIT(); __builtin_amdgcn_s_barrier(); asm volatile("" ::: "memory");
#pragma unroll
    for (int ai = 0; ai < 2; ++ai)
#pragma unroll
        for (int m = 0; m < 4; ++m)
#pragma unroll
            for (int bj = 0; bj < 2; ++bj) {
                const f32x4 v = *(const LAS f32x4*)(X + ((ai * 128 + wr * 64 + m * 16 + fr) * 2 + bj) * 4);
                ss[ai][m][bj] = (v[0] + v[1]) + (v[2] + v[3]);
            }
}
__device__ __forceinline__ u32x4 pack8(const f32x4 a, const f32x4 b) { u32x4 w; w.x = cvtpk(a[0], a[1]); w.y = cvtpk(a[2], a[3]); w.z = cvtpk(b[0], b[1]); w.w = cvtpk(b[2], b[3]); return w; }

struct EpiP1 {
    unsigned char* ws; const float* gqd; const float* gkd;
    __device__ __forceinline__ bool operator()(Acc& acc, const Unit& u, int wr, int wc, int fr, int fq, LAS unsigned char* lds) const {
        fr = opaque(fr); fq = opaque(fq);
        const int pn = u.pn; const int row0 = u.pm * 256 + wr * 64 + fr;
        const int colw = wc * 32 + 8 * fq;
        if (pn < T_KR) {
            float ss[2][4][2]; tile_half_ss(acc, lds, wr, wc, fr, fq, ss);
            const bool iscq = pn < T_CKV;
            bf16* dst = iscq ? (bf16*)(wsp(ws, WS_CQ)) : (bf16*)(wsp(ws, WS_CKV)); const int ld = iscq ? 768 : 512; const int c0 = iscq ? pn * 256 : (pn - T_CKV) * 256;
            const int chunk0 = iscq ? pn * 2 : 6 + (pn - T_CKV) * 2;
            float* ssp = (float*)(wsp(ws, WS_SSP));
#pragma unroll
            for (int ai = 0; ai < 2; ++ai)
#pragma unroll
                for (int m = 0; m < 4; ++m) { const int row = row0 + ai * 128 + m * 16;
#pragma unroll
                    for (int bj = 0; bj < 2; ++bj) {
                        *(u32x4*)(dst + (size_t)row * ld + c0 + bj * 128 + colw) = pack8(acc[ai][bj][m][0], acc[ai][bj][m][1]);
                        if (wc == 0 && fq == 0) ssp[(size_t)row * 16 + chunk0 + bj] = ss[ai][m][bj];
                    } }
            return false;
        }
        if (pn == T_KR) {
            if (wc < 2) { bf16* dst = (bf16*)(wsp(ws, WS_KR));
#pragma unroll
                for (int ai = 0; ai < 2; ++ai)
#pragma unroll
                    for (int m = 0; m < 4; ++m) { const int row = row0 + ai * 128 + m * 16; *(u32x4*)(dst + (size_t)row * 64 + colw) = pack8(acc[ai][0][m][0], acc[ai][0][m][1]); } }
            return false;
        }
        if (pn >= T_QD && pn < T_VD) {
            float ss[2][4][2]; tile_half_ss(acc, lds, wr, wc, fr, fq, ss);
            const bool isq = pn < T_KD; const float* g = isq ? gqd : gkd; const float post = isq ? QS_DIFF : 1.f;
            bf16* dst = isq ? (bf16*)(wsp(ws, WS_QD)) : (bf16*)(wsp(ws, WS_KD)); const int c0 = (isq ? pn - T_QD : pn - T_KD) * 256;
            const f32x4 g0 = *(const f32x4*)(g + colw), g1 = *(const f32x4*)(g + colw + 4);
#pragma unroll
            for (int ai = 0; ai < 2; ++ai)
#pragma unroll
                for (int m = 0; m < 4; ++m) { const int row = row0 + ai * 128 + m * 16;
#pragma unroll
                    for (int bj = 0; bj < 2; ++bj) { const float rs = __builtin_amdgcn_rsqf(ss[ai][m][bj] * (1.f / 128.f) + EPS) * post;
                        *(u32x4*)(dst + (size_t)row * 2048 + c0 + bj * 128 + colw) = pack8(acc[ai][bj][m][0] * g0 * rs, acc[ai][bj][m][1] * g1 * rs); } }
            return false;
        }
        int mode; bf16* dst; int c0;
        if (pn < T_QD) { mode = 1; dst = (bf16*)(wsp(ws, WS_ZA)); c0 = (pn - T_ZA) * 256; }
        else if (pn < T_ZB) { mode = 0; dst = (bf16*)(wsp(ws, WS_VD)); c0 = (pn - T_VD) * 256; }
        else if (pn < T_GA) { mode = 1; dst = (bf16*)(wsp(ws, WS_ZB)); c0 = (pn - T_ZB) * 256; }
        else if (pn < T_GB) { mode = 2; dst = (bf16*)(wsp(ws, WS_SA)); c0 = (pn - T_GA) * 256; }
        else { mode = 2; dst = (bf16*)(wsp(ws, WS_SB)); c0 = (pn - T_GB) * 256; }
#pragma unroll
        for (int ai = 0; ai < 2; ++ai)
#pragma unroll
            for (int m = 0; m < 4; ++m) { const int row = row0 + ai * 128 + m * 16;
#pragma unroll
                for (int bj = 0; bj < 2; ++bj) { f32x4 a = acc[ai][bj][m][0], b = acc[ai][bj][m][1];
                    if (mode == 1) {
#pragma unroll
                        for (int e = 0; e < 4; ++e) { a[e] = silu_f(a[e]); b[e] = silu_f(b[e]); } }
                    else if (mode == 2) {
#pragma unroll
                        for (int e = 0; e < 4; ++e) { a[e] = sigm_f(a[e]); b[e] = sigm_f(b[e]); } }
                    *(u32x4*)(dst + (size_t)row * 2048 + c0 + bj * 128 + colw) = pack8(a, b); } }
        return false;
    }
};
struct SchedP1 {
    TileOrder T; const char* U; const char* Umeta; const char* W;
    __device__ __forceinline__ bool next(int i, Unit& u) const {
        int pm, pn; if (!T.tile(i, pm, pn)) return false;
        u.pm = pm; u.pn = pn; u.kind = 0;
        u.A = (pm < 32) ? U + (size_t)pm * 256 * 2048 * 2 : Umeta; u.B = W + (size_t)pn * 256 * 2048 * 2; return true;
    }
};

__device__ __forceinline__ float ssp_rs(const float* ssp, int row, int c0, int n, float invw) {
    float s = 0.f; for (int c = 0; c < n; ++c) s += ssp[(size_t)row * 16 + c0 + c]; return __builtin_amdgcn_rsqf(s * invw + EPS);
}
struct EpiP2Q {
    unsigned char* ws; const float* gq;
    __device__ __forceinline__ bool operator()(Acc& acc, const Unit& u, int wr, int wc, int fr, int fq, LAS unsigned char* lds) const {
        fr = opaque(fr); fq = opaque(fq);
        const int h = u.pn; const int row0 = u.pm * 256 + wr * 64 + fr; const int colw = wc * 32 + 8 * fq;
        const float* ssp = (const float*)(wsp(ws, WS_SSP));
#pragma unroll
        for (int ai = 0; ai < 2; ++ai)
#pragma unroll
            for (int m = 0; m < 4; ++m) { const float rs = ssp_rs(ssp, row0 + ai * 128 + m * 16, 0, 6, 1.f / 768.f);
#pragma unroll
                for (int bj = 0; bj < 2; ++bj) { acc[ai][bj][m][0] *= rs; acc[ai][bj][m][1] *= rs; }
                if (m & 1) asm volatile("" ::: "memory"); }
        float ss[2][4][2]; tile_half_ss(acc, lds, wr, wc, fr, fq, ss);
        bf16* dst = (bf16*)(wsp(ws, WS_QM));
        { const f32x4 g0 = *(const f32x4*)(gq + colw), g1 = *(const f32x4*)(gq + colw + 4);
#pragma unroll
          for (int ai = 0; ai < 2; ++ai)
#pragma unroll
            for (int m = 0; m < 4; ++m) { const int row = row0 + ai * 128 + m * 16;
                const float rs = __builtin_amdgcn_rsqf((ss[ai][m][0] + ss[ai][m][1]) * (1.f / 192.f) + EPS) * QS_MLA;
                *(u32x4*)(dst + (size_t)row * 3072 + h * 192 + colw) = pack8(acc[ai][0][m][0] * g0 * rs, acc[ai][0][m][1] * g1 * rs); } }
        if (wc < 2) {
            const int ib = opaque(16 * wc + 4 * fq);
            const f32x4 gr1 = *(const f32x4*)(gq + 128 + ib), gr2 = *(const f32x4*)(gq + 160 + ib);
            const float* ctab = (const float*)(wsp(ws, WS_TAB) + TAB_COS); const float* stab = (const float*)(wsp(ws, WS_TAB) + TAB_SIN);
#pragma unroll
            for (int ai = 0; ai < 2; ++ai)
#pragma unroll
                for (int m = 0; m < 4; ++m) { const int row = row0 + ai * 128 + m * 16;
                    const float rs = __builtin_amdgcn_rsqf((ss[ai][m][0] + ss[ai][m][1]) * (1.f / 192.f) + EPS) * QS_MLA;
                    const int pos = NMETA + (row & (SEQ - 1));
                    const f32x4 c = *(const f32x4*)(ctab + pos * 32 + ib), sn = *(const f32x4*)(stab + pos * 32 + ib);
                    const f32x4 x1 = acc[ai][1][m][0] * gr1 * rs, x2 = acc[ai][1][m][1] * gr2 * rs;
                    *(u32x4*)(dst + (size_t)row * 3072 + h * 192 + 128 + colw) = pack8(x1 * c - x2 * sn, x2 * c + x1 * sn);
                    asm volatile("" ::: "memory"); }
        }
        return false;
    }
};
struct SchedP2Q {
    TileOrder T; const char* CQ; const char* W;
    __device__ __forceinline__ bool next(int i, Unit& u) const {
        int pm, pn; if (!T.tile(i, pm, pn)) return false;
        u.pm = pm; u.pn = pn; u.kind = 0; u.A = CQ + (size_t)pm * 256 * 768 * 2; u.B = W + (size_t)pn * 256 * 768 * 2; return true;
    }
};
struct EpiP2KV {
    unsigned char* ws; const float* gk;
    __device__ __forceinline__ bool operator()(Acc& acc, const Unit& u, int wr, int wc, int fr, int fq, LAS unsigned char* lds) const {
        fr = opaque(fr); fq = opaque(fq);
        const int h = u.pn; const int row0 = u.pm * 256 + wr * 64 + fr; const int colw = wc * 32 + 8 * fq;
        const float* ssp = (const float*)(wsp(ws, WS_SSP));
#pragma unroll
        for (int ai = 0; ai < 2; ++ai)
#pragma unroll
            for (int m = 0; m < 4; ++m) { const float rs = ssp_rs(ssp, row0 + ai * 128 + m * 16, 6, 4, 1.f / 512.f);
#pragma unroll
                for (int bj = 0; bj < 2; ++bj) { acc[ai][bj][m][0] *= rs; acc[ai][bj][m][1] *= rs; }
                if (m & 1) asm volatile("" ::: "memory"); }
        const int tid = opaque(threadIdx.x), rr = tid >> 1, hf = tid & 1; const int rrow = u.pm * 256 + rr;
        const bf16* kr = (const bf16*)(wsp(ws, WS_KR)) + (size_t)rrow * 64 + hf * 32;
        u32x4 kv[4]; float sr = 0.f;
#pragma unroll
        for (int j = 0; j < 4; ++j) { kv[j] = *(const u32x4*)(kr + j * 8);
#pragma unroll
            for (int e = 0; e < 4; ++e) { const float a = bflo(kv[j][e]), b = bfhi(kv[j][e]); sr += a * a + b * b; } }
        sr += __shfl_xor(sr, 1);
        LAS float* X2 = (LAS float*)(lds + LDS_X2);
        if (hf == 0) X2[rr] = sr;
        float ss[2][4][2]; tile_half_ss(acc, lds, wr, wc, fr, fq, ss);
        const f32x4 g0 = *(const f32x4*)(gk + colw), g1 = *(const f32x4*)(gk + colw + 4);
        bf16* kdst = (bf16*)(wsp(ws, WS_KM)); bf16* vdst = (bf16*)(wsp(ws, WS_VM));
#pragma unroll
        for (int ai = 0; ai < 2; ++ai)
#pragma unroll
            for (int m = 0; m < 4; ++m) { const int trow = ai * 128 + wr * 64 + m * 16 + fr; const int row = u.pm * 256 + trow;
                const float rs = __builtin_amdgcn_rsqf((ss[ai][m][0] + X2[trow]) * (1.f / 192.f) + EPS);
                *(u32x4*)(kdst + (size_t)row * 3072 + h * 192 + colw) = pack8(acc[ai][0][m][0] * g0 * rs, acc[ai][0][m][1] * g1 * rs);
                *(u32x4*)(vdst + (size_t)row * 2048 + h * 128 + colw) = pack8(acc[ai][1][m][0], acc[ai][1][m][1]); }
        { const LAS float* X = (const LAS float*)(lds + LDS_X); const f32x4 pv = *(const LAS f32x4*)(X + (rr * 2 + 0) * 4);
          const float rs = __builtin_amdgcn_rsqf(((pv[0] + pv[1]) + (pv[2] + pv[3]) + sr) * (1.f / 192.f) + EPS);
          const int pos = (u.pm < 32) ? NMETA + (rrow & (SEQ - 1)) : (rr < NMETA ? rr : 0);
          const float* ctab = (const float*)(wsp(ws, WS_TAB) + TAB_COS) + pos * 32; const float* stab = (const float*)(wsp(ws, WS_TAB) + TAB_SIN) + pos * 32;
#pragma unroll
          for (int j = 0; j < 4; ++j) { const int g = hf * 4 + j; const int i0 = 4 * g;
              const f32x4 c = *(const f32x4*)(ctab + i0), s = *(const f32x4*)(stab + i0), gg1 = *(const f32x4*)(gk + 128 + i0), gg2 = *(const f32x4*)(gk + 160 + i0);
              f32x4 x1 = {bflo(kv[j][0]), bfhi(kv[j][0]), bflo(kv[j][1]), bfhi(kv[j][1])}, x2 = {bflo(kv[j][2]), bfhi(kv[j][2]), bflo(kv[j][3]), bfhi(kv[j][3])};
              x1 = x1 * gg1 * rs; x2 = x2 * gg2 * rs;
              *(u32x4*)(kdst + (size_t)rrow * 3072 + h * 192 + 128 + g * 8) = pack8(x1 * c - x2 * s, x2 * c + x1 * s); } }
        return false;
    }
};
struct SchedP2KV {
    TileOrder T; const char* CKV; const char* W;
    __device__ __forceinline__ bool next(int i, Unit& u) const {
        int pm, pn; if (!T.tile(i, pm, pn)) return false;
        u.pm = pm; u.pn = pn; u.kind = 0; u.A = CKV + (size_t)pm * 256 * 512 * 2; u.B = W + (size_t)pn * 256 * 512 * 2; return true;
    }
};

struct EpiP4 {
    unsigned char* ws; int dbg;
    __device__ __forceinline__ bool operator()(Acc& acc, const Unit& u, int wr, int wc, int fr, int fq, LAS unsigned char* lds) const {
        fr = opaque(fr); fq = opaque(fq);
        const int row0 = u.pm * 256 + wr * 64 + fr; const int col0 = u.pn * 256 + wc * 32 + 8 * fq;
        const bf16* sa = (const bf16*)(wsp(ws, WS_SA)); const bf16* sb = (const bf16*)(wsp(ws, WS_SB)); bf16* mb = (bf16*)(wsp(ws, WS_MB));
#pragma unroll
        for (int ai = 0; ai < 2; ++ai)
#pragma unroll
            for (int m = 0; m < 4; ++m) { const int row = row0 + ai * 128 + m * 16;
#pragma unroll
                for (int bj = 0; bj < 2; ++bj) { const size_t off = (size_t)row * 2048 + col0 + bj * 128;
                    const u32x4 b = *(const u32x4*)(sb + off);
                    const f32x4 b0 = {bflo(b[0]), bfhi(b[0]), bflo(b[1]), bfhi(b[1])}, b1 = {bflo(b[2]), bfhi(b[2]), bflo(b[3]), bfhi(b[3])};
                    if (u.kind == 0) { const u32x4 a = *(const u32x4*)(sa + off);
                        const f32x4 a0 = {bflo(a[0]), bfhi(a[0]), bflo(a[1]), bfhi(a[1])}, a1 = {bflo(a[2]), bfhi(a[2]), bflo(a[3]), bfhi(a[3])};
                        if (dbg == 1) { *(u32x4*)(mb + off) = pack8(acc[ai][bj][m][0] * a0, acc[ai][bj][m][1] * a1); } else {
#pragma unroll
                        for (int e = 0; e < 4; ++e) { acc[ai][bj][m][0][e] *= a0[e] * __builtin_amdgcn_rcpf(b0[e]); acc[ai][bj][m][1][e] *= a1[e] * __builtin_amdgcn_rcpf(b1[e]); } } }
                    else *(u32x4*)(mb + off) = pack8(acc[ai][bj][m][0] * b0, acc[ai][bj][m][1] * b1); } }
        return u.kind == 0 && dbg != 1;
    }
};
struct SchedP4 {
    TileOrder T; const char* OA; const char* OB; const char* WA; const char* WB; int dbg;
    __device__ __forceinline__ bool next(int i, Unit& u) const {
        int pm, pn; const int ti = dbg ? i : (i >> 1), kd = dbg ? (dbg - 1) : (i & 1);
        if (!T.tile(ti, pm, pn)) return false;
        u.pm = pm; u.pn = pn; u.kind = kd;
        u.A = (kd ? OB : OA) + (size_t)pm * 256 * 2048 * 2; u.B = (kd ? WB : WA) + (size_t)pn * 256 * 2048 * 2; return true;
    }
};
struct EpiP5 {
    const float* x; float* out;
    __device__ __forceinline__ bool operator()(Acc& acc, const Unit& u, int wr, int wc, int fr, int fq, LAS unsigned char* lds) const {
        fr = opaque(fr); fq = opaque(fq);
        const int row0 = u.pm * 256 + wr * 64 + fr; const int col0 = u.pn * 256 + wc * 32 + 8 * fq;
#pragma unroll
        for (int ai = 0; ai < 2; ++ai)
#pragma unroll
            for (int m = 0; m < 4; ++m) { const int row = row0 + ai * 128 + m * 16;
#pragma unroll
                for (int bj = 0; bj < 2; ++bj) { const size_t off = (size_t)row * 2048 + col0 + bj * 128;
                    const f32x4 x0 = *(const f32x4*)(x + off), x1 = *(const f32x4*)(x + off + 4);
                    *(f32x4*)(out + off) = x0 + acc[ai][bj][m][0]; *(f32x4*)(out + off + 4) = x1 + acc[ai][bj][m][1]; } }
        return false;
    }
};
struct SchedP5 {
    TileOrder T; const char* MB; const char* WO;
    __device__ __forceinline__ bool next(int i, Unit& u) const {
        int pm, pn; if (!T.tile(i, pm, pn)) return false;
        u.pm = pm; u.pn = pn; u.kind = 0; u.A = MB + (size_t)pm * 256 * 2048 * 2; u.B = WO + (size_t)pn * 256 * 2048 * 2; return true;
    }
};

constexpr float NEGBIG = -1e30f;
constexpr float THR_L2 = 8.f * LOG2E;
template <int NCB> __device__ __forceinline__ int v_st(int k, int c) { const int kk = (k & ~0xC) | ((k & 4) << 1) | ((k & 8) >> 1); return ((kk >> 3) * NCB + (c >> 5)) * 512 + ((kk & 7) * 32 + (c & 31)) * 2; }
__device__ __forceinline__ int v_rd_base(int lane) { return ((lane & 3) << 3) | (((lane >> 2) & 3) << 6) | (((lane >> 4) & 1) << 5) | (((lane >> 5) & 1) << 8); }
typedef short v4i16_t __attribute__((ext_vector_type(4)));
typedef LAS const char* lds_cptr;
__device__ __forceinline__ s16x4 vtr(lds_cptr p) { return __builtin_bit_cast(s16x4, __builtin_amdgcn_ds_read_tr16_b64_v4i16((LAS v4i16_t*)p)); }
template <int NCB> __device__ __forceinline__ void pv_all(f32x16* o, lds_cptr vp, bf16x8 pa0, bf16x8 pa1, bf16x8 pa2, bf16x8 pa3) {
    constexpr int KS = NCB * 1024, HF = NCB * 512;
#pragma unroll
    for (int d0 = 0; d0 < NCB; ++d0) {
        const s16x4 l0 = vtr(vp + d0 * 512 + 0 * KS), h0 = vtr(vp + d0 * 512 + 0 * KS + HF), l1 = vtr(vp + d0 * 512 + 1 * KS), h1 = vtr(vp + d0 * 512 + 1 * KS + HF);
        const s16x4 l2 = vtr(vp + d0 * 512 + 2 * KS), h2 = vtr(vp + d0 * 512 + 2 * KS + HF), l3 = vtr(vp + d0 * 512 + 3 * KS), h3 = vtr(vp + d0 * 512 + 3 * KS + HF);
#define PK(L, H) (bf16x8){L[0], L[1], L[2], L[3], H[0], H[1], H[2], H[3]}
        o[d0] = __builtin_amdgcn_mfma_f32_32x32x16_bf16(pa0, PK(l0, h0), o[d0], 0, 0, 0);
        o[d0] = __builtin_amdgcn_mfma_f32_32x32x16_bf16(pa1, PK(l1, h1), o[d0], 0, 0, 0);
        o[d0] = __builtin_amdgcn_mfma_f32_32x32x16_bf16(pa2, PK(l2, h2), o[d0], 0, 0, 0);
        o[d0] = __builtin_amdgcn_mfma_f32_32x32x16_bf16(pa3, PK(l3, h3), o[d0], 0, 0, 0);
#undef PK
    }
}

template <int DQK, int DV, bool BIAS, int VAR = 0>
__device__ __forceinline__ void attn_pass(f32x16 (&o)[DV / 32], float& l_out, const bf16* __restrict__ Q, int ldq, const bf16* __restrict__ Kr, const bf16* __restrict__ Km, int ldk,
                                          const bf16* __restrict__ Vr, const bf16* __restrict__ Vm, int ldv, int q0, LAS unsigned char* ldsb) {
    constexpr int NKP = 64 * DQK * 2 / 8192, NVP = 64 * DV * 2 / 8192, KB = 64 * DQK * 2, VB = 64 * DV * 2, ND0 = DV / 32, NQ = DQK / 16, NCB = DV / 32;
    const int tid = opaque(threadIdx.x), lane = tid & 63, r32 = lane & 31, hi = lane >> 5; const int wid = __builtin_amdgcn_readfirstlane(tid >> 6);
    char* lds = (char*)ldsb;
    float* wsc = (float*)(lds + LDS_WSC) + wid * 64; float* al_l = wsc + 32;
    const float* btab = (const float*)(lds + LDS_BT);
    const int qw0 = q0 + wid * 32;
    bf16x8 qr[NQ];
    { const bf16* Qw = Q + (size_t)(wid * 32 + r32) * ldq + hi * 8;
#pragma unroll
      for (int d0 = 0; d0 < NQ; ++d0) qr[d0] = *(const bf16x8*)(Qw + d0 * 16); }
    const lds_cptr vp0 = (lds_cptr)ldsb + 3 * KB + v_rd_base(lane);
#define KXW(row) ((DQK == 128) ? ((row) & 15) : (((row) >> 1) & 7))
    constexpr int NKO = (DQK == 128) ? 8 : 4;
    int koff[NKO];
#pragma unroll
    for (int d0 = 0; d0 < NKO; ++d0) koff[d0] = r32 * (DQK * 2) + (((2 * d0 + hi) ^ KXW(r32)) << 4);
#define KOFF(d0) (koff[(d0) % NKO] + ((d0) / NKO) * (NKO * 32))
    unsigned ksrc[NKP], vsrc[NVP];
#pragma unroll
    for (int j = 0; j < NKP; ++j) { const int off = 8192 * j + 16 * tid, row = off / (DQK * 2), cpos = (off % (DQK * 2)) >> 4; ksrc[j] = (unsigned)(row * ldk + ((cpos ^ KXW(row)) << 3)); }
#pragma unroll
    for (int j = 0; j < NVP; ++j) { const int off = 8192 * j + 16 * tid, st = off >> 9, kk = (st / NCB) * 8 + ((off & 511) >> 6), c = (st % NCB) * 32 + ((off & 63) >> 1);
        const int k = (kk & ~0xC) | ((kk & 4) << 1) | ((kk & 8) >> 1); vsrc[j] = (unsigned)(k * ldv + c); }
    const unsigned ldsw = (unsigned)wid * 1024u;
#define DMA_K(t, KO_) do { const bf16* kp = (t) == 0 ? Km : Kr + (size_t)((VAR == 1 ? ((t) & 1) + 1 : (t)) - 1) * 64 * ldk; \
        _Pragma("unroll") for (int j = 0; j < NKP; ++j) __builtin_amdgcn_global_load_lds((const unsigned*)(kp + ksrc[j]), (LAS unsigned*)(ldsb + (KO_) + 8192 * j + ldsw), 16, 0, 0); } while (0)
#define DMA_V(t, VO_) do { const bf16* vp = (t) == 0 ? Vm : Vr + (size_t)((VAR == 1 ? ((t) & 1) + 1 : (t)) - 1) * 64 * ldv; \
        _Pragma("unroll") for (int j = 0; j < NVP; ++j) __builtin_amdgcn_global_load_lds((const unsigned*)(vp + vsrc[j]), (LAS unsigned*)(ldsb + 3 * KB + (VO_) + 8192 * j + ldsw), 16, 0, 0); } while (0)
#define WAITBAR_N() do { if (VAR == 2) asm volatile("s_waitcnt vmcnt(%0) lgkmcnt(0)" :: "n"(NKP + NVP) : "memory"); else if (VAR == 3) asm volatile("s_waitcnt lgkmcnt(0)\n\ts_barrier" ::: "memory"); else asm volatile("s_waitcnt vmcnt(%0) lgkmcnt(0)\n\ts_barrier" :: "n"(NKP + NVP) : "memory"); } while (0)
#define WAITBAR_0() do { if (VAR == 2) asm volatile("s_waitcnt vmcnt(0) lgkmcnt(0)" ::: "memory"); else asm volatile("s_waitcnt vmcnt(0) lgkmcnt(0)\n\ts_barrier" ::: "memory"); } while (0)
    float mhat = 0.f, l_reg = 0.f, ccur = 0.f;
    f32x16 negm;
#pragma unroll
    for (int r = 0; r < 16; ++r) negm[r] = 0.f;
#pragma unroll
    for (int d = 0; d < ND0; ++d) o[d] = (f32x16){0.f, 0.f, 0.f, 0.f, 0.f, 0.f, 0.f, 0.f, 0.f, 0.f, 0.f, 0.f, 0.f, 0.f, 0.f, 0.f};
#define PK4(P, BASE, OUT) do { unsigned a0 = cvtpk(P[BASE + 0], P[BASE + 1]), a1 = cvtpk(P[BASE + 2], P[BASE + 3]), b0_ = cvtpk(P[BASE + 4], P[BASE + 5]), b1_ = cvtpk(P[BASE + 6], P[BASE + 7]); \
        auto r0 = __builtin_amdgcn_permlane32_swap(a0, b0_, false, false); auto r1 = __builtin_amdgcn_permlane32_swap(a1, b1_, false, false); \
        u32x4 w = {r0[0], r1[0], r0[1], r1[1]}; OUT = __builtin_bit_cast(bf16x8, w); } while (0)
#define LOADV(VV, D0) do { _Pragma("unroll") for (int ks_ = 0; ks_ < 4; ++ks_) { VV[2 * ks_] = vtr(vp_ + (D0) * 512 + ks_ * (NCB * 1024)); VV[2 * ks_ + 1] = vtr(vp_ + (D0) * 512 + ks_ * (NCB * 1024) + NCB * 512); } } while (0)
#define VFRAG(VV, ks_) (bf16x8){VV[2 * (ks_)][0], VV[2 * (ks_)][1], VV[2 * (ks_)][2], VV[2 * (ks_)][3], VV[2 * (ks_) + 1][0], VV[2 * (ks_) + 1][1], VV[2 * (ks_) + 1][2], VV[2 * (ks_) + 1][3]}
#define MMAV(VV, D0) do { o[D0] = __builtin_amdgcn_mfma_f32_32x32x16_bf16(pa0, VFRAG(VV, 0), o[D0], 0, 0, 0); if (VAR != 7) { o[D0] = __builtin_amdgcn_mfma_f32_32x32x16_bf16(pa1, VFRAG(VV, 1), o[D0], 0, 0, 0); \
        o[D0] = __builtin_amdgcn_mfma_f32_32x32x16_bf16(pa2, VFRAG(VV, 2), o[D0], 0, 0, 0); o[D0] = __builtin_amdgcn_mfma_f32_32x32x16_bf16(pa3, VFRAG(VV, 3), o[D0], 0, 0, 0); } else { asm volatile("" :: "v"(VV[2]), "v"(VV[3]), "v"(VV[4]), "v"(VV[5]), "v"(VV[6]), "v"(VV[7]), "v"(pa1), "v"(pa2), "v"(pa3)); } } while (0)
#define STEP(MODE_, TR_, KO_, VO_, DMA_STMT) do { \
        f32x16 p0, p1; \
        bool cinit = true;        \
        if ((MODE_) == 0) { cinit = false; \
            float neg_ = NEGBIG, zer_ = 0.f; asm volatile("" : "+v"(neg_), "+v"(zer_)); \
            _Pragma("unroll") for (int r = 0; r < 16; ++r) { p1[r] = neg_; \
                if (r < 8) { if (BIAS) { int idx = crow(r, hi) - NMETA - (qw0 + r32) + 128; idx = idx < 0 ? 0 : idx; p0[r] = btab[idx]; } else p0[r] = zer_; } \
                else p0[r] = neg_; } \
        } else if (BIAS) { \
            const int d = 64 * (TR_) - qw0; \
            if (d <= -154 || d >= 122) { const float cn = btab[d < 0 ? 0 : 256] - mhat; \
                if (__any(cn != ccur)) { ccur = cn; _Pragma("unroll") for (int r = 0; r < 16; ++r) negm[r] = cn; } } \
            else { cinit = false; const int ib = d + 4 * hi - r32 + 128; \
                _Pragma("unroll") for (int r = 0; r < 16; ++r) { int i0 = ib + (r & 3) + 8 * (r >> 2), i1 = i0 + 32; \
                    i0 = i0 < 0 ? 0 : (i0 > 256 ? 256 : i0); i1 = i1 < 0 ? 0 : (i1 > 256 ? 256 : i1); p0[r] = btab[i0] - mhat; p1[r] = btab[i1] - mhat; \
                    if ((r & 3) == 3) asm volatile("" ::: "memory"); } } \
        } \
        { const LAS char* Kb = (const LAS char*)ldsb + (KO_); bf16x8 kp[3][2]; \
          kp[0][0] = *(const LAS bf16x8*)(Kb + KOFF(0)); kp[0][1] = *(const LAS bf16x8*)(Kb + KOFF(0) + 32 * (DQK * 2)); \
          kp[1][0] = *(const LAS bf16x8*)(Kb + KOFF(1)); kp[1][1] = *(const LAS bf16x8*)(Kb + KOFF(1) + 32 * (DQK * 2)); \
          _Pragma("unroll") for (int d0 = 0; d0 < NQ; ++d0) { \
              SBAR(); \
              if (d0 + 2 < NQ) { if (VAR != 6) { kp[(d0 + 2) % 3][0] = *(const LAS bf16x8*)(Kb + KOFF(d0 + 2)); kp[(d0 + 2) % 3][1] = *(const LAS bf16x8*)(Kb + KOFF(d0 + 2) + 32 * (DQK * 2)); } else { kp[(d0 + 2) % 3][0] = kp[d0 % 3][0]; kp[(d0 + 2) % 3][1] = kp[d0 % 3][1]; } } \
              if (d0 == 0 && cinit) { p0 = __builtin_amdgcn_mfma_f32_32x32x16_bf16(kp[0][0], qr[0], negm, 0, 0, 0); p1 = __builtin_amdgcn_mfma_f32_32x32x16_bf16(kp[0][1], qr[0], negm, 0, 0, 0); } \
              else if (VAR != 7 || d0 == 0) { p0 = __builtin_amdgcn_mfma_f32_32x32x16_bf16(kp[d0 % 3][0], qr[d0], p0, 0, 0, 0); p1 = __builtin_amdgcn_mfma_f32_32x32x16_bf16(kp[d0 % 3][1], qr[d0], p1, 0, 0, 0); } \
              else { asm volatile("" :: "v"(kp[d0 % 3][0]), "v"(kp[d0 % 3][1])); } } \
          SBAR(); } \
        const lds_cptr vp_ = vp0 + (VO_); s16x4 va[8], vb[8]; \
        LOADV(va, 0); SBAR(); \
        DMA_STMT; SBAR(); \
          \
        float rm = fmaxf(fmaxf(p0[0], p0[1]), p1[0]); \
        _Pragma("unroll") for (int r = 2; r < 16; r += 2) rm = fmaxf(fmaxf(rm, p0[r]), p0[r + 1]); \
        _Pragma("unroll") for (int r = 1; r < 16; r += 2) rm = fmaxf(fmaxf(rm, p1[r]), p1[(r + 1) & 15]); \
        { auto rr = __builtin_amdgcn_permlane32_swap(__float_as_uint(rm), __float_as_uint(rm), false, false); rm = fmaxf(__uint_as_float(rr[0]), __uint_as_float(rr[1])); } \
        if ((MODE_) == 0 || __builtin_expect(__any(rm > THR_L2), 0)) { \
            const float dl = (MODE_) == 0 ? rm : fmaxf(rm, 0.f); mhat += dl; ccur -= dl; \
            _Pragma("unroll") for (int r = 0; r < 16; ++r) { p0[r] -= dl; p1[r] -= dl; negm[r] = ccur; } \
            if ((MODE_) != 0) { const float f = __builtin_amdgcn_exp2f(-dl); l_reg *= f; \
                if (hi == 0) al_l[r32] = f; asm volatile("s_waitcnt lgkmcnt(0)" ::: "memory"); \
                _Pragma("unroll") for (int d = 0; d < ND0; ++d) _Pragma("unroll") for (int r = 0; r < 16; ++r) o[d][r] *= al_l[crow(r, hi)]; } } \
        float ps = 0.f; \
        if (VAR != 4) { \
        _Pragma("unroll") for (int r = 0; r < 16; ++r) { p0[r] = __builtin_amdgcn_exp2f(p0[r]); ps += p0[r]; } \
        _Pragma("unroll") for (int r = 0; r < 16; ++r) { p1[r] = __builtin_amdgcn_exp2f(p1[r]); ps += p1[r]; } } \
        { auto rr = __builtin_amdgcn_permlane32_swap(__float_as_uint(ps), __float_as_uint(ps), false, false); ps = __uint_as_float(rr[0]) + __uint_as_float(rr[1]); } \
        l_reg += ps; \
        bf16x8 pa0, pa1, pa2, pa3; \
        PK4(p0, 0, pa0); PK4(p0, 8, pa1); PK4(p1, 0, pa2); PK4(p1, 8, pa3); \
        if (VAR != 5) { \
        _Pragma("unroll") for (int d0 = 0; d0 < NCB; d0 += 2) { \
            SBAR(); if (d0 + 1 < NCB) LOADV(vb, d0 + 1); MMAV(va, d0); \
            SBAR(); if (d0 + 2 < NCB) LOADV(va, d0 + 2); if (d0 + 1 < NCB) MMAV(vb, d0 + 1); } \
        } else { asm volatile("" :: "v"(pa0), "v"(pa1), "v"(pa2), "v"(pa3), "v"(va[0]), "v"(va[7])); } \
        SBAR(); } while (0)
    int kc = 0, kn = KB, kf = 2 * KB, vc = 0, vn = VB, vf = 2 * VB;
#define ROT() do { const int a_ = kc; kc = kn; kn = kf; kf = a_; const int b_ = vc; vc = vn; vn = vf; vf = b_; } while (0)
    DMA_K(0, 0); DMA_V(0, 0); DMA_K(1, KB); DMA_V(1, VB); WAITBAR_0();
    STEP(0, 0, kc, vc, { DMA_K(2, kf); DMA_V(2, vf); }); WAITBAR_N(); ROT();
#pragma unroll 1
    for (int t = 1; t <= 30; ++t) { STEP(1, t - 1, kc, vc, { if (VAR != 3) { DMA_K(t + 2, kf); DMA_V(t + 2, vf); } }); WAITBAR_N(); ROT(); }
    STEP(1, 30, kc, vc, {}); WAITBAR_0(); ROT();
    STEP(1, 31, kc, vc, {});
    __syncthreads();
#undef ROT
#undef STEP
#undef LOADV
#undef VFRAG
#undef MMAV
#undef KXW
#undef KOFF
#undef PK4
#undef DMA_K
#undef DMA_V
#undef WAITBAR_N
#undef WAITBAR_0
    l_out = l_reg;
}

template <int VAR = 0> __device__ __forceinline__ void mla_unit(unsigned char* ws, int bl, int h, int qb, LAS unsigned char* ldsb, bool nostore = false) {
    const int tid = opaque(threadIdx.x); int lane = tid & 63, r32 = lane & 31, hi = lane >> 5; const int wid = __builtin_amdgcn_readfirstlane(tid >> 6);
    char* lds = (char*)ldsb; float* wsc = (float*)(lds + LDS_WSC) + wid * 64;
    const size_t rb = (size_t)bl * SEQ; const int q0 = qb * 256;
    const bf16* QM = (const bf16*)(wsp(ws, WS_QM)); const bf16* KM = (const bf16*)(wsp(ws, WS_KM)); const bf16* VM = (const bf16*)(wsp(ws, WS_VM));
    f32x16 o[4]; float l;
    attn_pass<192, 128, false, VAR>(o, l, QM + (rb + q0) * 3072 + h * 192, 3072, KM + rb * 3072 + h * 192, KM + (size_t)MH * 3072 + h * 192, 3072,
                               VM + rb * 2048 + h * 128, VM + (size_t)MH * 2048 + h * 128, 2048, q0, ldsb);
    lane = opaque(lane); r32 = lane & 31; hi = lane >> 5;
    if (hi == 0) wsc[r32] = l; LDS_WAIT();
    bf16* stg = (bf16*)(lds + wid * 8192);
#pragma unroll
    for (int r = 0; r < 16; ++r) { const float rl = __builtin_amdgcn_rcpf(wsc[crow(r, hi)]); const int orow = crow(r, hi);
#pragma unroll
        for (int d0 = 0; d0 < 4; ++d0) { const unsigned w = cvtpk(o[d0][r] * rl, 0.f); stg[orow * 128 + d0 * 32 + r32] = (bf16)(w & 0xffffu); } }
    LDS_WAIT();
    bf16* zp = (bf16*)(wsp(ws, WS_ZA)) + (rb + q0 + wid * 32 + (lane >> 4)) * 2048 + h * 128 + (lane & 15) * 8; const bf16* sp = stg + (lane >> 4) * 128 + (lane & 15) * 8;
#pragma unroll
    for (int i = 0; i < 8; ++i, zp += 4 * 2048, sp += 4 * 128) { asm volatile("" : "+v"(zp));
        const u32x4 s = *(const u32x4*)sp; const u32x4 z = *(const u32x4*)zp; u32x4 w;
#pragma unroll
        for (int e = 0; e < 4; ++e) w[e] = cvtpk(bflo(s[e]) * bflo(z[e]), bfhi(s[e]) * bfhi(z[e]));
        if (!nostore) *(u32x4*)zp = w; }
    __syncthreads();
}
template <int VAR = 0> __device__ __forceinline__ void diff_unit(unsigned char* ws, float* o1s, const float* subln, int bl, int h, int qb, LAS unsigned char* ldsb, bool nostore = false) {
    const int tid = opaque(threadIdx.x); int lane = tid & 63, r32 = lane & 31, hi = lane >> 5; const int wid = __builtin_amdgcn_readfirstlane(tid >> 6);
    char* lds = (char*)ldsb; float* wsc = (float*)(lds + LDS_WSC) + wid * 64; float* wss = (float*)(lds + LDS_WSS) + wid * 32;
    const size_t rb = (size_t)bl * SEQ; const int q0 = qb * 256;
    const bf16* QD = (const bf16*)(wsp(ws, WS_QD)); const bf16* KD = (const bf16*)(wsp(ws, WS_KD)); const bf16* VD = (const bf16*)(wsp(ws, WS_VD));
    { float* bt = (float*)(lds + LDS_BT); const float* src = (const float*)(wsp(ws, WS_TAB) + TAB_BIAS) + h * 260; for (int i = tid; i < 257; i += NTHREADS) bt[i] = src[i]; }
    __syncthreads();
    const float lam = *(const float*)(wsp(ws, WS_TAB) + TAB_LAM);
#pragma unroll 1
    for (int pass = 0; pass < 4; ++pass) {
        const int mp = pass >> 1, vh = pass & 1;
        f32x16 o[4]; float l;
        attn_pass<128, 128, true, VAR>(o, l, QD + (rb + q0) * 2048 + h * 256 + mp * 128, 2048, KD + rb * 2048 + h * 256 + mp * 128, KD + (size_t)MH * 2048 + h * 256 + mp * 128, 2048,
                                  VD + rb * 2048 + h * 256 + vh * 128, VD + (size_t)MH * 2048 + h * 256 + vh * 128, 2048, q0, ldsb);
        lane = opaque(lane); r32 = lane & 31; hi = lane >> 5;
        if (hi == 0) wsc[r32] = l; LDS_WAIT();
        GF* st = (GF*)o1s + ((size_t)blockIdx.x * 8 + wid) * (32 * 256) + vh * 128 + r32;
        if (mp == 0) {
#pragma unroll
            for (int r = 0; r < 16; ++r) { const float rl = __builtin_amdgcn_rcpf(wsc[crow(r, hi)]); GF* sp = st + crow(r, hi) * 256;
#pragma unroll
                for (int d0 = 0; d0 < 4; ++d0) sp[d0 * 32] = o[d0][r] * rl; }
        } else {
#pragma unroll
            for (int r = 0; r < 16; ++r) { const float rl = __builtin_amdgcn_rcpf(wsc[crow(r, hi)]); GF* sp = st + crow(r, hi) * 256; float sq = 0.f;
#pragma unroll
                for (int d0 = 0; d0 < 4; ++d0) { const float y = sp[d0 * 32] - lam * (o[d0][r] * rl); sp[d0 * 32] = y; sq += y * y; }
                sq += __shfl_xor(sq, 1); sq += __shfl_xor(sq, 2); sq += __shfl_xor(sq, 4); sq += __shfl_xor(sq, 8); sq += __shfl_xor(sq, 16);
                if (r32 == 0) { if (vh == 0) wss[crow(r, hi)] = sq; else wss[crow(r, hi)] += sq; } }
        }
        asm volatile("s_waitcnt vmcnt(0) lgkmcnt(0)" ::: "memory");
    }
    { const GF* yp = (const GF*)o1s + ((size_t)blockIdx.x * 8 + wid) * (32 * 256) + (lane >> 5) * 256 + (lane & 31) * 8;
      bf16* zp = (bf16*)(wsp(ws, WS_ZB)) + (rb + q0 + wid * 32 + (lane >> 5)) * 2048 + h * 256 + (lane & 31) * 8;
      const f32x4 g0 = *(const f32x4*)(subln + (lane & 31) * 8), g1 = *(const f32x4*)(subln + (lane & 31) * 8 + 4);
#pragma unroll 4
      for (int i = 0; i < 16; ++i, zp += 2 * 2048, yp += 2 * 256) {
          const float rsn = __builtin_amdgcn_rsqf(wss[2 * i + (lane >> 5)] * (1.f / 256.f) + EPS) * 0.8f;
          const f32x4 y0 = *(const __attribute__((address_space(1))) f32x4*)yp, y1 = *(const __attribute__((address_space(1))) f32x4*)(yp + 4); const u32x4 z = *(const u32x4*)zp; u32x4 w;
          w[0] = cvtpk(y0[0] * rsn * g0[0] * bflo(z[0]), y0[1] * rsn * g0[1] * bfhi(z[0])); w[1] = cvtpk(y0[2] * rsn * g0[2] * bflo(z[1]), y0[3] * rsn * g0[3] * bfhi(z[1]));
          w[2] = cvtpk(y1[0] * rsn * g1[0] * bflo(z[2]), y1[1] * rsn * g1[1] * bfhi(z[2])); w[3] = cvtpk(y1[2] * rsn * g1[2] * bflo(z[3]), y1[3] * rsn * g1[3] * bfhi(z[3]));
          if (!nostore) *(u32x4*)zp = w; } }
    __syncthreads();
}

template <class Map>
__device__ __forceinline__ void transpose_item(const float* __restrict__ W, int Nsrc, int K, bf16* __restrict__ WT, LAS float* scr, int item, int lane, const float* __restrict__ gain, Map map) {
    const int nkb = K / 64, nb = item / nkb, kb = item % nkb, k0 = 64 * kb, n0 = 32 * nb;
    const int sc = map(n0 + (lane & 31));
    float v[32];
    const float* wp = W + (size_t)(k0 + (lane >> 5)) * Nsrc + (sc >= 0 ? sc : 0);
#pragma unroll
    for (int i = 0; i < 32; ++i) v[i] = wp[(size_t)(2 * i) * Nsrc];
    if (gain) {
#pragma unroll
        for (int i = 0; i < 32; ++i) v[i] *= gain[k0 + 2 * i + (lane >> 5)]; }
#pragma unroll
    for (int i = 0; i < 32; ++i) scr[(2 * i + (lane >> 5)) * 33 + (lane & 31)] = (sc >= 0) ? v[i] : 0.f;
    LDS_WAIT(); asm volatile("" ::: "memory");
    const int c = lane & 7;
#pragma unroll
    for (int j = 0; j < 4; ++j) { const int n = (lane >> 3) + 8 * j; const LAS float* s = scr + (8 * c) * 33 + n;
        u32x4 o; o.x = cvtpk(s[0 * 33], s[1 * 33]); o.y = cvtpk(s[2 * 33], s[3 * 33]); o.z = cvtpk(s[4 * 33], s[5 * 33]); o.w = cvtpk(s[6 * 33], s[7 * 33]);
        *(u32x4*)(WT + (size_t)(n0 + n) * K + k0 + 8 * c) = o; }
    LDS_WAIT(); asm volatile("" ::: "memory");
}
__device__ __forceinline__ int rope_orig(int c) { return 32 * ((c >> 2) & 1) + 4 * (c >> 3) + (c & 3); }
struct MapWin { __device__ int operator()(int n) const { if (n < 1280) return n; if (n < 1536) { const int c = n - 1280; return c < 64 ? 1280 + rope_orig(c) : -1; } return n - 192; } };
struct MapWuq { __device__ int operator()(int n) const { const int h = n >> 8, c = n & 255; if (c < 128) return h * 192 + c; if (c < 192) return h * 192 + 128 + rope_orig(c - 128); return -1; } };
struct MapId { __device__ int operator()(int n) const { return n; } };

__device__ __forceinline__ int t5_bucket(int rel) {
    const int n = rel < 0 ? -rel : rel; int b;
    if (n < 8) b = n; else b = 8 + (n >= 12) + (n >= 16) + (n >= 23) + (n >= 32) + (n >= 46) + (n >= 64) + (n >= 91);
    return b + (rel > 0 ? 16 : 0);
}
__device__ __forceinline__ void rms_row_bf16(const float* __restrict__ xrow, const float* __restrict__ g, bf16* __restrict__ orow, int lane) {
    u32x2* o8 = (u32x2*)orow + lane;
    if (!xrow) {
#pragma unroll
        for (int j = 0; j < 8; ++j) o8[64 * j] = (u32x2){0u, 0u};
        return; }
    const f32x4* xr = (const f32x4*)xrow + lane; const f32x4* gr = (const f32x4*)g + lane;
    f32x4 v[8]; float s = 0.f;
#pragma unroll
    for (int j = 0; j < 8; ++j) { v[j] = xr[64 * j]; s += (v[j][0] * v[j][0] + v[j][1] * v[j][1]) + (v[j][2] * v[j][2] + v[j][3] * v[j][3]); }
    const float rs = __builtin_amdgcn_rsqf(wave_sum(s) * (1.f / 2048.f) + EPS);
#pragma unroll
    for (int j = 0; j < 8; ++j) { const f32x4 gg = gr[64 * j]; const f32x4 y = v[j] * rs * gg; o8[64 * j] = (u32x2){cvtpk(y[0], y[1]), cvtpk(y[2], y[3])}; }
}
__device__ __forceinline__ void p0_prologue(LAS unsigned char* ldsb, int vcu, int G) {
    const int tid = opaque(threadIdx.x), lane = tid & 63; const int wave = __builtin_amdgcn_readfirstlane(tid >> 6);
    LAS float* scr = (LAS float*)(ldsb + wave * 16384);
    const int gw = vcu * NWAVES + wave, NGW = G * NWAVES;
    unsigned char* ws = kws();
    constexpr int I_WIN = (NIN / 32) * 32, I_WUQ = 128 * 12, I_WUKV = 128 * 8, I_SQ = 64 * 32;
    constexpr int NITEMS = I_WIN + I_WUQ + I_WUKV + 3 * I_SQ;
    for (int it = gw; it < NITEMS; it += NGW) {
        int r = it;
        if (r < I_WIN) { transpose_item(kin(4), INW, 2048, (bf16*)(wsp(ws, WS_WIN)), scr, r, lane, nullptr, MapWin()); continue; } r -= I_WIN;
        if (r < I_WUQ) { transpose_item(kin(7), 3072, 768, (bf16*)(wsp(ws, WS_WUQ)), scr, r, lane, kin(5), MapWuq()); continue; } r -= I_WUQ;
        if (r < I_WUKV) { transpose_item(kin(8), 4096, 512, (bf16*)(wsp(ws, WS_WUKV)), scr, r, lane, kin(6), MapId()); continue; } r -= I_WUKV;
        if (r < I_SQ) { transpose_item(kin(15), 2048, 2048, (bf16*)(wsp(ws, WS_WA)), scr, r, lane, nullptr, MapId()); continue; } r -= I_SQ;
        if (r < I_SQ) { transpose_item(kin(16), 2048, 2048, (bf16*)(wsp(ws, WS_WB)), scr, r, lane, nullptr, MapId()); continue; } r -= I_SQ;
        transpose_item(kin(17), 2048, 2048, (bf16*)(wsp(ws, WS_WO)), scr, r, lane, nullptr, MapId());
    }
    bf16* ureal = (bf16*)((unsigned char*)kout() + (size_t)64 * 1024 * 1024); bf16* umeta = (bf16*)(wsp(ws, WS_UMETA));
    for (int m = gw; m < NBATCH * SEQ + 256; m += NGW) {
        if (m < NBATCH * SEQ) rms_row_bf16(kin(0) + (size_t)m * DM, kin(3), ureal + (size_t)m * DM, lane);
        else { const int j = m - NBATCH * SEQ; rms_row_bf16(j < NMETA ? kin(1) + (size_t)j * DM : nullptr, kin(3), umeta + (size_t)j * DM, lane); }
    }
    const int gt = vcu * NTHREADS + tid, NGT = G * NTHREADS;
    float* ctab = (float*)(wsp(ws, WS_TAB) + TAB_COS); float* stab = (float*)(wsp(ws, WS_TAB) + TAB_SIN); float* btab = (float*)(wsp(ws, WS_TAB) + TAB_BIAS);
    for (int i = gt; i < 2064 * 32; i += NGT) { const int pos = i >> 5, k = i & 31; const float inv = powf(10000.f, -(float)k / 32.f); const float ang = (float)pos * inv; ctab[i] = cosf(ang); stab[i] = sinf(ang); }
    for (int i = gt; i < 8 * 257; i += NGT) { const int h = i / 257, j = i % 257; btab[h * 260 + j] = kin(2)[t5_bucket(j - 128) * 8 + h] * LOG2E; }
    if (vcu == 0 && wave == 0) { const float* dl = kin(13);
        float a = dl[lane] * dl[128 + lane] + dl[64 + lane] * dl[192 + lane], b = dl[256 + lane] * dl[384 + lane] + dl[320 + lane] * dl[448 + lane];
        a = wave_sum(a); b = wave_sum(b); if (lane == 0) *(float*)(wsp(ws, WS_TAB) + TAB_LAM) = __expf(a) - __expf(b) + 0.2f; }
}

#ifndef MK_PH_LO
#define MK_PH_LO 0
#define MK_PH_HI 99
#endif
#ifndef MK_ONLY
#define MK_ON(n) 1
#else
#define MK_ON(n) (MK_ONLY == (n))
#endif
#ifndef MK_REPEAT
#define MK_REPEAT -1
#endif
#define MK_REP(n) ((MK_REPEAT == (n)) ? 2 : ((n) == 9 ? 0 : 1))
#define WSL() kws()
template <int half> __device__ __forceinline__ void run_half(LAS unsigned char* lds, const XcdBarrier& xb, int G, int bx, int vcu) {
        unsigned char* ws;
        for (int rep = 0; rep < MK_REP(1); ++rep) { ws = WSL(); if (MK_ON(1)) { SchedP1 S; S.T.init(half == 0 ? 33 : 32, 62, G, bx); S.U = (const char*)kout() + (size_t)64 * 1024 * 1024 + (size_t)half * MH * 2048 * 2; S.Umeta = (const char*)(wsp(ws, WS_UMETA)); S.W = (const char*)(wsp(ws, WS_WIN));
          EpiP1 E{ws, kin(11), kin(12)};
          gemm_phase(lds, 2048, 2048, 32, S, E); } }
        xcd_barrier(xb);
        for (int rep = 0; rep < MK_REP(2); ++rep) { ws = WSL(); if (MK_ON(2)) { SchedP2Q S; S.T.init(32, 16, G, bx); S.CQ = (const char*)(wsp(ws, WS_CQ)); S.W = (const char*)(wsp(ws, WS_WUQ)); EpiP2Q E{ws, kin(9)};
          gemm_phase(lds, 768, 768, 12, S, E); }
        ws = WSL(); if (MK_ON(3)) { SchedP2KV S; S.T.init(half == 0 ? 33 : 32, 16, G, bx); S.CKV = (const char*)(wsp(ws, WS_CKV)); S.W = (const char*)(wsp(ws, WS_WUKV)); EpiP2KV E{ws, kin(10)};
          gemm_phase(lds, 512, 512, 8, S, E); } }
        xcd_barrier(xb);
        for (int rep = 0; rep < ((MK_REPEAT >= 3 && MK_REPEAT <= 5) ? 2 : 1); ++rep) { const bool ns = (rep == 0) && (MK_REPEAT >= 3 && MK_REPEAT <= 5); const bool do_mla = !ns || MK_REPEAT != 5, do_diff = !ns || MK_REPEAT != 4; ws = WSL(); { const int x = vcu >> 5, v = vcu & 31;
          float* o1s = half == 0 ? kout() : (float*)(wsp(ws, WS_WIN));
          if (G == 256) {
#ifdef MK_VARIANT
              if (ns) { if (do_mla) for (int i = 0; i < 2; ++i) { const int pair = 8 * x + 4 * i + (v >> 3); mla_unit<MK_VARIANT>(ws, pair >> 4, pair & 15, v & 7, lds, true); }
                        if (do_diff) { const int pair = 4 * x + (v >> 3); diff_unit<MK_VARIANT>(ws, o1s, kin(14), pair >> 3, pair & 7, v & 7, lds, true); } } else
#endif
              {
              if (MK_ON(4) && do_mla) for (int i = 0; i < 2; ++i) { const int pair = 8 * x + 4 * i + (v >> 3); mla_unit(ws, pair >> 4, pair & 15, v & 7, lds, ns); }
              if (MK_ON(5) && do_diff) { const int pair = 4 * x + (v >> 3); diff_unit(ws, o1s, kin(14), pair >> 3, pair & 7, v & 7, lds, ns); }
              }
          } else {
              if (MK_ON(4)) for (int uidx = bx; uidx < 512; uidx += G) mla_unit(ws, uidx >> 7, (uidx >> 3) & 15, uidx & 7, lds, ns);
              if (MK_ON(5)) for (int uidx = bx; uidx < 256; uidx += G) diff_unit(ws, o1s, kin(14), uidx >> 6, (uidx >> 3) & 7, uidx & 7, lds, ns);
          } } }
        xcd_barrier(xb);
        for (int rep = 0; rep < MK_REP(6); ++rep) { ws = WSL(); if (MK_ON(6)) { SchedP4 S; S.T.init(32, 8, G, bx); S.OA = (const char*)(wsp(ws, WS_ZA)); S.OB = (const char*)(wsp(ws, WS_ZB)); S.WA = (const char*)(wsp(ws, WS_WA)); S.WB = (const char*)(wsp(ws, WS_WB)); S.dbg = kdbg();
          EpiP4 E{ws, kdbg()}; gemm_phase(lds, 2048, 2048, 32, S, E); } }
        xcd_barrier(xb);
        for (int rep = 0; rep < MK_REP(7); ++rep) { ws = WSL(); if (MK_ON(7)) { SchedP5 S; S.T.init(32, 8, G, bx); S.MB = (const char*)(wsp(ws, WS_MB)); S.WO = (const char*)(wsp(ws, WS_WO));
          EpiP5 E{kin(0) + (size_t)half * MH * DM, kout() + (size_t)half * MH * DM}; gemm_phase(lds, 2048, 2048, 32, S, E); } }
    }
__global__ void __launch_bounds__(NTHREADS, 2) mega(Params p) {
    extern __shared__ __attribute__((aligned(16))) unsigned char lds_raw[];
    LAS unsigned char* lds = (LAS unsigned char*)lds_raw;
    cg::grid_group grid = cg::this_grid();
    const int G = gridDim.x, bx = blockIdx.x; const int vcu = (G % 8 == 0) ? (bx % 8) * (G / 8) + bx / 8 : bx;
    if (threadIdx.x < 4) ((LAS unsigned*)(lds + LDS_MISC))[threadIdx.x] = 0u;
    __syncthreads();
    const XcdBarrier xb = xcd_barrier_post((unsigned*)(kws() + WS_CTL) + 4096, (volatile LAS unsigned*)(lds + LDS_MISC));
    { unsigned* xr = (unsigned*)(kws() + WS_CTL) + 8192;
      if (threadIdx.x == 0) ((LAS unsigned*)(lds + LDS_MISC))[2] = xb_add(&xr[64 * (xb.x & 15)], 1u); }
    for (int rep = 0; rep < MK_REP(0); ++rep) { if (MK_ON(0)) p0_prologue(lds, vcu, G); }
    grid.sync();
    for (int rep = 0; rep < MK_REP(9); ++rep) xcd_barrier(xb);
    int lb = bx;
    { unsigned* xr = (unsigned*)(kws() + WS_CTL) + 8192; bool ok = (G % 8 == 0) && xb.x < 8u;
      for (int j = 0; j < 8; ++j) ok = ok && (xb_ld(&xr[64 * j]) == (unsigned)(G / 8));
      const int rank = (int)((volatile LAS unsigned*)(lds + LDS_MISC))[2];
      if (ok) lb = rank * 8 + (int)xb.x; }
    lb = __builtin_amdgcn_readfirstlane(lb);
    const int vcu2 = (G % 8 == 0) ? (lb % 8) * (G / 8) + lb / 8 : lb;
    run_half<0>(lds, xb, G, lb, vcu2);
    run_half<1>(lds, xb, G, lb, vcu2);
}
}
extern "C" void kernel_launch(void* const* d_in, const int* in_sizes, int n_in, void* d_out, int out_size, void* d_ws, size_t ws_size, hipStream_t stream) {
    static int grid_blocks = 0;
    if (!grid_blocks) {
        int dev = 0, cus = 0, per_cu = 0;
        (void)hipGetDevice(&dev);
        (void)hipDeviceGetAttribute(&cus, hipDeviceAttributeMultiprocessorCount, dev);
        (void)hipFuncSetAttribute((const void*)mk::mega, hipFuncAttributeMaxDynamicSharedMemorySize, mk::LDS_BYTES);
        (void)hipOccupancyMaxActiveBlocksPerMultiprocessor(&per_cu, (const void*)mk::mega, mk::NTHREADS, mk::LDS_BYTES);
        if (per_cu < 1) per_cu = 1;
        grid_blocks = cus * per_cu;
        if (ws_size < mk::WS_CTL + mk::CTL_BYTES) { fprintf(stderr, "kernel_launch: workspace too small: %zu < %zu\n", ws_size, (size_t)mk::WS_END); grid_blocks = -1; }
    }
    if (grid_blocks < 0) return;
    (void)hipMemsetAsync((char*)d_ws + mk::WS_CTL, 0, mk::CTL_BYTES, stream);
    mk::Params p{};
    for (int i = 0; i < 18; ++i) p.in[i] = (const float*)d_in[i];
    p.out = (float*)d_out; p.ws = (unsigned char*)d_ws;
    void* args[] = {&p};
    hipError_t e = hipLaunchCooperativeKernel((const void*)mk::mega, dim3(grid_blocks), dim3(mk::NTHREADS), args, mk::LDS_BYTES, stream);
    if (e != hipSuccess) fprintf(stderr, "cooperative launch failed: %s (grid %d)\n", hipGetErrorString(e), grid_blocks);
}
```

```cpp
#include <hip/hip_runtime.h>
#include <hip/hip_cooperative_groups.h>
#include <math.h>
#include <stdint.h>
#include <cstdio>
namespace mk {
namespace cg = cooperative_groups;
#define LAS __attribute__((address_space(3)))
typedef unsigned short bf16;
typedef short bf16x8 __attribute__((ext_vector_type(8)));
typedef short s16x4 __attribute__((ext_vector_type(4)));
typedef float f32x4 __attribute__((ext_vector_type(4)));
typedef float f32x2 __attribute__((ext_vector_type(2)));
typedef float f32x16 __attribute__((ext_vector_type(16)));
typedef unsigned u32x4 __attribute__((ext_vector_type(4)));
typedef unsigned u32x2 __attribute__((ext_vector_type(2)));
typedef __bf16 bf16x2_t __attribute__((ext_vector_type(2)));
typedef __attribute__((address_space(1))) float GF;

constexpr int DM = 2048, NBATCH = 8, SEQ = 2048, NMETA = 16;
constexpr int HB = 4, MH = HB * SEQ, MHK = MH + 256;
constexpr int NIN = 15872;
constexpr int INW = 15680;
constexpr float EPS = 1e-6f, LOG2E = 1.4426950408889634f;
constexpr float QS_MLA = 0.07216878364870322f * LOG2E;
constexpr float QS_DIFF = 0.08838834764831845f * LOG2E;
constexpr int NWAVES = 8, NTHREADS = 512;
constexpr int T_CQ = 0, T_CKV = 3, T_KR = 5, T_ZA = 6, T_QD = 14, T_KD = 22, T_VD = 30, T_ZB = 38, T_GA = 46, T_GB = 54, T_END = 62;

constexpr size_t al(size_t x) { return (x + 4095) / 4096 * 4096; }
constexpr size_t WS_WIN = 0;
constexpr size_t WS_WUQ = WS_WIN + al((size_t)NIN * 2048 * 2);
constexpr size_t WS_WUKV = WS_WUQ + al((size_t)4096 * 768 * 2);
constexpr size_t WS_WA = WS_WUKV + al((size_t)4096 * 512 * 2);
constexpr size_t WS_WB = WS_WA + al((size_t)2048 * 2048 * 2);
constexpr size_t WS_WO = WS_WB + al((size_t)2048 * 2048 * 2);
constexpr size_t WS_UMETA = WS_WO + al((size_t)2048 * 2048 * 2);
constexpr size_t WS_TAB = WS_UMETA + al((size_t)256 * 2048 * 2);
constexpr size_t TAB_COS = 0, TAB_SIN = (size_t)2064 * 32 * 4, TAB_BIAS = 2 * TAB_SIN, TAB_LAM = TAB_BIAS + 8 * 260 * 4;
constexpr size_t WS_CQ = WS_TAB + al(TAB_LAM + 64);
constexpr size_t WS_CKV = WS_CQ + al((size_t)MHK * 768 * 2);
constexpr size_t WS_KR = WS_CKV + al((size_t)MHK * 512 * 2);
constexpr size_t WS_SSP = WS_KR + al((size_t)MHK * 64 * 2);
constexpr size_t SZ_ACT = al((size_t)MHK * 2048 * 2);
constexpr size_t WS_ZA = WS_SSP + al((size_t)MHK * 16 * 4);
constexpr size_t WS_QD = WS_ZA + SZ_ACT, WS_KD = WS_QD + SZ_ACT, WS_VD = WS_KD + SZ_ACT, WS_ZB = WS_VD + SZ_ACT, WS_SA = WS_ZB + SZ_ACT, WS_SB = WS_SA + SZ_ACT;
constexpr size_t WS_QM = WS_SB + SZ_ACT;
constexpr size_t WS_KM = WS_QM + al((size_t)MHK * 3072 * 2);
constexpr size_t WS_VM = WS_KM + al((size_t)MHK * 3072 * 2);
constexpr size_t WS_END = WS_VM + SZ_ACT;
constexpr size_t WS_MB = WS_VM;
constexpr size_t O1S_BYTES = (size_t)256 * 8 * 32 * 256 * 4;
static_assert(WS_WUKV - WS_WIN >= O1S_BYTES, "O1 stash of half 1 overlays WIN_T|WUQ_T");
constexpr size_t WS_CTL = WS_END, CTL_BYTES = 65536;
static_assert(WS_CTL + CTL_BYTES <= (size_t)512 * 1024 * 1024, "workspace");

constexpr int LDS_RING = 0, RING_BYTES = 147456;
constexpr int LDS_X = RING_BYTES;
constexpr int LDS_X2 = LDS_X + 8192;
constexpr int LDS_WSC = LDS_X2 + 1024;
constexpr int LDS_WSS = LDS_WSC + 2048;
constexpr int LDS_BT = LDS_WSS + 1024;
constexpr int LDS_MISC = LDS_BT + 1056;
constexpr int LDS_BYTES = 163840;

struct Params {
    const float* in[18];
    float* out; unsigned char* ws;
    int dbg, pad;
};

#define CAS __attribute__((address_space(4)))
typedef const float* cfp_t; typedef float* fp_t; typedef unsigned char* ucp_t;
__device__ __forceinline__ const float* kin(int k) { const volatile CAS cfp_t* kp = (const volatile CAS cfp_t*)__builtin_amdgcn_kernarg_segment_ptr(); return kp[k]; }
__device__ __forceinline__ float* kout() { const volatile CAS fp_t* kp = (const volatile CAS fp_t*)__builtin_amdgcn_kernarg_segment_ptr(); return kp[18]; }
__device__ __forceinline__ unsigned char* kws() { const volatile CAS ucp_t* kp = (const volatile CAS ucp_t*)__builtin_amdgcn_kernarg_segment_ptr(); return kp[19]; }
__device__ __forceinline__ unsigned char* wsp(unsigned char* ws, size_t off) { unsigned k = (unsigned)(off >> 12); asm volatile("" : "+s"(k)); return ws + ((size_t)k << 12); }
__device__ __forceinline__ int kdbg() { const volatile CAS int* kp = (const volatile CAS int*)__builtin_amdgcn_kernarg_segment_ptr(); return kp[40]; }
__device__ __forceinline__ unsigned cvtpk(float lo, float hi) { f32x2 v = {lo, hi}; bf16x2_t b = __builtin_convertvector(v, bf16x2_t); return __builtin_bit_cast(unsigned, b); }
__device__ __forceinline__ float bflo(unsigned u) { return __builtin_bit_cast(float, u << 16); }
__device__ __forceinline__ float bfhi(unsigned u) { return __builtin_bit_cast(float, u & 0xffff0000u); }
__device__ __forceinline__ float silu_f(float v) { return v * __builtin_amdgcn_rcpf(1.f + __expf(-v)); }
__device__ __forceinline__ float sigm_f(float v) { return __builtin_amdgcn_rcpf(1.f + __expf(-v)); }
__device__ __forceinline__ float wave_sum(float v) {
#pragma unroll
    for (int o = 1; o < 64; o <<= 1) v += __shfl_xor(v, o);
    return v;
}
__device__ __forceinline__ int crow(int r, int hi) { return (r & 3) + 8 * (r >> 2) + 4 * hi; }
__device__ __forceinline__ int opaque(int x) { asm volatile("" : "+v"(x)); return x; }
#define LDS_WAIT() asm volatile("s_waitcnt lgkmcnt(0)" ::: "memory")
#define SBAR() __builtin_amdgcn_sched_barrier(0)


#define XB_TMO      128
#define XB_XCNT(j)  (256  + 64 * (j))
#define XB_XSUB(j)  (1280 + 64 * (j))
#define XB_XGEN(j)  (2304 + 64 * (j))
#define XB_TOP      3328
#define XB_TOPGEN   3392
#define XB_SPIN_CAP (1u << 22)
__device__ __forceinline__ unsigned xb_ld(unsigned* p)              { return __hip_atomic_load(p, __ATOMIC_RELAXED, __HIP_MEMORY_SCOPE_AGENT); }
__device__ __forceinline__ unsigned xb_add(unsigned* p, unsigned v) { return __hip_atomic_fetch_add(p, v, __ATOMIC_RELAXED, __HIP_MEMORY_SCOPE_AGENT); }
__device__ __forceinline__ unsigned xb_xcc_id() { return (unsigned)__builtin_amdgcn_s_getreg((3 << 11) | 20) & 0xFu; }
#define XB_SPIN(cond, bar) do { unsigned _sp = 0; while (cond) { __builtin_amdgcn_s_sleep(1); \
    if ((++_sp & 255u) == 0u) { if (xb_ld(&(bar)[XB_TMO])) break; if (_sp > XB_SPIN_CAP) { atomicAdd(&(bar)[XB_TMO], 1u); break; } } } } while (0)
struct XcdBarrier { unsigned* bar; unsigned x; volatile LAS unsigned* st; };
__device__ __forceinline__ XcdBarrier xcd_barrier_post(unsigned* bar, volatile LAS unsigned* st) {
    XcdBarrier b; b.bar = bar; b.x = xb_xcc_id(); b.st = st;
    if (threadIdx.x == 0) (void)xb_add(&bar[XB_XCNT(b.x)], 1u);
    return b;
}
__device__ __forceinline__ void xcd_barrier_complete(unsigned* bar, unsigned x, unsigned& nloc, unsigned& nx) {
    const unsigned G = gridDim.x * gridDim.y * gridDim.z;
    unsigned sum, cnt, mine, sp = 0u;
    for (;;) {
        sum = 0u; cnt = 0u; mine = 0u;
#pragma unroll
        for (unsigned j = 0; j < 16; ++j) { const unsigned c = xb_ld(&bar[XB_XCNT(j)]); sum += c; cnt += (c > 0u) ? 1u : 0u; mine = (j == x) ? c : mine; }
        if (sum == G) break;
        __builtin_amdgcn_s_sleep(1);
        if ((++sp & 255u) == 0u) { if (xb_ld(&bar[XB_TMO])) break; if (sp > XB_SPIN_CAP) { atomicAdd(&bar[XB_TMO], 1u); break; } }
    }
    nloc = mine > 0u ? mine : 1u; nx = cnt > 0u ? cnt : 1u;
}
__device__ __forceinline__ void xcd_barrier(const XcdBarrier& b) {
    asm volatile("s_waitcnt vmcnt(0)" ::: "memory");
    __syncthreads();
    if (threadIdx.x == 0) {
        unsigned* bar = b.bar;
        __builtin_amdgcn_s_waitcnt(0);
        unsigned nloc = b.st[0], nx = b.st[1];
        if (nloc == 0u) { xcd_barrier_complete(bar, b.x, nloc, nx); b.st[0] = nloc; b.st[1] = nx; }
        const unsigned old = xb_add(&bar[XB_XSUB(b.x)], 1u);
        const unsigned gen = old / nloc;
        if (old + 1u == (gen + 1u) * nloc) {
            __builtin_amdgcn_fence(__ATOMIC_RELEASE, "agent");
            asm volatile("s_waitcnt vmcnt(0)" ::: "memory");
            (void)xb_add(&bar[XB_TOP], 1u);
        }
        XB_SPIN(xb_ld(&bar[XB_TOP]) < (gen + 1u) * nx, bar);
        __builtin_amdgcn_fence(__ATOMIC_ACQUIRE, "agent");
        asm volatile("s_waitcnt vmcnt(0)" ::: "memory");
    }
    __syncthreads();
}

constexpr int BM = 256, BK = 64, HALF = 128, HTB = HALF * BK * 2, NXCD = 8, WGM = 4;
__device__ __forceinline__ int lds_byte(int r, int c) { const int st = (r >> 4) * 2 + (c >> 5), rr = r & 15, cc = c & 31, ob = rr * 64 + cc * 2; return st * 1024 + (ob ^ (((ob >> 9) & 1) << 5)); }
__device__ __forceinline__ void stage_rc(int b, int& R, int& C) { const int st = b / 1024, sb = b % 1024, swz = sb ^ (((sb >> 9) & 1) << 5); R = (st >> 1) * 16 + swz / 64; C = (st & 1) * 32 + (swz % 64) / 2; }
__device__ __forceinline__ int perm32(int rho) { const int n = rho >> 4, i = rho & 15; return 8 * (i >> 2) + 4 * n + (i & 3); }

struct Unit { const char* A; const char* B; int pm, pn, kind; };
struct TileOrder {
    int nM, nN, nwg, G, c;
    __device__ void init(int nM_, int nN_, int G_, int c_) { nM = nM_; nN = nN_; nwg = nM * nN; G = G_; c = c_; }
    __device__ bool tile(int i, int& pm, int& pn) const {
        const long L = (long)i * G + c; if (L >= nwg) return false;
        int wgid = (int)L; { const int q = nwg / NXCD, r = nwg % NXCD, xcd = wgid % NXCD, off = wgid / NXCD; wgid = (xcd < r ? xcd * (q + 1) : r * (q + 1) + (xcd - r) * q) + off; }
        const int nig = WGM * nN, gid = wgid / nig, fm = gid * WGM, gsz = (nM - fm) < WGM ? (nM - fm) : WGM;
        pm = fm + ((wgid % nig) % gsz); pn = (wgid % nig) / gsz; return true;
    }
};

typedef f32x4 Acc[2][2][4][2];

template <class Epi, class Sched>
__device__ __forceinline__ void gemm_phase(LAS unsigned char* lds, const int lda, const int ldb, const int nt, const Sched& S, const Epi& E) {
    const int tid = opaque(threadIdx.x), wid = __builtin_amdgcn_readfirstlane(tid >> 6), lane = tid & 63, wr = wid >> 2, wc = wid & 3, fr = lane & 15, fq = lane >> 4;
    unsigned voffA[2], voffB[2];
#pragma unroll
    for (int i = 0; i < 2; ++i) { int R, C; stage_rc(tid * 16 + i * 8192, R, C); const int Rb = (R & ~31) + perm32(R & 31);
        voffA[i] = (unsigned)(R * lda + C) * 2u; voffB[i] = (unsigned)(Rb * ldb + C) * 2u; }
    const size_t kstep = (size_t)(BK * 2);
    const size_t hstepA = (size_t)HALF * lda * 2, hstepB = (size_t)HALF * ldb * 2;
    const unsigned ldsw = (unsigned)wid * 1024u;
    const int aoff = lds_byte(wr * 64 + fr, fq * 8), boff = lds_byte(wc * 32 + fr, fq * 8);
#define PG8_SA(b, h) (((b) * 2 + (h)) * HTB)
#define PG8_SB(b, h) ((4 + (b) * 2 + (h)) * HTB)
#define PG8_STAGE(bufoff, gbase, voff) do { _Pragma("unroll") for (int _i = 0; _i < 2; ++_i) \
        __builtin_amdgcn_global_load_lds((const unsigned*)((const char*)(gbase) + (voff)[_i]), (LAS unsigned*)(lds + (bufoff) + ldsw + _i * 8192), 16, 0, 0); } while (0)
#define PG8_LDA(dst, b, h) do { _Pragma("unroll") for (int m = 0; m < 4; ++m) _Pragma("unroll") for (int k = 0; k < 2; ++k) dst[m][k] = *(const LAS bf16x8*)(lds + PG8_SA(b, h) + aoff + m * 2048 + k * 1024); } while (0)
#define PG8_LDB(dst, b, h) do { _Pragma("unroll") for (int n = 0; n < 2; ++n) _Pragma("unroll") for (int k = 0; k < 2; ++k) dst[n][k] = *(const LAS bf16x8*)(lds + PG8_SB(b, h) + boff + n * 2048 + k * 1024); } while (0)
#define PG8_MMA(ai, bj, At, Bt) do { __builtin_amdgcn_s_setprio(1); _Pragma("unroll") for (int m = 0; m < 4; ++m) _Pragma("unroll") for (int n = 0; n < 2; ++n) _Pragma("unroll") for (int k = 0; k < 2; ++k) \
        acc[ai][bj][m][n] = __builtin_amdgcn_mfma_f32_16x16x32_bf16(Bt[n][k], At[m][k], acc[ai][bj][m][n], 0, 0, 0); __builtin_amdgcn_s_setprio(0); } while (0)
#define PG8_WAIT_V(n) asm volatile("s_waitcnt vmcnt(" #n ")" ::: "memory")
#define PG8_WAIT_L(n) asm volatile("s_waitcnt lgkmcnt(" #n ")" ::: "memory")
#define PG8_WAIT_VR(r) asm volatile("s_cmp_eq_u32 %0, 0\n\ts_cbranch_scc1 .Lpg8w%=\n\ts_waitcnt vmcnt(24)\n\ts_branch .Lpg8x%=\n.Lpg8w%=:\n\ts_waitcnt vmcnt(8)\n.Lpg8x%=:" :: "s"(r) : "memory", "scc")
#define PG8_BAR __builtin_amdgcn_s_barrier()
#define PG8_SCHED __builtin_amdgcn_sched_barrier(0)
    Unit cur, nxt; int ui = 0, pend = 0;
    if (!S.next(0, cur)) return;
    Acc acc;
#pragma unroll
    for (int a = 0; a < 2; ++a)
#pragma unroll
        for (int b = 0; b < 2; ++b)
#pragma unroll
            for (int m = 0; m < 4; ++m)
#pragma unroll
                for (int n = 0; n < 2; ++n) acc[a][b][m][n] = (f32x4){0.f, 0.f, 0.f, 0.f};
    bf16x8 At[4][2], B0[2][2], B1[2][2];
    const char* cA = cur.A; const char* cB = cur.B;
    PG8_STAGE(PG8_SB(0, 0), cB, voffB); PG8_STAGE(PG8_SB(0, 1), cB + hstepB, voffB); PG8_STAGE(PG8_SA(0, 0), cA, voffA); PG8_STAGE(PG8_SA(0, 1), cA + hstepA, voffA);
    if (wr == 1) PG8_BAR;
    PG8_WAIT_V(2); PG8_BAR;
    PG8_STAGE(PG8_SB(1, 0), cB + kstep, voffB); PG8_STAGE(PG8_SA(1, 0), cA + kstep, voffA); PG8_STAGE(PG8_SB(1, 1), cB + hstepB + kstep, voffB);
    PG8_WAIT_V(6); PG8_BAR;
    for (;;) {
        const bool has_next = S.next(ui + 1, nxt);
        const char* nA = has_next ? nxt.A : cA; const char* nB = has_next ? nxt.B : cB;
#define PG8_TRIP(WV) do { \
            const bool last = (t == nt - 2); \
            const char* a1 = cA + (size_t)(t + 1) * kstep; \
            const char* a2 = last ? nA : cA + (size_t)(t + 2) * kstep; const char* b2 = last ? nB : cB + (size_t)(t + 2) * kstep; \
            const char* a3 = a2 + kstep; const char* b3 = b2 + kstep; \
            PG8_LDB(B0, 0, 0); PG8_LDB(B1, 0, 1); PG8_SCHED; PG8_LDA(At, 0, 0); PG8_STAGE(PG8_SA(1, 1), a1 + hstepA, voffA); \
            if constexpr (Epi::RELAX) PG8_WAIT_VR(WV); else PG8_WAIT_V(8); PG8_WAIT_L(0); PG8_BAR; PG8_MMA(0, 0, At, B0); PG8_MMA(0, 1, At, B1); PG8_BAR; PG8_SCHED; \
            PG8_LDA(At, 0, 1); PG8_STAGE(PG8_SB(0, 0), b2, voffB); PG8_STAGE(PG8_SB(0, 1), b2 + hstepB, voffB); PG8_STAGE(PG8_SA(0, 0), a2, voffA); \
            if constexpr (Epi::RELAX) PG8_WAIT_VR(WV); else PG8_WAIT_V(8); PG8_WAIT_L(0); PG8_BAR; PG8_MMA(1, 0, At, B0); PG8_MMA(1, 1, At, B1); PG8_BAR; PG8_SCHED; \
            PG8_LDB(B0, 1, 0); PG8_LDB(B1, 1, 1); PG8_SCHED; PG8_LDA(At, 1, 0); PG8_STAGE(PG8_SA(0, 1), a2 + hstepA, voffA); \
            if constexpr (Epi::RELAX) PG8_WAIT_VR(WV); else PG8_WAIT_V(8); PG8_WAIT_L(0); PG8_BAR; PG8_MMA(0, 0, At, B0); PG8_MMA(0, 1, At, B1); PG8_BAR; PG8_SCHED; \
            PG8_LDA(At, 1, 1); PG8_STAGE(PG8_SB(1, 0), b3, voffB); PG8_STAGE(PG8_SB(1, 1), b3 + hstepB, voffB); PG8_STAGE(PG8_SA(1, 0), a3, voffA); \
            if constexpr (Epi::RELAX) PG8_WAIT_VR(WV); else PG8_WAIT_V(8); PG8_WAIT_L(0); PG8_BAR; PG8_MMA(1, 0, At, B0); PG8_MMA(1, 1, At, B1); PG8_BAR; PG8_SCHED; } while (0)
        for (int t = 0; t < nt; t += 2) { const int rel = (Epi::RELAX && t == 0) ? ui : 0; PG8_TRIP(rel); }
#undef PG8_TRIP
        if (wr == 0) PG8_BAR;
        int nst = 0;
        const bool keep = E(acc, cur, wr, wc, fr, fq, lds, nst);
        (void)nst; (void)pend;
        if (!has_next) break;
        if (!keep) {
#pragma unroll
            for (int a = 0; a < 2; ++a)
#pragma unroll
                for (int b = 0; b < 2; ++b)
#pragma unroll
                    for (int m = 0; m < 4; ++m)
#pragma unroll
                        for (int n = 0; n < 2; ++n) acc[a][b][m][n] = (f32x4){0.f, 0.f, 0.f, 0.f};
        }
        cur = nxt; cA = nA; cB = nB; ++ui;
        if (wr == 1) PG8_BAR;
    }
    PG8_WAIT_V(0);
    PG8_BAR;
#undef PG8_SA
#undef PG8_SB
#undef PG8_STAGE
#undef PG8_LDA
#undef PG8_LDB
#undef PG8_MMA
#undef PG8_WAIT_V
#undef PG8_WAIT_L
#undef PG8_WAIT_VR
#undef PG8_BAR
#undef PG8_SCHED
}

__device__ __forceinline__ void tile_half_ss(const Acc& acc, LAS unsigned char* lds, int wr, int wc, int fr, int fq, float (&ss)[2][4][2]) {
    LAS float* X = (LAS float*)(lds + LDS_X);
#pragma unroll
    for (int ai = 0; ai < 2; ++ai)
#pragma unroll
        for (int m = 0; m < 4; ++m)
#pragma unroll
            for (int bj = 0; bj < 2; ++bj) {
                const f32x4 a = acc[ai][bj][m][0], b = acc[ai][bj][m][1];
                float s = (a[0] * a[0] + a[1] * a[1]) + (a[2] * a[2] + a[3] * a[3]) + (b[0] * b[0] + b[1] * b[1]) + (b[2] * b[2] + b[3] * b[3]);
                s += __shfl_xor(s, 16); s += __shfl_xor(s, 32);
                if (fq == 0) X[((ai * 128 + wr * 64 + m * 16 + fr) * 2 + bj) * 4 + wc] = s;
            }
    LDS_WAIT(); __builtin_amdgcn_s_barrier(); asm volatile("" ::: "memory");
#pragma unroll
    for (int ai = 0; ai < 2; ++ai)
#pragma unroll
        for (int m = 0; m < 4; ++m)
#pragma unroll
            for (int bj = 0; bj < 2; ++bj) {
                const f32x4 v = *(const LAS f32x4*)(X + ((ai * 128 + wr * 64 + m * 16 + fr) * 2 + bj) * 4);
                ss[ai][m][bj] = (v[0] + v[1]) + (v[2] + v[3]);
            }
}
__device__ __forceinline__ u32x4 pack8(const f32x4 a, const f32x4 b) { u32x4 w; w.x = cvtpk(a[0], a[1]); w.y = cvtpk(a[2], a[3]); w.z = cvtpk(b[0], b[1]); w.w = cvtpk(b[2], b[3]); return w; }

struct EpiP1 {
    static constexpr bool RELAX = true;
    unsigned char* ws; const float* gqd; const float* gkd; bool skip;
    __device__ __forceinline__ bool operator()(Acc& acc, const Unit& u, int wr, int wc, int fr, int fq, LAS unsigned char* lds, int& nst) const {
        if (skip) return false;
        { const int l_ = opaque(threadIdx.x) & 63; fr = l_ & 15; fq = l_ >> 4; }
        const int pn = u.pn; const int row0 = u.pm * 256 + wr * 64 + fr;
        const int colw = wc * 32 + 8 * fq;
        if (pn < T_KR) {
            float ss[2][4][2]; tile_half_ss(acc, lds, wr, wc, fr, fq, ss);
            const bool iscq = pn < T_CKV;
            bf16* dst = iscq ? (bf16*)(wsp(ws, WS_CQ)) : (bf16*)(wsp(ws, WS_CKV)); const int ld = iscq ? 768 : 512; const int c0 = iscq ? pn * 256 : (pn - T_CKV) * 256;
            const int chunk0 = iscq ? pn * 2 : 6 + (pn - T_CKV) * 2;
            float* ssp = (float*)(wsp(ws, WS_SSP));
#pragma unroll
            for (int ai = 0; ai < 2; ++ai)
#pragma unroll
                for (int m = 0; m < 4; ++m) { const int row = row0 + ai * 128 + m * 16;
#pragma unroll
                    for (int bj = 0; bj < 2; ++bj) {
                        *(u32x4*)(dst + (size_t)row * ld + c0 + bj * 128 + colw) = pack8(acc[ai][bj][m][0], acc[ai][bj][m][1]);
                        if (wc == 0 && fq == 0) ssp[(size_t)row * 16 + chunk0 + bj] = ss[ai][m][bj];
                    } }
            nst = 16; return false;
        }
        if (pn == T_KR) {
            { bf16* dst = (bf16*)(wsp(ws, WS_KR)); bf16* dum = (bf16*)(wsp(ws, WS_CTL) + 32768) + (size_t)(threadIdx.x) * 8;
#pragma unroll
                for (int ai = 0; ai < 2; ++ai)
#pragma unroll
                    for (int m = 0; m < 4; ++m) { const int row = row0 + ai * 128 + m * 16; const u32x4 w = pack8(acc[ai][0][m][0], acc[ai][0][m][1]);
                        *(u32x4*)(wc < 2 ? dst + (size_t)row * 64 + colw : dum) = w; *(u32x4*)dum = w; } }
            return false;
        }
        if (pn >= T_QD && pn < T_VD) {
            float ss[2][4][2]; tile_half_ss(acc, lds, wr, wc, fr, fq, ss);
            const bool isq = pn < T_KD; const float* g = isq ? gqd : gkd; const float post = isq ? QS_DIFF : 1.f;
            bf16* dst = isq ? (bf16*)(wsp(ws, WS_QD)) : (bf16*)(wsp(ws, WS_KD)); const int c0 = (isq ? pn - T_QD : pn - T_KD) * 256;
            const f32x4 g0 = *(const f32x4*)(g + colw), g1 = *(const f32x4*)(g + colw + 4);
#pragma unroll
            for (int ai = 0; ai < 2; ++ai)
#pragma unroll
                for (int m = 0; m < 4; ++m) { const int row = row0 + ai * 128 + m * 16;
#pragma unroll
                    for (int bj = 0; bj < 2; ++bj) { const float rs = __builtin_amdgcn_rsqf(ss[ai][m][bj] * (1.f / 128.f) + EPS) * post;
                        *(u32x4*)(dst + (size_t)row * 2048 + c0 + bj * 128 + colw) = pack8(acc[ai][bj][m][0] * g0 * rs, acc[ai][bj][m][1] * g1 * rs); } }
            nst = 16; return false;
        }
        int mode; bf16* dst; int c0;
        if (pn < T_QD) { mode = 1; dst = (bf16*)(wsp(ws, WS_ZA)); c0 = (pn - T_ZA) * 256; }
        else if (pn < T_ZB) { mode = 0; dst = (bf16*)(wsp(ws, WS_VD)); c0 = (pn - T_VD) * 256; }
        else if (pn < T_GA) { mode = 1; dst = (bf16*)(wsp(ws, WS_ZB)); c0 = (pn - T_ZB) * 256; }
        else if (pn < T_GB) { mode = 2; dst = (bf16*)(wsp(ws, WS_SA)); c0 = (pn - T_GA) * 256; }
        else { mode = 2; dst = (bf16*)(wsp(ws, WS_SB)); c0 = (pn - T_GB) * 256; }
#pragma unroll
        for (int ai = 0; ai < 2; ++ai)
#pragma unroll
            for (int m = 0; m < 4; ++m) { const int row = row0 + ai * 128 + m * 16;
#pragma unroll
                for (int bj = 0; bj < 2; ++bj) { f32x4 a = acc[ai][bj][m][0], b = acc[ai][bj][m][1];
                    if (mode == 1) {
#pragma unroll
                        for (int e = 0; e < 4; ++e) { a[e] = silu_f(a[e]); b[e] = silu_f(b[e]); } }
                    else if (mode == 2) {
#pragma unroll
                        for (int e = 0; e < 4; ++e) { a[e] = sigm_f(a[e]); b[e] = sigm_f(b[e]); } }
                    *(u32x4*)(dst + (size_t)row * 2048 + c0 + bj * 128 + colw) = pack8(a, b); } }
        nst = 16; return false;
    }
};
struct SchedP1 {
    TileOrder T; const char* U; const char* Umeta; const char* W;
    __device__ __forceinline__ bool next(int i, Unit& u) const {
        int pm, pn; if (!T.tile(i, pm, pn)) return false;
        u.pm = pm; u.pn = pn; u.kind = 0;
        u.A = (pm < 32) ? U + (size_t)pm * 256 * 2048 * 2 : Umeta; u.B = W + (size_t)pn * 256 * 2048 * 2; return true;
    }
};

__device__ __forceinline__ float ssp_rs(const float* ssp, int row, int c0, int n, float invw) {
    float s = 0.f; for (int c = 0; c < n; ++c) s += ssp[(size_t)row * 16 + c0 + c]; return __builtin_amdgcn_rsqf(s * invw + EPS);
}
struct EpiP2Q {
    static constexpr bool RELAX = false;
    unsigned char* ws; const float* gq; bool skip;
    __device__ __forceinline__ bool operator()(Acc& acc, const Unit& u, int wr, int wc, int fr, int fq, LAS unsigned char* lds, int& nst) const {
        if (skip) return false;
        { const int l_ = opaque(threadIdx.x) & 63; fr = l_ & 15; fq = l_ >> 4; }
        const int h = u.pn; const int row0 = u.pm * 256 + wr * 64 + fr; const int colw = wc * 32 + 8 * fq;
        const float* ssp = (const float*)(wsp(ws, WS_SSP));
        float myrs[2];
        { const float* p0 = ssp + (size_t)(row0 + fq * 16) * 16; const float* p1 = p0 + (size_t)128 * 16;
          const f32x4 a0 = *(const f32x4*)p0, b0 = *(const f32x4*)p1; const f32x2 a1 = *(const f32x2*)(p0 + 4), b1 = *(const f32x2*)(p1 + 4);
          myrs[0] = __builtin_amdgcn_rsqf(((a0[0] + a0[1]) + (a0[2] + a0[3]) + (a1[0] + a1[1])) * (1.f / 768.f) + EPS);
          myrs[1] = __builtin_amdgcn_rsqf(((b0[0] + b0[1]) + (b0[2] + b0[3]) + (b1[0] + b1[1])) * (1.f / 768.f) + EPS); }
        float ss[2][4][2]; tile_half_ss(acc, lds, wr, wc, fr, fq, ss);
        float sc[2][4];
#pragma unroll
        for (int ai = 0; ai < 2; ++ai)
#pragma unroll
            for (int m = 0; m < 4; ++m) { const float rc = __shfl(myrs[ai], fr + 16 * m);
                sc[ai][m] = rc * __builtin_amdgcn_rsqf(rc * rc * (ss[ai][m][0] + ss[ai][m][1]) * (1.f / 192.f) + EPS) * QS_MLA; }
        bf16* dst = (bf16*)(wsp(ws, WS_QM));
        { const f32x4 g0 = *(const f32x4*)(gq + colw), g1 = *(const f32x4*)(gq + colw + 4);
#pragma unroll
          for (int ai = 0; ai < 2; ++ai)
#pragma unroll
            for (int m = 0; m < 4; ++m) { const int row = row0 + ai * 128 + m * 16;
                *(u32x4*)(dst + (size_t)row * 3072 + h * 192 + colw) = pack8(acc[ai][0][m][0] * g0 * sc[ai][m], acc[ai][0][m][1] * g1 * sc[ai][m]); } }
        if (wc < 2) {
            const int ib = opaque(16 * wc + 4 * fq);
            const f32x4 gr1 = *(const f32x4*)(gq + 128 + ib), gr2 = *(const f32x4*)(gq + 160 + ib);
            const float* ctab = (const float*)(wsp(ws, WS_TAB) + TAB_COS); const float* stab = (const float*)(wsp(ws, WS_TAB) + TAB_SIN);
#pragma unroll
            for (int ai = 0; ai < 2; ++ai) {
                f32x4 c[4], sn[4];
#pragma unroll
                for (int m = 0; m < 4; ++m) { const int pos = NMETA + ((row0 + ai * 128 + m * 16) & (SEQ - 1)); c[m] = *(const f32x4*)(ctab + pos * 32 + ib); sn[m] = *(const f32x4*)(stab + pos * 32 + ib); }
#pragma unroll
                for (int m = 0; m < 4; ++m) { const int row = row0 + ai * 128 + m * 16;
                    const f32x4 x1 = acc[ai][1][m][0] * gr1 * sc[ai][m], x2 = acc[ai][1][m][1] * gr2 * sc[ai][m];
                    *(u32x4*)(dst + (size_t)row * 3072 + h * 192 + 128 + colw) = pack8(x1 * c[m] - x2 * sn[m], x2 * c[m] + x1 * sn[m]); }
                asm volatile("" ::: "memory"); }
        }
        nst = 8; return false;
    }
};
struct SchedP2Q {
    TileOrder T; const char* CQ; const char* W;
    __device__ __forceinline__ bool next(int i, Unit& u) const {
        int pm, pn; if (!T.tile(i, pm, pn)) return false;
        u.pm = pm; u.pn = pn; u.kind = 0; u.A = CQ + (size_t)pm * 256 * 768 * 2; u.B = W + (size_t)pn * 256 * 768 * 2; return true;
    }
};
struct EpiP2KV {
    static constexpr bool RELAX = false;
    unsigned char* ws; const float* gk; bool skip;
    __device__ __forceinline__ bool operator()(Acc& acc, const Unit& u, int wr, int wc, int fr, int fq, LAS unsigned char* lds, int& nst) const {
        if (skip) return false;
        { const int l_ = opaque(threadIdx.x) & 63; fr = l_ & 15; fq = l_ >> 4; }
        const int h = u.pn; const int row0 = u.pm * 256 + wr * 64 + fr; const int colw = wc * 32 + 8 * fq;
        const float* ssp = (const float*)(wsp(ws, WS_SSP));
        const int tid = opaque(threadIdx.x), rr = tid >> 1, hf = tid & 1; const int rrow = u.pm * 256 + rr;
        const bf16* kr = (const bf16*)(wsp(ws, WS_KR)) + (size_t)rrow * 64 + hf * 32;
        float sr = 0.f;
        { u32x4 kv[4];
#pragma unroll
          for (int j = 0; j < 4; ++j) kv[j] = *(const u32x4*)(kr + j * 8);
#pragma unroll
          for (int j = 0; j < 4; ++j)
#pragma unroll
            for (int e = 0; e < 4; ++e) { const float a = bflo(kv[j][e]), b = bfhi(kv[j][e]); sr += a * a + b * b; } }
        sr += __shfl_xor(sr, 1);
        float myrs[2];
        { const float* p0 = ssp + (size_t)(row0 + fq * 16) * 16 + 6; const float* p1 = p0 + (size_t)128 * 16;
          const f32x2 a0 = *(const f32x2*)p0, a1 = *(const f32x2*)(p0 + 2), b0 = *(const f32x2*)p1, b1 = *(const f32x2*)(p1 + 2);
          myrs[0] = __builtin_amdgcn_rsqf(((a0[0] + a0[1]) + (a1[0] + a1[1])) * (1.f / 512.f) + EPS);
          myrs[1] = __builtin_amdgcn_rsqf(((b0[0] + b0[1]) + (b1[0] + b1[1])) * (1.f / 512.f) + EPS); }
        float rcr;
        { const float* p = ssp + (size_t)rrow * 16 + 6; const f32x2 a0 = *(const f32x2*)p, a1 = *(const f32x2*)(p + 2); rcr = __builtin_amdgcn_rsqf(((a0[0] + a0[1]) + (a1[0] + a1[1])) * (1.f / 512.f) + EPS); }
        LAS float* X2 = (LAS float*)(lds + LDS_X2);
        if (hf == 0) X2[rr] = sr;
        float ss[2][4][2]; tile_half_ss(acc, lds, wr, wc, fr, fq, ss);
        const f32x4 g0 = *(const f32x4*)(gk + colw), g1 = *(const f32x4*)(gk + colw + 4);
        bf16* kdst = (bf16*)(wsp(ws, WS_KM)); bf16* vdst = (bf16*)(wsp(ws, WS_VM));
#pragma unroll
        for (int ai = 0; ai < 2; ++ai)
#pragma unroll
            for (int m = 0; m < 4; ++m) { const int trow = ai * 128 + wr * 64 + m * 16 + fr; const int row = u.pm * 256 + trow;
                const float rc = __shfl(myrs[ai], fr + 16 * m);
                const float rk = rc * __builtin_amdgcn_rsqf((rc * rc * ss[ai][m][0] + X2[trow]) * (1.f / 192.f) + EPS);
                *(u32x4*)(kdst + (size_t)row * 3072 + h * 192 + colw) = pack8(acc[ai][0][m][0] * g0 * rk, acc[ai][0][m][1] * g1 * rk);
                *(u32x4*)(vdst + (size_t)row * 2048 + h * 128 + colw) = pack8(acc[ai][1][m][0] * rc, acc[ai][1][m][1] * rc); }
        { const LAS float* X = (const LAS float*)(lds + LDS_X); const f32x4 pv = *(const LAS f32x4*)(X + (rr * 2 + 0) * 4);
          const float rs = __builtin_amdgcn_rsqf((rcr * rcr * ((pv[0] + pv[1]) + (pv[2] + pv[3])) + sr) * (1.f / 192.f) + EPS);
          const int pos = (u.pm < 32) ? NMETA + (rrow & (SEQ - 1)) : (rr < NMETA ? rr : 0);
          const float* ctab = (const float*)(wsp(ws, WS_TAB) + TAB_COS) + pos * 32; const float* stab = (const float*)(wsp(ws, WS_TAB) + TAB_SIN) + pos * 32;
          const bf16* kr2 = kr; asm volatile("" : "+v"(kr2));
#pragma unroll
          for (int j = 0; j < 4; ++j) { const int g = hf * 4 + j; const int i0 = 4 * g; const u32x4 kvj = *(const u32x4*)(kr2 + j * 8);
              const f32x4 c = *(const f32x4*)(ctab + i0), sn = *(const f32x4*)(stab + i0), gg1 = *(const f32x4*)(gk + 128 + i0), gg2 = *(const f32x4*)(gk + 160 + i0);
              f32x4 x1 = {bflo(kvj[0]), bfhi(kvj[0]), bflo(kvj[1]), bfhi(kvj[1])}, x2 = {bflo(kvj[2]), bfhi(kvj[2]), bflo(kvj[3]), bfhi(kvj[3])};
              x1 = x1 * gg1 * rs; x2 = x2 * gg2 * rs;
              *(u32x4*)(kdst + (size_t)rrow * 3072 + h * 192 + 128 + g * 8) = pack8(x1 * c - x2 * sn, x2 * c + x1 * sn); } }
        nst = 16; return false;
    }
};
struct SchedP2KV {
    TileOrder T; const char* CKV; const char* W;
    __device__ __forceinline__ bool next(int i, Unit& u) const {
        int pm, pn; if (!T.tile(i, pm, pn)) return false;
        u.pm = pm; u.pn = pn; u.kind = 0; u.A = CKV + (size_t)pm * 256 * 512 * 2; u.B = W + (size_t)pn * 256 * 512 * 2; return true;
    }
};

struct EpiP4 {
    static constexpr bool RELAX = false;
    unsigned char* ws; int dbg;
    __device__ __forceinline__ bool operator()(Acc& acc, const Unit& u, int wr, int wc, int fr, int fq, LAS unsigned char* lds, int& nst) const {
        { const int l_ = opaque(threadIdx.x) & 63; fr = l_ & 15; fq = l_ >> 4; }
        const int row0 = u.pm * 256 + wr * 64 + fr; const int col0 = u.pn * 256 + wc * 32 + 8 * fq;
        const bf16* sa = (const bf16*)(wsp(ws, WS_SA)); const bf16* sb = (const bf16*)(wsp(ws, WS_SB)); bf16* mb = (bf16*)(wsp(ws, WS_MB));
        if (u.kind == 0 && dbg != 1) {
#pragma unroll
            for (int ai = 0; ai < 2; ++ai) { u32x4 av[4][2], bv[4][2];
#pragma unroll
                for (int m = 0; m < 4; ++m)
#pragma unroll
                    for (int bj = 0; bj < 2; ++bj) { const size_t off = (size_t)(row0 + ai * 128 + m * 16) * 2048 + col0 + bj * 128; av[m][bj] = *(const u32x4*)(sa + off); bv[m][bj] = *(const u32x4*)(sb + off); }
#pragma unroll
                for (int m = 0; m < 4; ++m)
#pragma unroll
                    for (int bj = 0; bj < 2; ++bj) { const u32x4 a = av[m][bj], b = bv[m][bj];
                        const f32x4 a0 = {bflo(a[0]), bfhi(a[0]), bflo(a[1]), bfhi(a[1])}, a1 = {bflo(a[2]), bfhi(a[2]), bflo(a[3]), bfhi(a[3])};
                        const f32x4 b0 = {bflo(b[0]), bfhi(b[0]), bflo(b[1]), bfhi(b[1])}, b1 = {bflo(b[2]), bfhi(b[2]), bflo(b[3]), bfhi(b[3])};
#pragma unroll
                        for (int e = 0; e < 4; ++e) { acc[ai][bj][m][0][e] *= a0[e] * __builtin_amdgcn_rcpf(b0[e]); acc[ai][bj][m][1][e] *= a1[e] * __builtin_amdgcn_rcpf(b1[e]); } } }
            nst = 0; return true;
        }
        if (u.kind == 0) {
#pragma unroll
            for (int ai = 0; ai < 2; ++ai)
#pragma unroll
                for (int m = 0; m < 4; ++m)
#pragma unroll
                    for (int bj = 0; bj < 2; ++bj) { const size_t off = (size_t)(row0 + ai * 128 + m * 16) * 2048 + col0 + bj * 128; const u32x4 a = *(const u32x4*)(sa + off);
                        const f32x4 a0 = {bflo(a[0]), bfhi(a[0]), bflo(a[1]), bfhi(a[1])}, a1 = {bflo(a[2]), bfhi(a[2]), bflo(a[3]), bfhi(a[3])};
                        *(u32x4*)(mb + off) = pack8(acc[ai][bj][m][0] * a0, acc[ai][bj][m][1] * a1); }
            nst = 16; return false;
        }
        { u32x4 bv[2][4][2];
#pragma unroll
          for (int ai = 0; ai < 2; ++ai)
#pragma unroll
            for (int m = 0; m < 4; ++m)
#pragma unroll
                for (int bj = 0; bj < 2; ++bj) bv[ai][m][bj] = *(const u32x4*)(sb + (size_t)(row0 + ai * 128 + m * 16) * 2048 + col0 + bj * 128);
#pragma unroll
          for (int ai = 0; ai < 2; ++ai)
#pragma unroll
            for (int m = 0; m < 4; ++m)
#pragma unroll
                for (int bj = 0; bj < 2; ++bj) { const u32x4 b = bv[ai][m][bj];
                    const f32x4 b0 = {bflo(b[0]), bfhi(b[0]), bflo(b[1]), bfhi(b[1])}, b1 = {bflo(b[2]), bfhi(b[2]), bflo(b[3]), bfhi(b[3])};
                    *(u32x4*)(mb + (size_t)(row0 + ai * 128 + m * 16) * 2048 + col0 + bj * 128) = pack8(acc[ai][bj][m][0] * b0, acc[ai][bj][m][1] * b1); } }
        nst = 16; return false;
    }
};
struct SchedP4 {
    TileOrder T; const char* OA; const char* OB; const char* WA; const char* WB; int dbg;
    __device__ __forceinline__ bool next(int i, Unit& u) const {
        int pm, pn; const int ti = dbg ? i : (i >> 1), kd = dbg ? (dbg - 1) : (i & 1);
        if (!T.tile(ti, pm, pn)) return false;
        u.pm = pm; u.pn = pn; u.kind = kd;
        u.A = (kd ? OB : OA) + (size_t)pm * 256 * 2048 * 2; u.B = (kd ? WB : WA) + (size_t)pn * 256 * 2048 * 2; return true;
    }
};
struct EpiP5 {
    static constexpr bool RELAX = true;
    const float* x; float* out;
    __device__ __forceinline__ bool operator()(Acc& acc, const Unit& u, int wr, int wc, int fr, int fq, LAS unsigned char* lds, int& nst) const {
        { const int l_ = opaque(threadIdx.x) & 63; fr = l_ & 15; fq = l_ >> 4; }
        const int row0 = u.pm * 256 + wr * 64 + fr; const int col0 = u.pn * 256 + wc * 32 + 8 * fq;
        f32x4 xa[4][2][2], xb[4][2][2];
#pragma unroll
        for (int m = 0; m < 4; ++m)
#pragma unroll
            for (int bj = 0; bj < 2; ++bj) { const size_t off = (size_t)(row0 + m * 16) * 2048 + col0 + bj * 128; xa[m][bj][0] = *(const f32x4*)(x + off); xa[m][bj][1] = *(const f32x4*)(x + off + 4); }
#pragma unroll
        for (int m = 0; m < 4; ++m)
#pragma unroll
            for (int bj = 0; bj < 2; ++bj) { xa[m][bj][0] += acc[0][bj][m][0]; xa[m][bj][1] += acc[0][bj][m][1]; }
#pragma unroll
        for (int m = 0; m < 4; ++m)
#pragma unroll
            for (int bj = 0; bj < 2; ++bj) { const size_t off = (size_t)(row0 + 128 + m * 16) * 2048 + col0 + bj * 128; xb[m][bj][0] = *(const f32x4*)(x + off); xb[m][bj][1] = *(const f32x4*)(x + off + 4); }
#pragma unroll
        for (int m = 0; m < 4; ++m)
#pragma unroll
            for (int bj = 0; bj < 2; ++bj) { const size_t off = (size_t)(row0 + m * 16) * 2048 + col0 + bj * 128; *(f32x4*)(out + off) = xa[m][bj][0]; *(f32x4*)(out + off + 4) = xa[m][bj][1]; }
#pragma unroll
        for (int m = 0; m < 4; ++m)
#pragma unroll
            for (int bj = 0; bj < 2; ++bj) { const size_t off = (size_t)(row0 + 128 + m * 16) * 2048 + col0 + bj * 128; *(f32x4*)(out + off) = xb[m][bj][0] + acc[1][bj][m][0]; *(f32x4*)(out + off + 4) = xb[m][bj][1] + acc[1][bj][m][1]; }
        nst = 32; return false;
    }
};
struct SchedP5 {
    TileOrder T; const char* MB; const char* WO;
    __device__ __forceinline__ bool next(int i, Unit& u) const {
        int pm, pn; if (!T.tile(i, pm, pn)) return false;
        u.pm = pm; u.pn = pn; u.kind = 0; u.A = MB + (size_t)pm * 256 * 2048 * 2; u.B = WO + (size_t)pn * 256 * 2048 * 2; return true;
    }
};

constexpr float NEGBIG = -1e30f;
constexpr float THR_L2 = 8.f * LOG2E;
template <int NCB> __device__ __forceinline__ int v_st(int k, int c) { const int kk = (k & ~0xC) | ((k & 4) << 1) | ((k & 8) >> 1); return ((kk >> 3) * NCB + (c >> 5)) * 512 + ((kk & 7) * 32 + (c & 31)) * 2; }
__device__ __forceinline__ int v_rd_base(int lane) { return ((lane & 3) << 3) | (((lane >> 2) & 3) << 6) | (((lane >> 4) & 1) << 5) | (((lane >> 5) & 1) << 8); }
typedef short v4i16_t __attribute__((ext_vector_type(4)));
typedef LAS const char* lds_cptr;
__device__ __forceinline__ s16x4 vtr(lds_cptr p) { return __builtin_bit_cast(s16x4, __builtin_amdgcn_ds_read_tr16_b64_v4i16((LAS v4i16_t*)p)); }
template <int NCB> __device__ __forceinline__ void pv_all(f32x16* o, lds_cptr vp, bf16x8 pa0, bf16x8 pa1, bf16x8 pa2, bf16x8 pa3) {
    constexpr int KS = NCB * 1024, HF = NCB * 512;
#pragma unroll
    for (int d0 = 0; d0 < NCB; ++d0) {
        const s16x4 l0 = vtr(vp + d0 * 512 + 0 * KS), h0 = vtr(vp + d0 * 512 + 0 * KS + HF), l1 = vtr(vp + d0 * 512 + 1 * KS), h1 = vtr(vp + d0 * 512 + 1 * KS + HF);
        const s16x4 l2 = vtr(vp + d0 * 512 + 2 * KS), h2 = vtr(vp + d0 * 512 + 2 * KS + HF), l3 = vtr(vp + d0 * 512 + 3 * KS), h3 = vtr(vp + d0 * 512 + 3 * KS + HF);
#define PK(L, H) (bf16x8){L[0], L[1], L[2], L[3], H[0], H[1], H[2], H[3]}
        o[d0] = __builtin_amdgcn_mfma_f32_32x32x16_bf16(pa0, PK(l0, h0), o[d0], 0, 0, 0);
        o[d0] = __builtin_amdgcn_mfma_f32_32x32x16_bf16(pa1, PK(l1, h1), o[d0], 0, 0, 0);
        o[d0] = __builtin_amdgcn_mfma_f32_32x32x16_bf16(pa2, PK(l2, h2), o[d0], 0, 0, 0);
        o[d0] = __builtin_amdgcn_mfma_f32_32x32x16_bf16(pa3, PK(l3, h3), o[d0], 0, 0, 0);
#undef PK
    }
}

template <int DQK, int DV, bool BIAS, int VAR = 0>
__device__ __forceinline__ void attn_pass(f32x16 (&o)[DV / 32], float& l_out, const bf16* __restrict__ Q, int ldq, const bf16* __restrict__ Kr, const bf16* __restrict__ Km, int ldk,
                                          const bf16* __restrict__ Vr, const bf16* __restrict__ Vm, int ldv, int q0, LAS unsigned char* ldsb) {
    constexpr int NKP = 64 * DQK * 2 / 8192, NVP = 64 * DV * 2 / 8192, KB = 64 * DQK * 2, VB = 64 * DV * 2, ND0 = DV / 32, NQ = DQK / 16, NCB = DV / 32;
    const int tid = opaque(threadIdx.x), lane = tid & 63, r32 = lane & 31, hi = lane >> 5; const int wid = __builtin_amdgcn_readfirstlane(tid >> 6);
    char* lds = (char*)ldsb;
    float* wsc = (float*)(lds + LDS_WSC) + wid * 64; float* al_l = wsc + 32;
    const float* btab = (const float*)(lds + LDS_BT);
    const int qw0 = q0 + wid * 32;
    bf16x8 qr[NQ];
    { const bf16* Qw = Q + (size_t)(wid * 32 + r32) * ldq + hi * 8;
#pragma unroll
      for (int d0 = 0; d0 < NQ; ++d0) qr[d0] = *(const bf16x8*)(Qw + d0 * 16); }
    const lds_cptr vp0 = (lds_cptr)ldsb + 3 * KB + v_rd_base(lane);
#define KXW(row) ((DQK == 128) ? ((row) & 15) : (((row) >> 1) & 7))
    constexpr int NKO = (DQK == 128) ? 8 : 4;
    int koff[NKO];
#pragma unroll
    for (int d0 = 0; d0 < NKO; ++d0) koff[d0] = r32 * (DQK * 2) + (((2 * d0 + hi) ^ KXW(r32)) << 4);
#define KOFF(d0) (koff[(d0) % NKO] + ((d0) / NKO) * (NKO * 32))
    unsigned ksrc[NKP], vsrc[NVP];
#pragma unroll
    for (int j = 0; j < NKP; ++j) { const int off = 8192 * j + 16 * tid, row = off / (DQK * 2), cpos = (off % (DQK * 2)) >> 4; ksrc[j] = (unsigned)(row * ldk + ((cpos ^ KXW(row)) << 3)); }
#pragma unroll
    for (int j = 0; j < NVP; ++j) { const int off = 8192 * j + 16 * tid, st = off >> 9, kk = (st / NCB) * 8 + ((off & 511) >> 6), c = (st % NCB) * 32 + ((off & 63) >> 1);
        const int k = (kk & ~0xC) | ((kk & 4) << 1) | ((kk & 8) >> 1); vsrc[j] = (unsigned)(k * ldv + c); }
    const unsigned ldsw = (unsigned)wid * 1024u;
#define DMA_K(t, KO_) do { const bf16* kp = (t) == 0 ? Km : Kr + (size_t)((VAR == 1 ? ((t) & 1) + 1 : (t)) - 1) * 64 * ldk; \
        _Pragma("unroll") for (int j = 0; j < NKP; ++j) __builtin_amdgcn_global_load_lds((const unsigned*)(kp + ksrc[j]), (LAS unsigned*)(ldsb + (KO_) + 8192 * j + ldsw), 16, 0, 0); } while (0)
#define DMA_V(t, VO_) do { const bf16* vp = (t) == 0 ? Vm : Vr + (size_t)((VAR == 1 ? ((t) & 1) + 1 : (t)) - 1) * 64 * ldv; \
        _Pragma("unroll") for (int j = 0; j < NVP; ++j) __builtin_amdgcn_global_load_lds((const unsigned*)(vp + vsrc[j]), (LAS unsigned*)(ldsb + 3 * KB + (VO_) + 8192 * j + ldsw), 16, 0, 0); } while (0)
#define WAITBAR_N() do { if (VAR == 2) asm volatile("s_waitcnt vmcnt(%0) lgkmcnt(0)" :: "n"(NKP + NVP) : "memory"); else if (VAR == 3) asm volatile("s_waitcnt lgkmcnt(0)\n\ts_barrier" ::: "memory"); else asm volatile("s_waitcnt vmcnt(%0) lgkmcnt(0)\n\ts_barrier" :: "n"(NKP + NVP) : "memory"); } while (0)
#define WAITBAR_0() do { if (VAR == 2) asm volatile("s_waitcnt vmcnt(0) lgkmcnt(0)" ::: "memory"); else asm volatile("s_waitcnt vmcnt(0) lgkmcnt(0)\n\ts_barrier" ::: "memory"); } while (0)
    float mhat = 0.f, l_reg = 0.f, ccur = 0.f;
    f32x16 negm;
#pragma unroll
    for (int r = 0; r < 16; ++r) negm[r] = 0.f;
#pragma unroll
    for (int d = 0; d < ND0; ++d) o[d] = (f32x16){0.f, 0.f, 0.f, 0.f, 0.f, 0.f, 0.f, 0.f, 0.f, 0.f, 0.f, 0.f, 0.f, 0.f, 0.f, 0.f};
#define PK4(P, BASE, OUT) do { unsigned a0 = cvtpk(P[BASE + 0], P[BASE + 1]), a1 = cvtpk(P[BASE + 2], P[BASE + 3]), b0_ = cvtpk(P[BASE + 4], P[BASE + 5]), b1_ = cvtpk(P[BASE + 6], P[BASE + 7]); \
        auto r0 = __builtin_amdgcn_permlane32_swap(a0, b0_, false, false); auto r1 = __builtin_amdgcn_permlane32_swap(a1, b1_, false, false); \
        u32x4 w = {r0[0], r1[0], r0[1], r1[1]}; OUT = __builtin_bit_cast(bf16x8, w); } while (0)
#define LOADV(VV, D0) do { _Pragma("unroll") for (int ks_ = 0; ks_ < 4; ++ks_) { VV[2 * ks_] = vtr(vp_ + (D0) * 512 + ks_ * (NCB * 1024)); VV[2 * ks_ + 1] = vtr(vp_ + (D0) * 512 + ks_ * (NCB * 1024) + NCB * 512); } } while (0)
#define VFRAG(VV, ks_) (bf16x8){VV[2 * (ks_)][0], VV[2 * (ks_)][1], VV[2 * (ks_)][2], VV[2 * (ks_)][3], VV[2 * (ks_) + 1][0], VV[2 * (ks_) + 1][1], VV[2 * (ks_) + 1][2], VV[2 * (ks_) + 1][3]}
#define MMAV(VV, D0) do { o[D0] = __builtin_amdgcn_mfma_f32_32x32x16_bf16(pa0, VFRAG(VV, 0), o[D0], 0, 0, 0); if (VAR != 7) { o[D0] = __builtin_amdgcn_mfma_f32_32x32x16_bf16(pa1, VFRAG(VV, 1), o[D0], 0, 0, 0); \
        o[D0] = __builtin_amdgcn_mfma_f32_32x32x16_bf16(pa2, VFRAG(VV, 2), o[D0], 0, 0, 0); o[D0] = __builtin_amdgcn_mfma_f32_32x32x16_bf16(pa3, VFRAG(VV, 3), o[D0], 0, 0, 0); } else { asm volatile("" :: "v"(VV[2]), "v"(VV[3]), "v"(VV[4]), "v"(VV[5]), "v"(VV[6]), "v"(VV[7]), "v"(pa1), "v"(pa2), "v"(pa3)); } } while (0)
#define STEP(MODE_, TR_, KO_, VO_, DMA_STMT) do { \
        f32x16 p0, p1; \
        bool cinit = true;        \
        if ((MODE_) == 0) { cinit = false; \
            float neg_ = NEGBIG, zer_ = 0.f; asm volatile("" : "+v"(neg_), "+v"(zer_)); \
            _Pragma("unroll") for (int r = 0; r < 16; ++r) { p1[r] = neg_; \
                if (r < 8) { if (BIAS) { int idx = crow(r, hi) - NMETA - (qw0 + r32) + 128; idx = idx < 0 ? 0 : idx; p0[r] = btab[idx]; } else p0[r] = zer_; } \
                else p0[r] = neg_; } \
        } else if (BIAS) { \
            const int d = 64 * (TR_) - qw0; \
            if (d <= -154 || d >= 122) { const float cn = btab[d < 0 ? 0 : 256] - mhat; \
                if (__any(cn != ccur)) { ccur = cn; _Pragma("unroll") for (int r = 0; r < 16; ++r) negm[r] = cn; } } \
            else { cinit = false; const int ib = d + 4 * hi - r32 + 128; \
                _Pragma("unroll") for (int r = 0; r < 16; ++r) { int i0 = ib + (r & 3) + 8 * (r >> 2), i1 = i0 + 32; \
                    i0 = i0 < 0 ? 0 : (i0 > 256 ? 256 : i0); i1 = i1 < 0 ? 0 : (i1 > 256 ? 256 : i1); p0[r] = btab[i0] - mhat; p1[r] = btab[i1] - mhat; \
                    if ((r & 3) == 3) asm volatile("" ::: "memory"); } } \
        } \
        { const LAS char* Kb = (const LAS char*)ldsb + (KO_); bf16x8 kp[3][2]; \
          kp[0][0] = *(const LAS bf16x8*)(Kb + KOFF(0)); kp[0][1] = *(const LAS bf16x8*)(Kb + KOFF(0) + 32 * (DQK * 2)); \
          kp[1][0] = *(const LAS bf16x8*)(Kb + KOFF(1)); kp[1][1] = *(const LAS bf16x8*)(Kb + KOFF(1) + 32 * (DQK * 2)); \
          _Pragma("unroll") for (int d0 = 0; d0 < NQ; ++d0) { \
              SBAR(); \
              if (d0 + 2 < NQ) { if (VAR != 6) { kp[(d0 + 2) % 3][0] = *(const LAS bf16x8*)(Kb + KOFF(d0 + 2)); kp[(d0 + 2) % 3][1] = *(const LAS bf16x8*)(Kb + KOFF(d0 + 2) + 32 * (DQK * 2)); } else { kp[(d0 + 2) % 3][0] = kp[d0 % 3][0]; kp[(d0 + 2) % 3][1] = kp[d0 % 3][1]; } } \
              if (d0 == 0 && cinit) { p0 = __builtin_amdgcn_mfma_f32_32x32x16_bf16(kp[0][0], qr[0], negm, 0, 0, 0); p1 = __builtin_amdgcn_mfma_f32_32x32x16_bf16(kp[0][1], qr[0], negm, 0, 0, 0); } \
              else if (VAR != 7 || d0 == 0) { p0 = __builtin_amdgcn_mfma_f32_32x32x16_bf16(kp[d0 % 3][0], qr[d0], p0, 0, 0, 0); p1 = __builtin_amdgcn_mfma_f32_32x32x16_bf16(kp[d0 % 3][1], qr[d0], p1, 0, 0, 0); } \
              else { asm volatile("" :: "v"(kp[d0 % 3][0]), "v"(kp[d0 % 3][1])); } } \
          SBAR(); } \
        const lds_cptr vp_ = vp0 + (VO_); s16x4 va[8], vb[8]; \
        LOADV(va, 0); SBAR(); \
        DMA_STMT; SBAR(); \
          \
        float rm = fmaxf(fmaxf(p0[0], p0[1]), p1[0]); \
        _Pragma("unroll") for (int r = 2; r < 16; r += 2) rm = fmaxf(fmaxf(rm, p0[r]), p0[r + 1]); \
        _Pragma("unroll") for (int r = 1; r < 16; r += 2) rm = fmaxf(fmaxf(rm, p1[r]), p1[(r + 1) & 15]); \
        { auto rr = __builtin_amdgcn_permlane32_swap(__float_as_uint(rm), __float_as_uint(rm), false, false); rm = fmaxf(__uint_as_float(rr[0]), __uint_as_float(rr[1])); } \
        if ((MODE_) == 0 || __builtin_expect(__any(rm > THR_L2), 0)) { \
            const float dl = (MODE_) == 0 ? rm : fmaxf(rm, 0.f); mhat += dl; ccur -= dl; \
            _Pragma("unroll") for (int r = 0; r < 16; ++r) { p0[r] -= dl; p1[r] -= dl; negm[r] = ccur; } \
            if ((MODE_) != 0) { const float f = __builtin_amdgcn_exp2f(-dl); l_reg *= f; \
                if (hi == 0) al_l[r32] = f; asm volatile("s_waitcnt lgkmcnt(0)" ::: "memory"); \
                _Pragma("unroll") for (int d = 0; d < ND0; ++d) _Pragma("unroll") for (int r = 0; r < 16; ++r) o[d][r] *= al_l[crow(r, hi)]; } } \
        float ps = 0.f; \
        if (VAR != 4) { \
        _Pragma("unroll") for (int r = 0; r < 16; ++r) { p0[r] = __builtin_amdgcn_exp2f(p0[r]); ps += p0[r]; } \
        _Pragma("unroll") for (int r = 0; r < 16; ++r) { p1[r] = __builtin_amdgcn_exp2f(p1[r]); ps += p1[r]; } } \
        { auto rr = __builtin_amdgcn_permlane32_swap(__float_as_uint(ps), __float_as_uint(ps), false, false); ps = __uint_as_float(rr[0]) + __uint_as_float(rr[1]); } \
        l_reg += ps; \
        bf16x8 pa0, pa1, pa2, pa3; \
        PK4(p0, 0, pa0); PK4(p0, 8, pa1); PK4(p1, 0, pa2); PK4(p1, 8, pa3); \
        if (VAR != 5) { \
        _Pragma("unroll") for (int d0 = 0; d0 < NCB; d0 += 2) { \
            SBAR(); if (d0 + 1 < NCB) LOADV(vb, d0 + 1); MMAV(va, d0); \
            SBAR(); if (d0 + 2 < NCB) LOADV(va, d0 + 2); if (d0 + 1 < NCB) MMAV(vb, d0 + 1); } \
        } else { asm volatile("" :: "v"(pa0), "v"(pa1), "v"(pa2), "v"(pa3), "v"(va[0]), "v"(va[7])); } \
        SBAR(); } while (0)
    int kc = 0, kn = KB, kf = 2 * KB, vc = 0, vn = VB, vf = 2 * VB;
#define ROT() do { const int a_ = kc; kc = kn; kn = kf; kf = a_; const int b_ = vc; vc = vn; vn = vf; vf = b_; } while (0)
    DMA_K(0, 0); DMA_V(0, 0); DMA_K(1, KB); DMA_V(1, VB); WAITBAR_N();
    STEP(0, 0, kc, vc, { DMA_K(2, kf); DMA_V(2, vf); }); WAITBAR_N(); ROT();
#pragma unroll 1
    for (int t = 1; t <= 30; ++t) { STEP(1, t - 1, kc, vc, { if (VAR != 3) { DMA_K(t + 2, kf); DMA_V(t + 2, vf); } }); WAITBAR_N(); ROT(); }
    STEP(1, 30, kc, vc, {}); WAITBAR_0(); ROT();
    STEP(1, 31, kc, vc, {});
    __syncthreads();
#undef ROT
#undef STEP
#undef LOADV
#undef VFRAG
#undef MMAV
#undef KXW
#undef KOFF
#undef PK4
#undef DMA_K
#undef DMA_V
#undef WAITBAR_N
#undef WAITBAR_0
    l_out = l_reg;
}

template <int VAR = 0> __device__ __forceinline__ void mla_unit(unsigned char* ws, int bl, int h, int qb, LAS unsigned char* ldsb, bool nostore = false) {
    const int tid = opaque(threadIdx.x); int lane = tid & 63, r32 = lane & 31, hi = lane >> 5; const int wid = __builtin_amdgcn_readfirstlane(tid >> 6);
    char* lds = (char*)ldsb; float* wsc = (float*)(lds + LDS_WSC) + wid * 64;
    const size_t rb = (size_t)bl * SEQ; const int q0 = qb * 256;
    const bf16* QM = (const bf16*)(wsp(ws, WS_QM)); const bf16* KM = (const bf16*)(wsp(ws, WS_KM)); const bf16* VM = (const bf16*)(wsp(ws, WS_VM));
    f32x16 o[4]; float l;
    attn_pass<192, 128, false, VAR>(o, l, QM + (rb + q0) * 3072 + h * 192, 3072, KM + rb * 3072 + h * 192, KM + (size_t)MH * 3072 + h * 192, 3072,
                               VM + rb * 2048 + h * 128, VM + (size_t)MH * 2048 + h * 128, 2048, q0, ldsb);
    lane = opaque(lane); r32 = lane & 31; hi = lane >> 5;
    bf16* zp = (bf16*)(wsp(ws, WS_ZA)) + (rb + q0 + wid * 32 + (lane >> 4)) * 2048 + h * 128 + (lane & 15) * 8;
    u32x4 zv[8];
#pragma unroll
    for (int i = 0; i < 8; ++i) zv[i] = *(const u32x4*)(zp + (size_t)i * 4 * 2048);
    if (hi == 0) wsc[r32] = l; LDS_WAIT();
    bf16* stg = (bf16*)(lds + wid * 8192);
#pragma unroll
    for (int r = 0; r < 16; ++r) { const float rl = __builtin_amdgcn_rcpf(wsc[crow(r, hi)]); const int orow = crow(r, hi);
#pragma unroll
        for (int d0 = 0; d0 < 4; ++d0) { const unsigned w = cvtpk(o[d0][r] * rl, 0.f); stg[orow * 128 + d0 * 32 + r32] = (bf16)(w & 0xffffu); } }
    LDS_WAIT();
    const bf16* sp = stg + (lane >> 4) * 128 + (lane & 15) * 8;
#pragma unroll
    for (int i = 0; i < 8; ++i) {
        const u32x4 s = *(const u32x4*)(sp + i * 4 * 128); const u32x4 z = zv[i]; u32x4 w;
#pragma unroll
        for (int e = 0; e < 4; ++e) w[e] = cvtpk(bflo(s[e]) * bflo(z[e]), bfhi(s[e]) * bfhi(z[e]));
        if (!nostore) *(u32x4*)(zp + (size_t)i * 4 * 2048) = w; }
    __syncthreads();
}
constexpr int PS_PX = 131072;
template <int VAR = 0>
__device__ __forceinline__ void attn_pass_ps(f32x16 (&o)[4], float& l_out, const bf16* __restrict__ Q, int ldq, const bf16* __restrict__ Kr, const bf16* __restrict__ Km, int ldk,
                                             const bf16* __restrict__ Vr, const bf16* __restrict__ Vm, int ldv, int q0, LAS unsigned char* ldsb) {
    constexpr int NKP = 2, NVP = 4, KB = 16384, VB = 32768, NQ = 8, NCB = 8, VR0 = 2 * KB;
    const int tid = opaque(threadIdx.x), lane = tid & 63, r32 = lane & 31, hi = lane >> 5; const int wid = __builtin_amdgcn_readfirstlane(tid >> 6);
    const int pair = wid >> 1, half = wid & 1, grp = wid >> 2;
    char* lds = (char*)ldsb;
    float* wsc = (float*)(lds + LDS_WSC) + wid * 64; float* al_l = wsc + 32;
    float* rmx = (float*)(lds + LDS_WSS);
    const float* btab = (const float*)(lds + LDS_BT);
    const int qw0 = q0 + pair * 32;
    bf16x8 qr[NQ];
    { const bf16* Qw = Q + (size_t)(pair * 32 + r32) * ldq + hi * 8;
#pragma unroll
      for (int d0 = 0; d0 < NQ; ++d0) qr[d0] = *(const bf16x8*)(Qw + d0 * 16); }
    const lds_cptr vp0 = (lds_cptr)ldsb + VR0 + v_rd_base(lane) + half * (4 * 512);
    int koff[NQ];
#pragma unroll
    for (int d0 = 0; d0 < NQ; ++d0) koff[d0] = (32 * half + r32) * 256 + (((2 * d0 + hi) ^ (r32 & 15)) << 4);
    unsigned ksrc[NKP], vsrc[NVP];
#pragma unroll
    for (int j = 0; j < NKP; ++j) { const int off = 8192 * j + 16 * tid, row = off >> 8, cpos = (off & 255) >> 4; ksrc[j] = (unsigned)(row * ldk + ((cpos ^ (row & 15)) << 3)); }
#pragma unroll
    for (int j = 0; j < NVP; ++j) { const int off = 8192 * j + 16 * tid, st = off >> 9, kk = (st / NCB) * 8 + ((off & 511) >> 6), c = (st % NCB) * 32 + ((off & 63) >> 1);
        const int k = (kk & ~0xC) | ((kk & 4) << 1) | ((kk & 8) >> 1); vsrc[j] = (unsigned)(k * ldv + c); }
    const unsigned ldsw = (unsigned)wid * 1024u;
    const LAS char* pxo = (const LAS char*)ldsb + PS_PX + wid * 2048 + lane * 16;
    const LAS char* pxp = (const LAS char*)ldsb + PS_PX + (wid ^ 1) * 2048 + lane * 16;
#define DMA_K(t, KO_) do { const bf16* kp_ = (t) == 0 ? Km : Kr + (size_t)((t) - 1) * 64 * ldk; \
        _Pragma("unroll") for (int j = 0; j < NKP; ++j) __builtin_amdgcn_global_load_lds((const unsigned*)(kp_ + ksrc[j]), (LAS unsigned*)(ldsb + (KO_) + 8192 * j + ldsw), 16, 0, 0); } while (0)
#define DMA_V(t, VO_) do { const bf16* vp_g = (t) == 0 ? Vm : Vr + (size_t)((t) - 1) * 64 * ldv; \
        _Pragma("unroll") for (int j = 0; j < NVP; ++j) __builtin_amdgcn_global_load_lds((const unsigned*)(vp_g + vsrc[j]), (LAS unsigned*)(ldsb + VR0 + (VO_) + 8192 * j + ldsw), 16, 0, 0); } while (0)
#define BAR_L() asm volatile("s_waitcnt lgkmcnt(0)\n\ts_barrier" ::: "memory")
#define WAIT_E() asm volatile("s_waitcnt vmcnt(%0) lgkmcnt(0)\n\ts_barrier" :: "n"(NKP + NVP) : "memory")
#define WAIT_O() asm volatile("s_waitcnt vmcnt(%0) lgkmcnt(0)\n\ts_barrier" :: "n"(NVP) : "memory")
#define WAITBAR_0() asm volatile("s_waitcnt vmcnt(0) lgkmcnt(0)\n\ts_barrier" ::: "memory")
    float mhat = 0.f, l_reg = 0.f, ccur = 0.f;
#pragma unroll
    for (int d = 0; d < 4; ++d) o[d] = (f32x16){0.f, 0.f, 0.f, 0.f, 0.f, 0.f, 0.f, 0.f, 0.f, 0.f, 0.f, 0.f, 0.f, 0.f, 0.f, 0.f};
#define PK4(P, BASE, OUT) do { unsigned a0 = cvtpk(P[BASE + 0], P[BASE + 1]), a1 = cvtpk(P[BASE + 2], P[BASE + 3]), b0_ = cvtpk(P[BASE + 4], P[BASE + 5]), b1_ = cvtpk(P[BASE + 6], P[BASE + 7]); \
        auto r0 = __builtin_amdgcn_permlane32_swap(a0, b0_, false, false); auto r1 = __builtin_amdgcn_permlane32_swap(a1, b1_, false, false); \
        u32x4 w = {r0[0], r1[0], r0[1], r1[1]}; OUT = __builtin_bit_cast(bf16x8, w); } while (0)
#define LOADV(VV, D0) do { _Pragma("unroll") for (int j_ = 0; j_ < 2; ++j_) { VV[2 * j_] = vtr(vown_ + (D0) * 512 + j_ * 8192); VV[2 * j_ + 1] = vtr(vown_ + (D0) * 512 + j_ * 8192 + 4096); \
        VV[4 + 2 * j_] = vtr(vpar_ + (D0) * 512 + j_ * 8192); VV[4 + 2 * j_ + 1] = vtr(vpar_ + (D0) * 512 + j_ * 8192 + 4096); } } while (0)
#define VFRAG(VV, ks_) (bf16x8){VV[2 * (ks_)][0], VV[2 * (ks_)][1], VV[2 * (ks_)][2], VV[2 * (ks_)][3], VV[2 * (ks_) + 1][0], VV[2 * (ks_) + 1][1], VV[2 * (ks_) + 1][2], VV[2 * (ks_) + 1][3]}
#define MMAV(VV, D0) do { o[D0] = __builtin_amdgcn_mfma_f32_32x32x16_bf16(pk0, VFRAG(VV, 0), o[D0], 0, 0, 0); o[D0] = __builtin_amdgcn_mfma_f32_32x32x16_bf16(pk1, VFRAG(VV, 1), o[D0], 0, 0, 0); \
        o[D0] = __builtin_amdgcn_mfma_f32_32x32x16_bf16(pk2, VFRAG(VV, 2), o[D0], 0, 0, 0); o[D0] = __builtin_amdgcn_mfma_f32_32x32x16_bf16(pk3, VFRAG(VV, 3), o[D0], 0, 0, 0); } while (0)
#define H1(MODE_, TR_, KO_, DMA_STMT) do { \
        f32x16 p; bool cinit = true; \
        if ((MODE_) == 0) { cinit = false; float neg_ = NEGBIG; asm volatile("" : "+v"(neg_)); \
            _Pragma("unroll") for (int r = 0; r < 16; ++r) { if (r < 8 && half == 0) { int idx = crow(r, hi) - NMETA - (qw0 + r32) + 128; idx = idx < 0 ? 0 : idx; p[r] = btab[idx] - mhat; } else p[r] = neg_; } \
        } else { const int d = 64 * (TR_) + 32 * half - qw0; \
            if (d <= -122 || d >= 122) { const float cn = btab[d < 0 ? 0 : 256] - mhat; \
                ccur = cn; } \
            else { cinit = false; const int ib = d + 4 * hi - r32 + 128; \
                _Pragma("unroll") for (int r = 0; r < 16; ++r) { int i0 = ib + (r & 3) + 8 * (r >> 2); i0 = i0 < 0 ? 0 : (i0 > 256 ? 256 : i0); p[r] = btab[i0] - mhat; \
                    if ((r & 3) == 3) asm volatile("" ::: "memory"); } } } \
        if (cinit) { _Pragma("unroll") for (int r = 0; r < 16; ++r) p[r] = ccur; }        \
        { const LAS char* Kb = (const LAS char*)ldsb + (KO_); bf16x8 kp[3]; \
          kp[0] = *(const LAS bf16x8*)(Kb + koff[0]); kp[1] = *(const LAS bf16x8*)(Kb + koff[1]); \
          _Pragma("unroll") for (int d0 = 0; d0 < NQ; ++d0) { \
              SBAR(); if (d0 + 2 < NQ) kp[(d0 + 2) % 3] = *(const LAS bf16x8*)(Kb + koff[d0 + 2]); \
              p = __builtin_amdgcn_mfma_f32_32x32x16_bf16(kp[d0 % 3], qr[d0], p, 0, 0, 0); } \
          SBAR(); } \
        DMA_STMT; SBAR(); \
        rm = fmaxf(fmaxf(p[0], p[1]), p[2]); \
        _Pragma("unroll") for (int r = 3; r < 15; r += 2) rm = fmaxf(fmaxf(rm, p[r]), p[r + 1]); \
        rm = fmaxf(rm, p[15]); \
        { auto rr = __builtin_amdgcn_permlane32_swap(__float_as_uint(rm), __float_as_uint(rm), false, false); rm = fmaxf(__uint_as_float(rr[0]), __uint_as_float(rr[1])); } \
        if (hi == 0) rmx[wid * 32 + r32] = rm; \
        float ps = 0.f; \
        _Pragma("unroll") for (int r = 0; r < 16; ++r) { p[r] = __builtin_amdgcn_exp2f(p[r]); ps += p[r]; } \
        { auto rr = __builtin_amdgcn_permlane32_swap(__float_as_uint(ps), __float_as_uint(ps), false, false); ps = __uint_as_float(rr[0]) + __uint_as_float(rr[1]); } \
        l_reg += ps; \
        PK4(p, 0, pw0); PK4(p, 8, pw1); \
        *(LAS bf16x8*)(pxo) = pw0; *(LAS bf16x8*)(pxo + 1024) = pw1; } while (0)
#define H2(VO_, DMA_STMT) do { \
        DMA_STMT; SBAR(); \
        const lds_cptr vown_ = vp0 + (VO_) + half * 16384, vpar_ = vp0 + (VO_) + (1 - half) * 16384; s16x4 va[8], vb[8]; \
        LOADV(va, 0); \
        const bf16x8 pq0 = *(const LAS bf16x8*)(pxp), pq1 = *(const LAS bf16x8*)(pxp + 1024); \
        const float rmp = fmaxf(rm, rmx[(wid ^ 1) * 32 + r32]); \
        const bf16x8 pk0 = pw0, pk1 = pw1, pk2 = pq0, pk3 = pq1; \
        SBAR(); LOADV(vb, 1); MMAV(va, 0); \
        SBAR(); LOADV(va, 2); MMAV(vb, 1); \
        SBAR(); LOADV(vb, 3); MMAV(va, 2); \
        SBAR(); MMAV(vb, 3); \
        SBAR(); \
        if (__builtin_expect(__any(rmp > THR_L2), 0)) {   \
            const float dl = fmaxf(rmp, 0.f); mhat += dl; ccur -= dl; \
            const float f = __builtin_amdgcn_exp2f(-dl); l_reg *= f; \
            if (hi == 0) al_l[r32] = f; asm volatile("s_waitcnt lgkmcnt(0)" ::: "memory"); \
            _Pragma("unroll") for (int dd = 0; dd < 4; ++dd) { _Pragma("unroll") for (int r = 0; r < 16; ++r) o[dd][r] *= al_l[crow(r, hi)]; } } } while (0)
    bf16x8 pw0, pw1; float rm;
    int v0 = 0, v1 = VB, v2 = 2 * VB;
#define ROTV() do { const int b_ = v0; v0 = v1; v1 = v2; v2 = b_; } while (0)
#define KS(t) (((t) & 1) * KB)
    DMA_K(0, 0); DMA_V(0, 0); DMA_K(1, KB); DMA_V(1, VB);
    asm volatile("s_waitcnt vmcnt(%0) lgkmcnt(0)\n\ts_barrier" :: "n"(NKP + 2 * NVP) : "memory");
    if (grp == 0) {
        H1(0, 0, KS(0), {}); WAIT_E(); H2(v0, { DMA_V(2, v2); }); WAIT_O(); ROTV();
#pragma unroll 1
        for (int t = 1; t <= 30; ++t) { H1(1, t - 1, KS(t), { DMA_K(t + 1, KS(t + 1)); }); WAIT_E(); H2(v0, { DMA_V(t + 2, v2); }); WAIT_O(); ROTV(); }
        H1(1, 30, KS(31), { DMA_K(32, KS(32)); }); WAIT_E(); H2(v0, {}); WAITBAR_0(); ROTV();
        H1(1, 31, KS(32), {}); WAITBAR_0(); H2(v0, {}); BAR_L();
        BAR_L();
    } else {
        WAIT_E();
        H1(0, 0, KS(0), {}); WAIT_O(); H2(v0, { DMA_K(2, KS(2)); DMA_V(2, v2); }); WAIT_E(); ROTV();
#pragma unroll 1
        for (int t = 1; t <= 30; ++t) { H1(1, t - 1, KS(t), {}); WAIT_O(); H2(v0, { DMA_K(t + 2, KS(t + 2)); DMA_V(t + 2, v2); }); WAIT_E(); ROTV(); }
        H1(1, 30, KS(31), {}); WAITBAR_0(); H2(v0, {}); WAITBAR_0(); ROTV();
        H1(1, 31, KS(32), {}); BAR_L(); H2(v0, {}); BAR_L();
    }
    if (hi == 0) rmx[wid * 32 + r32] = l_reg;
    BAR_L();
    l_out = l_reg + rmx[(wid ^ 1) * 32 + r32];
    __syncthreads();
#undef ROTV
#undef KS
#undef H1
#undef H2
#undef LOADV
#undef VFRAG
#undef MMAV
#undef PK4
#undef DMA_K
#undef DMA_V
#undef BAR_L
#undef WAIT_E
#undef WAIT_O
#undef WAITBAR_0
}

template <int VAR = 0> __device__ __forceinline__ void diff_unit_ps(unsigned char* ws, float* o1s, const float* subln, int bl, int h, int qb, LAS unsigned char* ldsb, bool nostore = false) {
    const int tid = opaque(threadIdx.x); int lane = tid & 63, r32 = lane & 31, hi = lane >> 5; const int wid = __builtin_amdgcn_readfirstlane(tid >> 6);
    const int pair = wid >> 1, half = wid & 1;
    char* lds = (char*)ldsb; float* wsc = (float*)(lds + LDS_WSC) + wid * 64; float* wss = (float*)(lds + LDS_X);
    const size_t rb = (size_t)bl * SEQ; const int q0 = qb * 128;
    const bf16* QD = (const bf16*)(wsp(ws, WS_QD)); const bf16* KD = (const bf16*)(wsp(ws, WS_KD)); const bf16* VD = (const bf16*)(wsp(ws, WS_VD));
    { float* bt = (float*)(lds + LDS_BT); const float* src = (const float*)(wsp(ws, WS_TAB) + TAB_BIAS) + h * 260; if (tid < 257) bt[tid] = src[tid]; }
    __syncthreads();
    const float lam = *(const float*)(wsp(ws, WS_TAB) + TAB_LAM);
    const size_t stb = ((size_t)blockIdx.x * 4 + pair) * (32 * 256) + half * 128;
#pragma unroll 1
    for (int mp = 0; mp < 2; ++mp) {
        f32x16 o[4]; float l;
        attn_pass_ps<VAR>(o, l, QD + (rb + q0) * 2048 + h * 256 + mp * 128, 2048, KD + rb * 2048 + h * 256 + mp * 128, KD + (size_t)MH * 2048 + h * 256 + mp * 128, 2048,
                          VD + rb * 2048 + h * 256, VD + (size_t)MH * 2048 + h * 256, 2048, q0, ldsb);
        lane = opaque(lane); r32 = lane & 31; hi = lane >> 5;
        GF* st = (GF*)o1s + stb + r32;
        if (mp == 0) {
            if (hi == 0) wsc[r32] = l; LDS_WAIT();
#pragma unroll
            for (int r = 0; r < 16; ++r) { const float rl = __builtin_amdgcn_rcpf(wsc[crow(r, hi)]); GF* sp = st + crow(r, hi) * 256; asm volatile("" : "+v"(sp));
#pragma unroll
                for (int d0 = 0; d0 < 4; ++d0) sp[d0 * 32] = o[d0][r] * rl; }
            asm volatile("s_waitcnt vmcnt(0) lgkmcnt(0)" ::: "memory");
        } else {
            float o1[16][4];
#pragma unroll
            for (int r = 0; r < 16; ++r) { const GF* sp = st + crow(r, hi) * 256;
#pragma unroll
                for (int d0 = 0; d0 < 4; ++d0) o1[r][d0] = sp[d0 * 32]; }
            if (hi == 0) wsc[r32] = l; LDS_WAIT();
            float* ys = (float*)(lds + wid * 16384) + r32;
#pragma unroll
            for (int r = 0; r < 16; ++r) { const float rl = __builtin_amdgcn_rcpf(wsc[crow(r, hi)]); float sq = 0.f;
#pragma unroll
                for (int d0 = 0; d0 < 4; ++d0) { const float y = o1[r][d0] - lam * (o[d0][r] * rl); ys[crow(r, hi) * 128 + d0 * 32] = y; sq += y * y; }
                sq += __shfl_xor(sq, 1); sq += __shfl_xor(sq, 2); sq += __shfl_xor(sq, 4); sq += __shfl_xor(sq, 8); sq += __shfl_xor(sq, 16);
                if (r32 == 0) wss[wid * 32 + crow(r, hi)] = sq; }
        }
    }
    { bf16* zp = (bf16*)(wsp(ws, WS_ZB)) + (rb + q0 + pair * 32 + (lane >> 4)) * 2048 + h * 256 + half * 128 + (lane & 15) * 8;
      u32x4 zv[8];
#pragma unroll
      for (int i = 0; i < 8; ++i) zv[i] = *(const u32x4*)(zp + (size_t)i * 4 * 2048);
      const f32x4 g0 = *(const f32x4*)(subln + half * 128 + (lane & 15) * 8), g1 = *(const f32x4*)(subln + half * 128 + (lane & 15) * 8 + 4);
      __syncthreads();
      const float* yl = (const float*)(lds + wid * 16384) + (lane >> 4) * 128 + (lane & 15) * 8;
#pragma unroll
      for (int i = 0; i < 8; ++i) { const int row = 4 * i + (lane >> 4);
          const float rsn = __builtin_amdgcn_rsqf((wss[wid * 32 + row] + wss[(wid ^ 1) * 32 + row]) * (1.f / 256.f) + EPS) * 0.8f;
          const f32x4 y0 = *(const f32x4*)(yl + i * 4 * 128), y1 = *(const f32x4*)(yl + i * 4 * 128 + 4); const u32x4 z = zv[i]; u32x4 w;
          w[0] = cvtpk(y0[0] * rsn * g0[0] * bflo(z[0]), y0[1] * rsn * g0[1] * bfhi(z[0])); w[1] = cvtpk(y0[2] * rsn * g0[2] * bflo(z[1]), y0[3] * rsn * g0[3] * bfhi(z[1]));
          w[2] = cvtpk(y1[0] * rsn * g1[0] * bflo(z[2]), y1[1] * rsn * g1[1] * bfhi(z[2])); w[3] = cvtpk(y1[2] * rsn * g1[2] * bflo(z[3]), y1[3] * rsn * g1[3] * bfhi(z[3]));
          if (!nostore) *(u32x4*)(zp + (size_t)i * 4 * 2048) = w; } }
    __syncthreads();
}

template <int VAR = 0> __device__ __forceinline__ void diff_unit(unsigned char* ws, float* o1s, const float* subln, int bl, int h, int qb, LAS unsigned char* ldsb, bool nostore = false) {
    const int tid = opaque(threadIdx.x); int lane = tid & 63, r32 = lane & 31, hi = lane >> 5; const int wid = __builtin_amdgcn_readfirstlane(tid >> 6);
    char* lds = (char*)ldsb; float* wsc = (float*)(lds + LDS_WSC) + wid * 64; float* wss = (float*)(lds + LDS_WSS) + wid * 32;
    const size_t rb = (size_t)bl * SEQ; const int q0 = qb * 256;
    const bf16* QD = (const bf16*)(wsp(ws, WS_QD)); const bf16* KD = (const bf16*)(wsp(ws, WS_KD)); const bf16* VD = (const bf16*)(wsp(ws, WS_VD));
    { float* bt = (float*)(lds + LDS_BT); const float* src = (const float*)(wsp(ws, WS_TAB) + TAB_BIAS) + h * 260; for (int i = tid; i < 257; i += NTHREADS) bt[i] = src[i]; }
    __syncthreads();
    const float lam = *(const float*)(wsp(ws, WS_TAB) + TAB_LAM);
#pragma unroll 1
    for (int pass = 0; pass < 4; ++pass) {
        const int mp = pass >> 1, vh = pass & 1;
        f32x16 o[4]; float l;
        attn_pass<128, 128, true, VAR>(o, l, QD + (rb + q0) * 2048 + h * 256 + mp * 128, 2048, KD + rb * 2048 + h * 256 + mp * 128, KD + (size_t)MH * 2048 + h * 256 + mp * 128, 2048,
                                  VD + rb * 2048 + h * 256 + vh * 128, VD + (size_t)MH * 2048 + h * 256 + vh * 128, 2048, q0, ldsb);
        lane = opaque(lane); r32 = lane & 31; hi = lane >> 5;
        if (hi == 0) wsc[r32] = l; LDS_WAIT();
        GF* st = (GF*)o1s + ((size_t)blockIdx.x * 8 + wid) * (32 * 256) + vh * 128 + r32;
        if (mp == 0) {
#pragma unroll
            for (int r = 0; r < 16; ++r) { const float rl = __builtin_amdgcn_rcpf(wsc[crow(r, hi)]); GF* sp = st + crow(r, hi) * 256;
#pragma unroll
                for (int d0 = 0; d0 < 4; ++d0) sp[d0 * 32] = o[d0][r] * rl; }
        } else {
#pragma unroll
            for (int r = 0; r < 16; ++r) { const float rl = __builtin_amdgcn_rcpf(wsc[crow(r, hi)]); GF* sp = st + crow(r, hi) * 256; float sq = 0.f;
#pragma unroll
                for (int d0 = 0; d0 < 4; ++d0) { const float y = sp[d0 * 32] - lam * (o[d0][r] * rl); sp[d0 * 32] = y; sq += y * y; }
                sq += __shfl_xor(sq, 1); sq += __shfl_xor(sq, 2); sq += __shfl_xor(sq, 4); sq += __shfl_xor(sq, 8); sq += __shfl_xor(sq, 16);
                if (r32 == 0) { if (vh == 0) wss[crow(r, hi)] = sq; else wss[crow(r, hi)] += sq; } }
        }
        asm volatile("s_waitcnt vmcnt(0) lgkmcnt(0)" ::: "memory");
    }
    { const GF* yp = (const GF*)o1s + ((size_t)blockIdx.x * 8 + wid) * (32 * 256) + (lane >> 5) * 256 + (lane & 31) * 8;
      bf16* zp = (bf16*)(wsp(ws, WS_ZB)) + (rb + q0 + wid * 32 + (lane >> 5)) * 2048 + h * 256 + (lane & 31) * 8;
      const f32x4 g0 = *(const f32x4*)(subln + (lane & 31) * 8), g1 = *(const f32x4*)(subln + (lane & 31) * 8 + 4);
#pragma unroll 4
      for (int i = 0; i < 16; ++i, zp += 2 * 2048, yp += 2 * 256) {
          const float rsn = __builtin_amdgcn_rsqf(wss[2 * i + (lane >> 5)] * (1.f / 256.f) + EPS) * 0.8f;
          const f32x4 y0 = *(const __attribute__((address_space(1))) f32x4*)yp, y1 = *(const __attribute__((address_space(1))) f32x4*)(yp + 4); const u32x4 z = *(const u32x4*)zp; u32x4 w;
          w[0] = cvtpk(y0[0] * rsn * g0[0] * bflo(z[0]), y0[1] * rsn * g0[1] * bfhi(z[0])); w[1] = cvtpk(y0[2] * rsn * g0[2] * bflo(z[1]), y0[3] * rsn * g0[3] * bfhi(z[1]));
          w[2] = cvtpk(y1[0] * rsn * g1[0] * bflo(z[2]), y1[1] * rsn * g1[1] * bfhi(z[2])); w[3] = cvtpk(y1[2] * rsn * g1[2] * bflo(z[3]), y1[3] * rsn * g1[3] * bfhi(z[3]));
          if (!nostore) *(u32x4*)zp = w; } }
    __syncthreads();
}

template <class Map>
__device__ __forceinline__ void transpose_item(const float* __restrict__ W, int Nsrc, int K, bf16* __restrict__ WT, LAS float* scr, int item, int lane, const float* __restrict__ gain, Map map) {
    const int nkb = K / 64, nb = item / nkb, kb = item % nkb, k0 = 64 * kb, n0 = 64 * nb;
    const int sc = map(n0 + lane);
    float v[64];
    const float* wp = W + (size_t)k0 * Nsrc + (sc >= 0 ? sc : 0);
#pragma unroll
    for (int i = 0; i < 64; ++i) v[i] = wp[(size_t)i * Nsrc];
    if (gain) {
#pragma unroll
        for (int i = 0; i < 64; ++i) v[i] *= gain[k0 + i]; }
#pragma unroll
    for (int i = 0; i < 64; ++i) scr[i * 65 + lane] = (sc >= 0) ? v[i] : 0.f;
    LDS_WAIT(); asm volatile("" ::: "memory");
    const int c = lane & 7;
#pragma unroll
    for (int j = 0; j < 8; ++j) { const int n = (lane >> 3) + 8 * j; const LAS float* s = scr + (8 * c) * 65 + n;
        u32x4 o; o.x = cvtpk(s[0 * 65], s[1 * 65]); o.y = cvtpk(s[2 * 65], s[3 * 65]); o.z = cvtpk(s[4 * 65], s[5 * 65]); o.w = cvtpk(s[6 * 65], s[7 * 65]);
        *(u32x4*)(WT + (size_t)(n0 + n) * K + k0 + 8 * c) = o; }
    LDS_WAIT(); asm volatile("" ::: "memory");
}
__device__ __forceinline__ int rope_orig(int c) { return 32 * ((c >> 2) & 1) + 4 * (c >> 3) + (c & 3); }
struct MapWin { __device__ int operator()(int n) const { if (n < 1280) return n; if (n < 1536) { const int c = n - 1280; return c < 64 ? 1280 + rope_orig(c) : -1; } return n - 192; } };
struct MapWuq { __device__ int operator()(int n) const { const int h = n >> 8, c = n & 255; if (c < 128) return h * 192 + c; if (c < 192) return h * 192 + 128 + rope_orig(c - 128); return -1; } };
struct MapId { __device__ int operator()(int n) const { return n; } };

__device__ __forceinline__ int t5_bucket(int rel) {
    const int n = rel < 0 ? -rel : rel; int b;
    if (n < 8) b = n; else b = 8 + (n >= 12) + (n >= 16) + (n >= 23) + (n >= 32) + (n >= 46) + (n >= 64) + (n >= 91);
    return b + (rel > 0 ? 16 : 0);
}
__device__ __forceinline__ void rms_row_bf16(const float* __restrict__ xrow, const float* __restrict__ g, bf16* __restrict__ orow, int lane) {
    u32x4* o16 = (u32x4*)orow + lane;
    if (!xrow) {
#pragma unroll
        for (int j = 0; j < 4; ++j) o16[64 * j] = (u32x4){0u, 0u, 0u, 0u};
        return; }
    const f32x4* xr = (const f32x4*)xrow + 2 * lane; const f32x4* gr = (const f32x4*)g + 2 * lane;
    f32x4 v[8]; float s = 0.f;
#pragma unroll
    for (int j = 0; j < 4; ++j) { v[2 * j] = xr[128 * j]; v[2 * j + 1] = xr[128 * j + 1]; }
#pragma unroll
    for (int j = 0; j < 8; ++j) s += (v[j][0] * v[j][0] + v[j][1] * v[j][1]) + (v[j][2] * v[j][2] + v[j][3] * v[j][3]);
    const float rs = __builtin_amdgcn_rsqf(wave_sum(s) * (1.f / 2048.f) + EPS);
#pragma unroll
    for (int j = 0; j < 4; ++j) { const f32x4 g0 = gr[128 * j], g1 = gr[128 * j + 1]; const f32x4 y0 = v[2 * j] * rs * g0, y1 = v[2 * j + 1] * rs * g1;
        o16[64 * j] = (u32x4){cvtpk(y0[0], y0[1]), cvtpk(y0[2], y0[3]), cvtpk(y1[0], y1[1]), cvtpk(y1[2], y1[3])}; }
}
__device__ __forceinline__ void rms_row2_bf16(const float* __restrict__ x0, const float* __restrict__ x1, const float* __restrict__ g, bf16* __restrict__ o0, bf16* __restrict__ o1, int lane) {
    const f32x4* xa = (const f32x4*)x0 + 2 * lane; const f32x4* xb = (const f32x4*)x1 + 2 * lane; const f32x4* gr = (const f32x4*)g + 2 * lane;
    f32x4 va[8], vb[8]; float sa = 0.f, sb = 0.f;
#pragma unroll
    for (int j = 0; j < 4; ++j) { va[2 * j] = xa[128 * j]; va[2 * j + 1] = xa[128 * j + 1]; vb[2 * j] = xb[128 * j]; vb[2 * j + 1] = xb[128 * j + 1]; }
#pragma unroll
    for (int j = 0; j < 8; ++j) { sa += (va[j][0] * va[j][0] + va[j][1] * va[j][1]) + (va[j][2] * va[j][2] + va[j][3] * va[j][3]); sb += (vb[j][0] * vb[j][0] + vb[j][1] * vb[j][1]) + (vb[j][2] * vb[j][2] + vb[j][3] * vb[j][3]); }
    const float ra = __builtin_amdgcn_rsqf(wave_sum(sa) * (1.f / 2048.f) + EPS), rb = __builtin_amdgcn_rsqf(wave_sum(sb) * (1.f / 2048.f) + EPS);
    u32x4* oa = (u32x4*)o0 + lane; u32x4* ob = (u32x4*)o1 + lane;
#pragma unroll
    for (int j = 0; j < 4; ++j) { const f32x4 g0 = gr[128 * j], g1 = gr[128 * j + 1];
        const f32x4 y0 = va[2 * j] * ra * g0, y1 = va[2 * j + 1] * ra * g1, z0 = vb[2 * j] * rb * g0, z1 = vb[2 * j + 1] * rb * g1;
        oa[64 * j] = (u32x4){cvtpk(y0[0], y0[1]), cvtpk(y0[2], y0[3]), cvtpk(y1[0], y1[1]), cvtpk(y1[2], y1[3])};
        ob[64 * j] = (u32x4){cvtpk(z0[0], z0[1]), cvtpk(z0[2], z0[3]), cvtpk(z1[0], z1[1]), cvtpk(z1[2], z1[3])}; }
}
__device__ __forceinline__ void p0_prologue(LAS unsigned char* ldsb, int vcu, int G) {
    const int tid = opaque(threadIdx.x), lane = tid & 63; const int wave = __builtin_amdgcn_readfirstlane(tid >> 6);
    LAS float* scr = (LAS float*)(ldsb + wave * 16896);
    const int gw = vcu * NWAVES + wave, NGW = G * NWAVES;
    unsigned char* ws = kws();
    constexpr int I_WIN = (NIN / 64) * 32, I_WUQ = 64 * 12, I_WUKV = 64 * 8, I_SQ = 32 * 32;
    constexpr int NITEMS = I_WIN + I_WUQ + I_WUKV + 3 * I_SQ;
    for (int it = gw; it < NITEMS; it += NGW) {
        int r = it;
        if (r < I_WIN) { transpose_item(kin(4), INW, 2048, (bf16*)(wsp(ws, WS_WIN)), scr, r, lane, nullptr, MapWin()); continue; } r -= I_WIN;
        if (r < I_WUQ) { transpose_item(kin(7), 3072, 768, (bf16*)(wsp(ws, WS_WUQ)), scr, r, lane, kin(5), MapWuq()); continue; } r -= I_WUQ;
        if (r < I_WUKV) { transpose_item(kin(8), 4096, 512, (bf16*)(wsp(ws, WS_WUKV)), scr, r, lane, kin(6), MapId()); continue; } r -= I_WUKV;
        if (r < I_SQ) { transpose_item(kin(15), 2048, 2048, (bf16*)(wsp(ws, WS_WA)), scr, r, lane, nullptr, MapId()); continue; } r -= I_SQ;
        if (r < I_SQ) { transpose_item(kin(16), 2048, 2048, (bf16*)(wsp(ws, WS_WB)), scr, r, lane, nullptr, MapId()); continue; } r -= I_SQ;
        transpose_item(kin(17), 2048, 2048, (bf16*)(wsp(ws, WS_WO)), scr, r, lane, nullptr, MapId());
    }
    bf16* ureal = (bf16*)((unsigned char*)kout() + (size_t)64 * 1024 * 1024); bf16* umeta = (bf16*)(wsp(ws, WS_UMETA));
    for (int m = gw; m < NBATCH * SEQ + 256; m += 2 * NGW) {
        const int m2 = m + NGW;
        if (m2 < NBATCH * SEQ) { rms_row2_bf16(kin(0) + (size_t)m * DM, kin(0) + (size_t)m2 * DM, kin(3), ureal + (size_t)m * DM, ureal + (size_t)m2 * DM, lane); continue; }
#pragma unroll 1
        for (int q = 0; q < 2; ++q) { const int mm = m + q * NGW; if (mm >= NBATCH * SEQ + 256) break;
            if (mm < NBATCH * SEQ) rms_row_bf16(kin(0) + (size_t)mm * DM, kin(3), ureal + (size_t)mm * DM, lane);
            else { const int j = mm - NBATCH * SEQ; rms_row_bf16(j < NMETA ? kin(1) + (size_t)j * DM : nullptr, kin(3), umeta + (size_t)j * DM, lane); } }
    }
    const int gt = vcu * NTHREADS + tid, NGT = G * NTHREADS;
    float* ctab = (float*)(wsp(ws, WS_TAB) + TAB_COS); float* stab = (float*)(wsp(ws, WS_TAB) + TAB_SIN); float* btab = (float*)(wsp(ws, WS_TAB) + TAB_BIAS);
    for (int i = gt; i < 2064 * 32; i += NGT) { const int pos = i >> 5, k = i & 31; const float inv = powf(10000.f, -(float)k / 32.f); const float ang = (float)pos * inv; ctab[i] = cosf(ang); stab[i] = sinf(ang); }
    for (int i = gt; i < 8 * 257; i += NGT) { const int h = i / 257, j = i % 257; btab[h * 260 + j] = kin(2)[t5_bucket(j - 128) * 8 + h] * LOG2E; }
    if (vcu == 0 && wave == 0) { const float* dl = kin(13);
        float a = dl[lane] * dl[128 + lane] + dl[64 + lane] * dl[192 + lane], b = dl[256 + lane] * dl[384 + lane] + dl[320 + lane] * dl[448 + lane];
        a = wave_sum(a); b = wave_sum(b); if (lane == 0) *(float*)(wsp(ws, WS_TAB) + TAB_LAM) = __expf(a) - __expf(b) + 0.2f; }
}

#ifndef MK_PH_LO
#define MK_PH_LO 0
#define MK_PH_HI 99
#endif
#ifndef MK_ONLY
#define MK_ON(n) 1
#else
#define MK_ON(n) (MK_ONLY == (n))
#endif
#ifndef MK_REPEAT
#define MK_REPEAT -1
#endif
#ifdef MK_VARIANT
#define MK_SKIPEPI(n, rep) ((MK_VARIANT == 9) && (MK_REPEAT == (n)) && (rep) == 0)
#else
#define MK_SKIPEPI(n, rep) false
#endif
#define MK_REP(n) ((MK_REPEAT == (n)) ? 2 : ((n) == 9 ? 0 : 1))
#define WSL() kws()
template <int half> __device__ __forceinline__ void run_half(LAS unsigned char* lds, const XcdBarrier& xb, int G, int bx, int vcu) {
        unsigned char* ws;
        for (int rep = 0; rep < MK_REP(1); ++rep) { ws = WSL(); if (MK_ON(1)) { SchedP1 S; S.T.init(half == 0 ? 33 : 32, 62, G, bx); S.U = (const char*)kout() + (size_t)64 * 1024 * 1024 + (size_t)half * MH * 2048 * 2; S.Umeta = (const char*)(wsp(ws, WS_UMETA)); S.W = (const char*)(wsp(ws, WS_WIN));
          EpiP1 E{ws, kin(11), kin(12), MK_SKIPEPI(1, rep)};
          gemm_phase(lds, 2048, 2048, 32, S, E); } }
        xcd_barrier(xb);
        for (int rep = 0; rep < MK_REP(2); ++rep) { for (int rq = 0; rq < MK_REP(21); ++rq) { ws = WSL(); if (MK_ON(2)) { SchedP2Q S; S.T.init(32, 16, G, bx); S.CQ = (const char*)(wsp(ws, WS_CQ)); S.W = (const char*)(wsp(ws, WS_WUQ)); EpiP2Q E{ws, kin(9), MK_SKIPEPI(2, rep)};
          gemm_phase(lds, 768, 768, 12, S, E); } }
        for (int rk = 0; rk < MK_REP(22); ++rk) { ws = WSL(); if (MK_ON(3)) { SchedP2KV S; S.T.init(half == 0 ? 33 : 32, 16, G, bx); S.CKV = (const char*)(wsp(ws, WS_CKV)); S.W = (const char*)(wsp(ws, WS_WUKV)); EpiP2KV E{ws, kin(10), MK_SKIPEPI(2, rep)};
          gemm_phase(lds, 512, 512, 8, S, E); } } }
        xcd_barrier(xb);
        for (int rep = 0; rep < ((MK_REPEAT >= 3 && MK_REPEAT <= 5) ? 2 : 1); ++rep) { const bool ns = (rep == 0) && (MK_REPEAT >= 3 && MK_REPEAT <= 5); const bool do_mla = !ns || MK_REPEAT != 5, do_diff = !ns || MK_REPEAT != 4; ws = WSL(); { const int x = vcu >> 5, v = vcu & 31;
          float* o1s = half == 0 ? kout() : (float*)(wsp(ws, WS_WIN));
          if (G == 256) {
#ifdef MK_VARIANT
              if (ns) { if (do_mla) for (int i = 0; i < 2; ++i) { const int pair = 8 * x + 4 * i + (v >> 3); mla_unit<MK_VARIANT>(ws, pair >> 4, pair & 15, v & 7, lds, true); }
                        if (do_diff) for (int i = 0; i < 2; ++i) { const int pair = 4 * x + 2 * i + (v >> 4); diff_unit_ps<MK_VARIANT>(ws, o1s, kin(14), pair >> 3, pair & 7, v & 15, lds, true); } } else
#endif
              {
              if (MK_ON(4) && do_mla) for (int i = 0; i < 2; ++i) { const int pair = 8 * x + 4 * i + (v >> 3); mla_unit(ws, pair >> 4, pair & 15, v & 7, lds, ns); }
              if (MK_ON(5) && do_diff) for (int i = 0; i < 2; ++i) { const int pair = 4 * x + 2 * i + (v >> 4); diff_unit_ps(ws, o1s, kin(14), pair >> 3, pair & 7, v & 15, lds, ns); }
              }
          } else {
              if (MK_ON(4)) for (int uidx = bx; uidx < 512; uidx += G) mla_unit(ws, uidx >> 7, (uidx >> 3) & 15, uidx & 7, lds, ns);
              if (MK_ON(5)) for (int uidx = bx; uidx < 512; uidx += G) diff_unit_ps(ws, o1s, kin(14), uidx >> 7, (uidx >> 4) & 7, uidx & 15, lds, ns);
          } } }
        xcd_barrier(xb);
        for (int rep = 0; rep < MK_REP(6); ++rep) { ws = WSL(); if (MK_ON(6)) { SchedP4 S; S.T.init(32, 8, G, bx); S.OA = (const char*)(wsp(ws, WS_ZA)); S.OB = (const char*)(wsp(ws, WS_ZB)); S.WA = (const char*)(wsp(ws, WS_WA)); S.WB = (const char*)(wsp(ws, WS_WB)); S.dbg = kdbg();
          EpiP4 E{ws, kdbg()}; gemm_phase(lds, 2048, 2048, 32, S, E); } }
        xcd_barrier(xb);
        for (int rep = 0; rep < MK_REP(7); ++rep) { ws = WSL(); if (MK_ON(7)) { SchedP5 S; S.T.init(32, 8, G, bx); S.MB = (const char*)(wsp(ws, WS_MB)); S.WO = (const char*)(wsp(ws, WS_WO));
          EpiP5 E{kin(0) + (size_t)half * MH * DM, kout() + (size_t)half * MH * DM}; gemm_phase(lds, 2048, 2048, 32, S, E); } }
    }
__global__ void __launch_bounds__(NTHREADS, 2) mega(Params p) {
    extern __shared__ __attribute__((aligned(16))) unsigned char lds_raw[];
    LAS unsigned char* lds = (LAS unsigned char*)lds_raw;
    cg::grid_group grid = cg::this_grid();
    const int G = gridDim.x, bx = blockIdx.x; const int vcu = (G % 8 == 0) ? (bx % 8) * (G / 8) + bx / 8 : bx;
    if (threadIdx.x < 4) ((LAS unsigned*)(lds + LDS_MISC))[threadIdx.x] = 0u;
    __syncthreads();
    const XcdBarrier xb = xcd_barrier_post((unsigned*)(kws() + WS_CTL) + 4096, (volatile LAS unsigned*)(lds + LDS_MISC));
    { unsigned* xr = (unsigned*)(kws() + WS_CTL) + 8192;
      if (threadIdx.x == 0) ((LAS unsigned*)(lds + LDS_MISC))[2] = xb_add(&xr[64 * (xb.x & 15)], 1u); }
    for (int rep = 0; rep < MK_REP(0); ++rep) { if (MK_ON(0)) p0_prologue(lds, vcu, G); }
    grid.sync();
    for (int rep = 0; rep < MK_REP(9); ++rep) xcd_barrier(xb);
    int lb = bx;
    { unsigned* xr = (unsigned*)(kws() + WS_CTL) + 8192; bool ok = (G % 8 == 0) && xb.x < 8u;
      unsigned cv[8];
#pragma unroll
      for (int j = 0; j < 8; ++j) cv[j] = xb_ld(&xr[64 * j]);
      unsigned bad = 0u;
#pragma unroll
      for (int j = 0; j < 8; ++j) bad |= cv[j] ^ (unsigned)(G / 8);
      ok = ok && (bad == 0u);
      const int rank = (int)((volatile LAS unsigned*)(lds + LDS_MISC))[2];
      if (ok) lb = rank * 8 + (int)xb.x; }
    lb = __builtin_amdgcn_readfirstlane(lb);
    const int vcu2 = (G % 8 == 0) ? (lb % 8) * (G / 8) + lb / 8 : lb;
    run_half<0>(lds, xb, G, lb, vcu2);
    run_half<1>(lds, xb, G, lb, vcu2);
}
}
extern "C" void kernel_launch(void* const* d_in, const int* in_sizes, int n_in, void* d_out, int out_size, void* d_ws, size_t ws_size, hipStream_t stream) {
    static int grid_blocks = 0;
    if (!grid_blocks) {
        int dev = 0, cus = 0, per_cu = 0;
        (void)hipGetDevice(&dev);
        (void)hipDeviceGetAttribute(&cus, hipDeviceAttributeMultiprocessorCount, dev);
        (void)hipFuncSetAttribute((const void*)mk::mega, hipFuncAttributeMaxDynamicSharedMemorySize, mk::LDS_BYTES);
        (void)hipOccupancyMaxActiveBlocksPerMultiprocessor(&per_cu, (const void*)mk::mega, mk::NTHREADS, mk::LDS_BYTES);
        if (per_cu < 1) per_cu = 1;
        grid_blocks = cus * per_cu;
        if (ws_size < mk::WS_CTL + mk::CTL_BYTES) { fprintf(stderr, "kernel_launch: workspace too small: %zu < %zu\n", ws_size, (size_t)mk::WS_END); grid_blocks = -1; }
    }
    if (grid_blocks < 0) return;
    (void)hipMemsetAsync((char*)d_ws + mk::WS_CTL, 0, mk::CTL_BYTES, stream);
    mk::Params p{};
    for (int i = 0; i < 18; ++i) p.in[i] = (const float*)d_in[i];
    p.out = (float*)d_out; p.ws = (unsigned char*)d_ws;
    void* args[] = {&p};
    hipError_t e = hipLaunchCooperativeKernel((const void*)mk::mega, dim3(grid_blocks), dim3(mk::NTHREADS), args, mk::LDS_BYTES, stream);
    if (e != hipSuccess) fprintf(stderr, "cooperative launch failed: %s (grid %d)\n", hipGetErrorString(e), grid_blocks);
}
```

```cpp
#include <hip/hip_runtime.h>
#include <hip/hip_cooperative_groups.h>
#include <math.h>
#include <stdint.h>
#include <cstdio>
namespace mk {
namespace cg = cooperative_groups;
#define LAS __attribute__((address_space(3)))
typedef unsigned short bf16;
typedef short bf16x8 __attribute__((ext_vector_type(8)));
typedef short s16x4 __attribute__((ext_vector_type(4)));
typedef float f32x4 __attribute__((ext_vector_type(4)));
typedef float f32x2 __attribute__((ext_vector_type(2)));
typedef float f32x16 __attribute__((ext_vector_type(16)));
typedef unsigned u32x4 __attribute__((ext_vector_type(4)));
typedef unsigned u32x2 __attribute__((ext_vector_type(2)));
typedef __bf16 bf16x2_t __attribute__((ext_vector_type(2)));
typedef __attribute__((address_space(1))) float GF;

constexpr int DM = 2048, NBATCH = 8, SEQ = 2048, NMETA = 16;
constexpr int HB = 4, MH = HB * SEQ, MHK = MH + 256;
constexpr int NIN = 15872;
constexpr int INW = 15680;
constexpr float EPS = 1e-6f, LOG2E = 1.4426950408889634f;
constexpr float QS_MLA = 0.07216878364870322f * LOG2E;
constexpr float QS_DIFF = 0.08838834764831845f * LOG2E;
constexpr int NWAVES = 8, NTHREADS = 512;
constexpr int T_CQ = 0, T_CKV = 3, T_KR = 5, T_ZA = 6, T_QD = 14, T_KD = 22, T_VD = 30, T_ZB = 38, T_GA = 46, T_GB = 54, T_END = 62;

constexpr size_t al(size_t x) { return (x + 4095) / 4096 * 4096; }
constexpr size_t WS_WIN = 0;
constexpr size_t WS_WUQ = WS_WIN + al((size_t)NIN * 2048 * 2);
constexpr size_t WS_WUKV = WS_WUQ + al((size_t)4096 * 768 * 2);
constexpr size_t WS_WA = WS_WUKV + al((size_t)4096 * 512 * 2);
constexpr size_t WS_WB = WS_WA + al((size_t)2048 * 2048 * 2);
constexpr size_t WS_WO = WS_WB + al((size_t)2048 * 2048 * 2);
constexpr size_t WS_UMETA = WS_WO + al((size_t)2048 * 2048 * 2);
constexpr size_t WS_TAB = WS_UMETA + al((size_t)256 * 2048 * 2);
constexpr size_t TAB_COS = 0, TAB_SIN = (size_t)2064 * 32 * 4, TAB_BIAS = 2 * TAB_SIN, TAB_LAM = TAB_BIAS + 8 * 260 * 4;
constexpr size_t WS_CQ = WS_TAB + al(TAB_LAM + 64);
constexpr size_t WS_CKV = WS_CQ + al((size_t)MHK * 768 * 2);
constexpr size_t WS_KR = WS_CKV + al((size_t)MHK * 512 * 2);
constexpr size_t WS_SSP = WS_KR + al((size_t)MHK * 64 * 2);
constexpr size_t SZ_ACT = al((size_t)MHK * 2048 * 2);
constexpr size_t WS_ZA = WS_SSP + al((size_t)MHK * 16 * 4);
constexpr size_t WS_QD = WS_ZA + SZ_ACT, WS_KD = WS_QD + SZ_ACT, WS_VD = WS_KD + SZ_ACT, WS_ZB = WS_VD + SZ_ACT, WS_SA = WS_ZB + SZ_ACT, WS_SB = WS_SA + SZ_ACT;
constexpr size_t WS_QM = WS_SB + SZ_ACT;
constexpr size_t WS_KM = WS_QM + al((size_t)MHK * 3072 * 2);
constexpr size_t WS_VM = WS_KM + al((size_t)MHK * 3072 * 2);
constexpr size_t WS_END = WS_VM + SZ_ACT;
constexpr size_t WS_MB = WS_VM;
constexpr size_t O1S_BYTES = (size_t)256 * 8 * 32 * 256 * 4;
static_assert(WS_WUKV - WS_WIN >= O1S_BYTES, "O1 stash of half 1 overlays WIN_T|WUQ_T");
constexpr size_t WS_CTL = WS_END, CTL_BYTES = 65536;
static_assert(WS_CTL + CTL_BYTES <= (size_t)512 * 1024 * 1024, "workspace");

constexpr int LDS_RING = 0, RING_BYTES = 147456;
constexpr int LDS_X = RING_BYTES;
constexpr int LDS_X2 = LDS_X + 8192;
constexpr int LDS_WSC = LDS_X2 + 1024;
constexpr int LDS_WSS = LDS_WSC + 2048;
constexpr int LDS_BT = LDS_WSS + 1024;
constexpr int LDS_MISC = LDS_BT + 1056;
constexpr int LDS_BYTES = 163840;

struct Params {
    const float* in[18];
    float* out; unsigned char* ws;
    int dbg, pad;
};

#define CAS __attribute__((address_space(4)))
typedef const float* cfp_t; typedef float* fp_t; typedef unsigned char* ucp_t;
__device__ __forceinline__ const float* kin(int k) { const volatile CAS cfp_t* kp = (const volatile CAS cfp_t*)__builtin_amdgcn_kernarg_segment_ptr(); return kp[k]; }
__device__ __forceinline__ float* kout() { const volatile CAS fp_t* kp = (const volatile CAS fp_t*)__builtin_amdgcn_kernarg_segment_ptr(); return kp[18]; }
__device__ __forceinline__ unsigned char* kws() { const volatile CAS ucp_t* kp = (const volatile CAS ucp_t*)__builtin_amdgcn_kernarg_segment_ptr(); return kp[19]; }
__device__ __forceinline__ unsigned char* wsp(unsigned char* ws, size_t off) { unsigned k = (unsigned)(off >> 12); asm volatile("" : "+s"(k)); return ws + ((size_t)k << 12); }
__device__ __forceinline__ int kdbg() { const volatile CAS int* kp = (const volatile CAS int*)__builtin_amdgcn_kernarg_segment_ptr(); return kp[40]; }
__device__ __forceinline__ unsigned cvtpk(float lo, float hi) { f32x2 v = {lo, hi}; bf16x2_t b = __builtin_convertvector(v, bf16x2_t); return __builtin_bit_cast(unsigned, b); }
__device__ __forceinline__ float bflo(unsigned u) { return __builtin_bit_cast(float, u << 16); }
__device__ __forceinline__ float bfhi(unsigned u) { return __builtin_bit_cast(float, u & 0xffff0000u); }
__device__ __forceinline__ float silu_f(float v) { return v * __builtin_amdgcn_rcpf(1.f + __expf(-v)); }
__device__ __forceinline__ float sigm_f(float v) { return __builtin_amdgcn_rcpf(1.f + __expf(-v)); }
__device__ __forceinline__ float wave_sum(float v) {
#pragma unroll
    for (int o = 1; o < 64; o <<= 1) v += __shfl_xor(v, o);
    return v;
}
__device__ __forceinline__ int crow(int r, int hi) { return (r & 3) + 8 * (r >> 2) + 4 * hi; }
__device__ __forceinline__ int opaque(int x) { asm volatile("" : "+v"(x)); return x; }
#define LDS_WAIT() asm volatile("s_waitcnt lgkmcnt(0)" ::: "memory")
#define SBAR() __builtin_amdgcn_sched_barrier(0)


#define XB_TMO      128
#define XB_XCNT(j)  (256  + 64 * (j))
#define XB_XSUB(j)  (1280 + 64 * (j))
#define XB_XGEN(j)  (2304 + 64 * (j))
#define XB_TOP      3328
#define XB_TOPGEN   3392
#define XB_SPIN_CAP (1u << 22)
__device__ __forceinline__ unsigned xb_ld(unsigned* p)              { return __hip_atomic_load(p, __ATOMIC_RELAXED, __HIP_MEMORY_SCOPE_AGENT); }
__device__ __forceinline__ unsigned xb_add(unsigned* p, unsigned v) { return __hip_atomic_fetch_add(p, v, __ATOMIC_RELAXED, __HIP_MEMORY_SCOPE_AGENT); }
__device__ __forceinline__ unsigned xb_xcc_id() { return (unsigned)__builtin_amdgcn_s_getreg((3 << 11) | 20) & 0xFu; }
#define XB_SPIN(cond, bar) do { unsigned _sp = 0; while (cond) { __builtin_amdgcn_s_sleep(1); \
    if ((++_sp & 255u) == 0u) { if (xb_ld(&(bar)[XB_TMO])) break; if (_sp > XB_SPIN_CAP) { atomicAdd(&(bar)[XB_TMO], 1u); break; } } } } while (0)
struct XcdBarrier { unsigned* bar; unsigned x; volatile LAS unsigned* st; };
__device__ __forceinline__ XcdBarrier xcd_barrier_post(unsigned* bar, volatile LAS unsigned* st) {
    XcdBarrier b; b.bar = bar; b.x = xb_xcc_id(); b.st = st;
    if (threadIdx.x == 0) (void)xb_add(&bar[XB_XCNT(b.x)], 1u);
    return b;
}
__device__ __forceinline__ void xcd_barrier_complete(unsigned* bar, unsigned x, unsigned& nloc, unsigned& nx) {
    const unsigned G = gridDim.x * gridDim.y * gridDim.z;
    unsigned sum, cnt, mine, sp = 0u;
    for (;;) {
        sum = 0u; cnt = 0u; mine = 0u;
#pragma unroll
        for (unsigned j = 0; j < 16; ++j) { const unsigned c = xb_ld(&bar[XB_XCNT(j)]); sum += c; cnt += (c > 0u) ? 1u : 0u; mine = (j == x) ? c : mine; }
        if (sum == G) break;
        __builtin_amdgcn_s_sleep(1);
        if ((++sp & 255u) == 0u) { if (xb_ld(&bar[XB_TMO])) break; if (sp > XB_SPIN_CAP) { atomicAdd(&bar[XB_TMO], 1u); break; } }
    }
    nloc = mine > 0u ? mine : 1u; nx = cnt > 0u ? cnt : 1u;
}
__device__ __forceinline__ void xcd_barrier(const XcdBarrier& b) {
    asm volatile("s_waitcnt vmcnt(0)" ::: "memory");
    __syncthreads();
    if (threadIdx.x == 0) {
        unsigned* bar = b.bar;
        __builtin_amdgcn_s_waitcnt(0);
        unsigned nloc = b.st[0], nx = b.st[1];
        if (nloc == 0u) { xcd_barrier_complete(bar, b.x, nloc, nx); b.st[0] = nloc; b.st[1] = nx; }
        const unsigned old = xb_add(&bar[XB_XSUB(b.x)], 1u);
        const unsigned gen = old / nloc;
        if (old + 1u == (gen + 1u) * nloc) {
            __builtin_amdgcn_fence(__ATOMIC_RELEASE, "agent");
            asm volatile("s_waitcnt vmcnt(0)" ::: "memory");
            (void)xb_add(&bar[XB_TOP], 1u);
        }
        XB_SPIN(xb_ld(&bar[XB_TOP]) < (gen + 1u) * nx, bar);
        __builtin_amdgcn_fence(__ATOMIC_ACQUIRE, "agent");
        asm volatile("s_waitcnt vmcnt(0)" ::: "memory");
    }
    __syncthreads();
}

constexpr int BM = 256, BK = 64, HALF = 128, HTB = HALF * BK * 2, NXCD = 8, WGM = 4;
__device__ __forceinline__ int lds_byte(int r, int c) { const int st = (r >> 4) * 2 + (c >> 5), rr = r & 15, cc = c & 31, ob = rr * 64 + cc * 2; return st * 1024 + (ob ^ (((ob >> 9) & 1) << 5)); }
__device__ __forceinline__ void stage_rc(int b, int& R, int& C) { const int st = b / 1024, sb = b % 1024, swz = sb ^ (((sb >> 9) & 1) << 5); R = (st >> 1) * 16 + swz / 64; C = (st & 1) * 32 + (swz % 64) / 2; }
__device__ __forceinline__ int perm32(int rho) { const int n = rho >> 4, i = rho & 15; return 8 * (i >> 2) + 4 * n + (i & 3); }

struct Unit { const char* A; const char* B; int pm, pn, kind; };
struct TileOrder {
    int nM, nN, nwg, G, c;
    __device__ void init(int nM_, int nN_, int G_, int c_) { nM = nM_; nN = nN_; nwg = nM * nN; G = G_; c = c_; }
    __device__ bool tile(int i, int& pm, int& pn) const {
        const long L = (long)i * G + c; if (L >= nwg) return false;
        int wgid = (int)L; { const int q = nwg / NXCD, r = nwg % NXCD, xcd = wgid % NXCD, off = wgid / NXCD; wgid = (xcd < r ? xcd * (q + 1) : r * (q + 1) + (xcd - r) * q) + off; }
        const int nig = WGM * nN, gid = wgid / nig, fm = gid * WGM, gsz = (nM - fm) < WGM ? (nM - fm) : WGM;
        pm = fm + ((wgid % nig) % gsz); pn = (wgid % nig) / gsz; return true;
    }
};

typedef f32x4 Acc[2][2][4][2];

template <class Epi, class Sched>
__device__ __forceinline__ void gemm_phase(LAS unsigned char* lds, const int lda, const int ldb, const int nt, const Sched& S, const Epi& E) {
    const int tid = opaque(threadIdx.x), wid = __builtin_amdgcn_readfirstlane(tid >> 6), lane = tid & 63, wr = wid >> 2, wc = wid & 3, fr = lane & 15, fq = lane >> 4;
    unsigned voffA[2], voffB[2];
#pragma unroll
    for (int i = 0; i < 2; ++i) { int R, C; stage_rc(tid * 16 + i * 8192, R, C); const int Rb = (R & ~31) + perm32(R & 31);
        voffA[i] = (unsigned)(R * lda + C) * 2u; voffB[i] = (unsigned)(Rb * ldb + C) * 2u; }
    const size_t kstep = (size_t)(BK * 2);
    const size_t hstepA = (size_t)HALF * lda * 2, hstepB = (size_t)HALF * ldb * 2;
    const unsigned ldsw = (unsigned)wid * 1024u;
    const int aoff = lds_byte(wr * 64 + fr, fq * 8), boff = lds_byte(wc * 32 + fr, fq * 8);
#define PG8_SA(b, h) (((b) * 2 + (h)) * HTB)
#define PG8_SB(b, h) ((4 + (b) * 2 + (h)) * HTB)
#define PG8_STAGE(bufoff, gbase, voff) do { _Pragma("unroll") for (int _i = 0; _i < 2; ++_i) \
        __builtin_amdgcn_global_load_lds((const unsigned*)((const char*)(gbase) + (voff)[_i]), (LAS unsigned*)(lds + (bufoff) + ldsw + _i * 8192), 16, 0, 0); } while (0)
#define PG8_LDA(dst, b, h) do { _Pragma("unroll") for (int m = 0; m < 4; ++m) _Pragma("unroll") for (int k = 0; k < 2; ++k) dst[m][k] = *(const LAS bf16x8*)(lds + PG8_SA(b, h) + aoff + m * 2048 + k * 1024); } while (0)
#define PG8_LDB(dst, b, h) do { _Pragma("unroll") for (int n = 0; n < 2; ++n) _Pragma("unroll") for (int k = 0; k < 2; ++k) dst[n][k] = *(const LAS bf16x8*)(lds + PG8_SB(b, h) + boff + n * 2048 + k * 1024); } while (0)
#define PG8_MMA(ai, bj, At, Bt) do { __builtin_amdgcn_s_setprio(1); _Pragma("unroll") for (int m = 0; m < 4; ++m) _Pragma("unroll") for (int n = 0; n < 2; ++n) _Pragma("unroll") for (int k = 0; k < 2; ++k) \
        acc[ai][bj][m][n] = __builtin_amdgcn_mfma_f32_16x16x32_bf16(Bt[n][k], At[m][k], acc[ai][bj][m][n], 0, 0, 0); __builtin_amdgcn_s_setprio(0); } while (0)
#define PG8_WAIT_V(n) asm volatile("s_waitcnt vmcnt(" #n ")" ::: "memory")
#define PG8_WAIT_L(n) asm volatile("s_waitcnt lgkmcnt(" #n ")" ::: "memory")
#define PG8_WAIT_VR(r) asm volatile("s_cmp_eq_u32 %0, 0\n\ts_cbranch_scc1 .Lpg8w%=\n\ts_waitcnt vmcnt(24)\n\ts_branch .Lpg8x%=\n.Lpg8w%=:\n\ts_waitcnt vmcnt(8)\n.Lpg8x%=:" :: "s"(r) : "memory", "scc")
#define PG8_BAR __builtin_amdgcn_s_barrier()
#define PG8_SCHED __builtin_amdgcn_sched_barrier(0)
    Unit cur, nxt; int ui = 0, pend = 0;
    if (!S.next(0, cur)) return;
    Acc acc;
#pragma unroll
    for (int a = 0; a < 2; ++a)
#pragma unroll
        for (int b = 0; b < 2; ++b)
#pragma unroll
            for (int m = 0; m < 4; ++m)
#pragma unroll
                for (int n = 0; n < 2; ++n) acc[a][b][m][n] = (f32x4){0.f, 0.f, 0.f, 0.f};
    bf16x8 At[4][2], B0[2][2], B1[2][2];
    const char* cA = cur.A; const char* cB = cur.B;
    PG8_STAGE(PG8_SB(0, 0), cB, voffB); PG8_STAGE(PG8_SB(0, 1), cB + hstepB, voffB); PG8_STAGE(PG8_SA(0, 0), cA, voffA); PG8_STAGE(PG8_SA(0, 1), cA + hstepA, voffA);
    if (wr == 1) PG8_BAR;
    PG8_WAIT_V(2); PG8_BAR;
    PG8_STAGE(PG8_SB(1, 0), cB + kstep, voffB); PG8_STAGE(PG8_SA(1, 0), cA + kstep, voffA); PG8_STAGE(PG8_SB(1, 1), cB + hstepB + kstep, voffB);
    PG8_WAIT_V(6); PG8_BAR;
    for (;;) {
        const bool has_next = S.next(ui + 1, nxt);
        const char* nA = has_next ? nxt.A : cA; const char* nB = has_next ? nxt.B : cB;
#define PG8_TRIP(WV) do { \
            const bool last = (t == nt - 2); \
            const char* a1 = cA + (size_t)(t + 1) * kstep; \
            const char* a2 = last ? nA : cA + (size_t)(t + 2) * kstep; const char* b2 = last ? nB : cB + (size_t)(t + 2) * kstep; \
            const char* a3 = a2 + kstep; const char* b3 = b2 + kstep; \
            PG8_LDB(B0, 0, 0); PG8_LDB(B1, 0, 1); PG8_SCHED; PG8_LDA(At, 0, 0); PG8_STAGE(PG8_SA(1, 1), a1 + hstepA, voffA); \
            if constexpr (Epi::RELAX) PG8_WAIT_VR(WV); else PG8_WAIT_V(8); PG8_WAIT_L(0); PG8_BAR; PG8_MMA(0, 0, At, B0); PG8_MMA(0, 1, At, B1); PG8_BAR; PG8_SCHED; \
            PG8_LDA(At, 0, 1); PG8_STAGE(PG8_SB(0, 0), b2, voffB); PG8_STAGE(PG8_SB(0, 1), b2 + hstepB, voffB); PG8_STAGE(PG8_SA(0, 0), a2, voffA); \
            if constexpr (Epi::RELAX) PG8_WAIT_VR(WV); else PG8_WAIT_V(8); PG8_WAIT_L(0); PG8_BAR; PG8_MMA(1, 0, At, B0); PG8_MMA(1, 1, At, B1); PG8_BAR; PG8_SCHED; \
            PG8_LDB(B0, 1, 0); PG8_LDB(B1, 1, 1); PG8_SCHED; PG8_LDA(At, 1, 0); PG8_STAGE(PG8_SA(0, 1), a2 + hstepA, voffA); \
            if constexpr (Epi::RELAX) PG8_WAIT_VR(WV); else PG8_WAIT_V(8); PG8_WAIT_L(0); PG8_BAR; PG8_MMA(0, 0, At, B0); PG8_MMA(0, 1, At, B1); PG8_BAR; PG8_SCHED; \
            PG8_LDA(At, 1, 1); PG8_STAGE(PG8_SB(1, 0), b3, voffB); PG8_STAGE(PG8_SB(1, 1), b3 + hstepB, voffB); PG8_STAGE(PG8_SA(1, 0), a3, voffA); \
            if constexpr (Epi::RELAX) PG8_WAIT_VR(WV); else PG8_WAIT_V(8); PG8_WAIT_L(0); PG8_BAR; PG8_MMA(1, 0, At, B0); PG8_MMA(1, 1, At, B1); PG8_BAR; PG8_SCHED; } while (0)
        for (int t = 0; t < nt; t += 2) { const int rel = (Epi::RELAX && t == 0) ? ui : 0; PG8_TRIP(rel); }
#undef PG8_TRIP
        if (wr == 0) PG8_BAR;
        int nst = 0;
        const bool keep = E(acc, cur, wr, wc, fr, fq, lds, nst);
        (void)nst; (void)pend;
        if (!has_next) break;
        if (!keep) {
#pragma unroll
            for (int a = 0; a < 2; ++a)
#pragma unroll
                for (int b = 0; b < 2; ++b)
#pragma unroll
                    for (int m = 0; m < 4; ++m)
#pragma unroll
                        for (int n = 0; n < 2; ++n) acc[a][b][m][n] = (f32x4){0.f, 0.f, 0.f, 0.f};
        }
        cur = nxt; cA = nA; cB = nB; ++ui;
        if (wr == 1) PG8_BAR;
    }
    PG8_WAIT_V(0);
    PG8_BAR;
#undef PG8_SA
#undef PG8_SB
#undef PG8_STAGE
#undef PG8_LDA
#undef PG8_LDB
#undef PG8_MMA
#undef PG8_WAIT_V
#undef PG8_WAIT_L
#undef PG8_WAIT_VR
#undef PG8_BAR
#undef PG8_SCHED
}

__device__ __forceinline__ void tile_half_ss(const Acc& acc, LAS unsigned char* lds, int wr, int wc, int fr, int fq, float (&ss)[2][4][2]) {
    LAS float* X = (LAS float*)(lds + LDS_X);
#pragma unroll
    for (int ai = 0; ai < 2; ++ai)
#pragma unroll
        for (int m = 0; m < 4; ++m)
#pragma unroll
            for (int bj = 0; bj < 2; ++bj) {
                const f32x4 a = acc[ai][bj][m][0], b = acc[ai][bj][m][1];
                float s = (a[0] * a[0] + a[1] * a[1]) + (a[2] * a[2] + a[3] * a[3]) + (b[0] * b[0] + b[1] * b[1]) + (b[2] * b[2] + b[3] * b[3]);
                s += __shfl_xor(s, 16); s += __shfl_xor(s, 32);
                if (fq == 0) X[((ai * 128 + wr * 64 + m * 16 + fr) * 2 + bj) * 4 + wc] = s;
            }
    LDS_WAIT(); __builtin_amdgcn_s_barrier(); asm volatile("" ::: "memory");
#pragma unroll
    for (int ai = 0; ai < 2; ++ai)
#pragma unroll
        for (int m = 0; m < 4; ++m)
#pragma unroll
            for (int bj = 0; bj < 2; ++bj) {
                const f32x4 v = *(const LAS f32x4*)(X + ((ai * 128 + wr * 64 + m * 16 + fr) * 2 + bj) * 4);
                ss[ai][m][bj] = (v[0] + v[1]) + (v[2] + v[3]);
            }
}
__device__ __forceinline__ u32x4 pack8(const f32x4 a, const f32x4 b) { u32x4 w; w.x = cvtpk(a[0], a[1]); w.y = cvtpk(a[2], a[3]); w.z = cvtpk(b[0], b[1]); w.w = cvtpk(b[2], b[3]); return w; }

struct EpiP1 {
    static constexpr bool RELAX = true;
    unsigned char* ws; const float* gqd; const float* gkd; bool skip;
    __device__ __forceinline__ bool operator()(Acc& acc, const Unit& u, int wr, int wc, int fr, int fq, LAS unsigned char* lds, int& nst) const {
        if (skip) return false;
        { const int l_ = opaque(threadIdx.x) & 63; fr = l_ & 15; fq = l_ >> 4; }
        const int pn = u.pn; const int row0 = u.pm * 256 + wr * 64 + fr;
        const int colw = wc * 32 + 8 * fq;
        if (pn < T_KR) {
            float ss[2][4][2]; tile_half_ss(acc, lds, wr, wc, fr, fq, ss);
            const bool iscq = pn < T_CKV;
            bf16* dst = iscq ? (bf16*)(wsp(ws, WS_CQ)) : (bf16*)(wsp(ws, WS_CKV)); const int ld = iscq ? 768 : 512; const int c0 = iscq ? pn * 256 : (pn - T_CKV) * 256;
            const int chunk0 = iscq ? pn * 2 : 6 + (pn - T_CKV) * 2;
            float* ssp = (float*)(wsp(ws, WS_SSP));
#pragma unroll
            for (int ai = 0; ai < 2; ++ai)
#pragma unroll
                for (int m = 0; m < 4; ++m) { const int row = row0 + ai * 128 + m * 16;
#pragma unroll
                    for (int bj = 0; bj < 2; ++bj) {
                        *(u32x4*)(dst + (size_t)row * ld + c0 + bj * 128 + colw) = pack8(acc[ai][bj][m][0], acc[ai][bj][m][1]);
                        if (wc == 0 && fq == 0) ssp[(size_t)row * 16 + chunk0 + bj] = ss[ai][m][bj];
                    } }
            nst = 16; return false;
        }
        if (pn == T_KR) {
            { bf16* dst = (bf16*)(wsp(ws, WS_KR)); bf16* dum = (bf16*)(wsp(ws, WS_CTL) + 32768) + (size_t)(threadIdx.x) * 8;
#pragma unroll
                for (int ai = 0; ai < 2; ++ai)
#pragma unroll
                    for (int m = 0; m < 4; ++m) { const int row = row0 + ai * 128 + m * 16; const u32x4 w = pack8(acc[ai][0][m][0], acc[ai][0][m][1]);
                        *(u32x4*)(wc < 2 ? dst + (size_t)row * 64 + colw : dum) = w; *(u32x4*)dum = w; } }
            return false;
        }
        if (pn >= T_QD && pn < T_VD) {
            float ss[2][4][2]; tile_half_ss(acc, lds, wr, wc, fr, fq, ss);
            const bool isq = pn < T_KD; const float* g = isq ? gqd : gkd; const float post = isq ? QS_DIFF : 1.f;
            bf16* dst = isq ? (bf16*)(wsp(ws, WS_QD)) : (bf16*)(wsp(ws, WS_KD)); const int c0 = (isq ? pn - T_QD : pn - T_KD) * 256;
            const f32x4 g0 = *(const f32x4*)(g + colw), g1 = *(const f32x4*)(g + colw + 4);
#pragma unroll
            for (int ai = 0; ai < 2; ++ai)
#pragma unroll
                for (int m = 0; m < 4; ++m) { const int row = row0 + ai * 128 + m * 16;
#pragma unroll
                    for (int bj = 0; bj < 2; ++bj) { const float rs = __builtin_amdgcn_rsqf(ss[ai][m][bj] * (1.f / 128.f) + EPS) * post;
                        *(u32x4*)(dst + (size_t)row * 2048 + c0 + bj * 128 + colw) = pack8(acc[ai][bj][m][0] * g0 * rs, acc[ai][bj][m][1] * g1 * rs); } }
            nst = 16; return false;
        }
        int mode; bf16* dst; int c0;
        if (pn < T_QD) { mode = 1; dst = (bf16*)(wsp(ws, WS_ZA)); c0 = (pn - T_ZA) * 256; }
        else if (pn < T_ZB) { mode = 0; dst = (bf16*)(wsp(ws, WS_VD)); c0 = (pn - T_VD) * 256; }
        else if (pn < T_GA) { mode = 1; dst = (bf16*)(wsp(ws, WS_ZB)); c0 = (pn - T_ZB) * 256; }
        else if (pn < T_GB) { mode = 2; dst = (bf16*)(wsp(ws, WS_SA)); c0 = (pn - T_GA) * 256; }
        else { mode = 2; dst = (bf16*)(wsp(ws, WS_SB)); c0 = (pn - T_GB) * 256; }
#pragma unroll
        for (int ai = 0; ai < 2; ++ai)
#pragma unroll
            for (int m = 0; m < 4; ++m) { const int row = row0 + ai * 128 + m * 16;
#pragma unroll
                for (int bj = 0; bj < 2; ++bj) { f32x4 a = acc[ai][bj][m][0], b = acc[ai][bj][m][1];
                    if (mode == 1) {
#pragma unroll
                        for (int e = 0; e < 4; ++e) { a[e] = silu_f(a[e]); b[e] = silu_f(b[e]); } }
                    else if (mode == 2) {
#pragma unroll
                        for (int e = 0; e < 4; ++e) { a[e] = sigm_f(a[e]); b[e] = sigm_f(b[e]); } }
                    *(u32x4*)(dst + (size_t)row * 2048 + c0 + bj * 128 + colw) = pack8(a, b); } }
        nst = 16; return false;
    }
};
struct SchedP1 {
    TileOrder T; const char* U; const char* Umeta; const char* W;
    __device__ __forceinline__ bool next(int i, Unit& u) const {
        int pm, pn; if (!T.tile(i, pm, pn)) return false;
        u.pm = pm; u.pn = pn; u.kind = 0;
        u.A = (pm < 32) ? U + (size_t)pm * 256 * 2048 * 2 : Umeta; u.B = W + (size_t)pn * 256 * 2048 * 2; return true;
    }
};

__device__ __forceinline__ float ssp_rs(const float* ssp, int row, int c0, int n, float invw) {
    float s = 0.f; for (int c = 0; c < n; ++c) s += ssp[(size_t)row * 16 + c0 + c]; return __builtin_amdgcn_rsqf(s * invw + EPS);
}
struct EpiP2Q {
    static constexpr bool RELAX = false;
    unsigned char* ws; const float* gq; bool skip;
    __device__ __forceinline__ bool operator()(Acc& acc, const Unit& u, int wr, int wc, int fr, int fq, LAS unsigned char* lds, int& nst) const {
        if (skip) return false;
        { const int l_ = opaque(threadIdx.x) & 63; fr = l_ & 15; fq = l_ >> 4; }
        const int h = u.pn; const int row0 = u.pm * 256 + wr * 64 + fr; const int colw = wc * 32 + 8 * fq;
        const float* ssp = (const float*)(wsp(ws, WS_SSP));
        float myrs[2];
        { const float* p0 = ssp + (size_t)(row0 + fq * 16) * 16; const float* p1 = p0 + (size_t)128 * 16;
          const f32x4 a0 = *(const f32x4*)p0, b0 = *(const f32x4*)p1; const f32x2 a1 = *(const f32x2*)(p0 + 4), b1 = *(const f32x2*)(p1 + 4);
          myrs[0] = __builtin_amdgcn_rsqf(((a0[0] + a0[1]) + (a0[2] + a0[3]) + (a1[0] + a1[1])) * (1.f / 768.f) + EPS);
          myrs[1] = __builtin_amdgcn_rsqf(((b0[0] + b0[1]) + (b0[2] + b0[3]) + (b1[0] + b1[1])) * (1.f / 768.f) + EPS); }
        float ss[2][4][2]; tile_half_ss(acc, lds, wr, wc, fr, fq, ss);
        float sc[2][4];
#pragma unroll
        for (int ai = 0; ai < 2; ++ai)
#pragma unroll
            for (int m = 0; m < 4; ++m) { const float rc = __shfl(myrs[ai], fr + 16 * m);
                sc[ai][m] = rc * __builtin_amdgcn_rsqf(rc * rc * (ss[ai][m][0] + ss[ai][m][1]) * (1.f / 192.f) + EPS) * QS_MLA; }
        bf16* dst = (bf16*)(wsp(ws, WS_QM));
        { const f32x4 g0 = *(const f32x4*)(gq + colw), g1 = *(const f32x4*)(gq + colw + 4);
#pragma unroll
          for (int ai = 0; ai < 2; ++ai)
#pragma unroll
            for (int m = 0; m < 4; ++m) { const int row = row0 + ai * 128 + m * 16;
                *(u32x4*)(dst + (size_t)row * 3072 + h * 192 + colw) = pack8(acc[ai][0][m][0] * g0 * sc[ai][m], acc[ai][0][m][1] * g1 * sc[ai][m]); } }
        if (wc < 2) {
            const int ib = opaque(16 * wc + 4 * fq);
            const f32x4 gr1 = *(const f32x4*)(gq + 128 + ib), gr2 = *(const f32x4*)(gq + 160 + ib);
            const float* ctab = (const float*)(wsp(ws, WS_TAB) + TAB_COS); const float* stab = (const float*)(wsp(ws, WS_TAB) + TAB_SIN);
#pragma unroll
            for (int ai = 0; ai < 2; ++ai) {
                f32x4 c[4], sn[4];
#pragma unroll
                for (int m = 0; m < 4; ++m) { const int pos = NMETA + ((row0 + ai * 128 + m * 16) & (SEQ - 1)); c[m] = *(const f32x4*)(ctab + pos * 32 + ib); sn[m] = *(const f32x4*)(stab + pos * 32 + ib); }
#pragma unroll
                for (int m = 0; m < 4; ++m) { const int row = row0 + ai * 128 + m * 16;
                    const f32x4 x1 = acc[ai][1][m][0] * gr1 * sc[ai][m], x2 = acc[ai][1][m][1] * gr2 * sc[ai][m];
                    *(u32x4*)(dst + (size_t)row * 3072 + h * 192 + 128 + colw) = pack8(x1 * c[m] - x2 * sn[m], x2 * c[m] + x1 * sn[m]); }
                asm volatile("" ::: "memory"); }
        }
        nst = 8; return false;
    }
};
struct SchedP2Q {
    TileOrder T; const char* CQ; const char* W;
    __device__ __forceinline__ bool next(int i, Unit& u) const {
        int pm, pn; if (!T.tile(i, pm, pn)) return false;
        u.pm = pm; u.pn = pn; u.kind = 0; u.A = CQ + (size_t)pm * 256 * 768 * 2; u.B = W + (size_t)pn * 256 * 768 * 2; return true;
    }
};
struct EpiP2KV {
    static constexpr bool RELAX = false;
    unsigned char* ws; const float* gk; bool skip;
    __device__ __forceinline__ bool operator()(Acc& acc, const Unit& u, int wr, int wc, int fr, int fq, LAS unsigned char* lds, int& nst) const {
        if (skip) return false;
        { const int l_ = opaque(threadIdx.x) & 63; fr = l_ & 15; fq = l_ >> 4; }
        const int h = u.pn; const int row0 = u.pm * 256 + wr * 64 + fr; const int colw = wc * 32 + 8 * fq;
        const float* ssp = (const float*)(wsp(ws, WS_SSP));
        const int tid = opaque(threadIdx.x), rr = tid >> 1, hf = tid & 1; const int rrow = u.pm * 256 + rr;
        const bf16* kr = (const bf16*)(wsp(ws, WS_KR)) + (size_t)rrow * 64 + hf * 32;
        float sr = 0.f;
        { u32x4 kv[4];
#pragma unroll
          for (int j = 0; j < 4; ++j) kv[j] = *(const u32x4*)(kr + j * 8);
#pragma unroll
          for (int j = 0; j < 4; ++j)
#pragma unroll
            for (int e = 0; e < 4; ++e) { const float a = bflo(kv[j][e]), b = bfhi(kv[j][e]); sr += a * a + b * b; } }
        sr += __shfl_xor(sr, 1);
        float myrs[2];
        { const float* p0 = ssp + (size_t)(row0 + fq * 16) * 16 + 6; const float* p1 = p0 + (size_t)128 * 16;
          const f32x2 a0 = *(const f32x2*)p0, a1 = *(const f32x2*)(p0 + 2), b0 = *(const f32x2*)p1, b1 = *(const f32x2*)(p1 + 2);
          myrs[0] = __builtin_amdgcn_rsqf(((a0[0] + a0[1]) + (a1[0] + a1[1])) * (1.f / 512.f) + EPS);
          myrs[1] = __builtin_amdgcn_rsqf(((b0[0] + b0[1]) + (b1[0] + b1[1])) * (1.f / 512.f) + EPS); }
        float rcr;
        { const float* p = ssp + (size_t)rrow * 16 + 6; const f32x2 a0 = *(const f32x2*)p, a1 = *(const f32x2*)(p + 2); rcr = __builtin_amdgcn_rsqf(((a0[0] + a0[1]) + (a1[0] + a1[1])) * (1.f / 512.f) + EPS); }
        LAS float* X2 = (LAS float*)(lds + LDS_X2);
        if (hf == 0) X2[rr] = sr;
        float ss[2][4][2]; tile_half_ss(acc, lds, wr, wc, fr, fq, ss);
        const f32x4 g0 = *(const f32x4*)(gk + colw), g1 = *(const f32x4*)(gk + colw + 4);
        bf16* kdst = (bf16*)(wsp(ws, WS_KM)); bf16* vdst = (bf16*)(wsp(ws, WS_VM));
#pragma unroll
        for (int ai = 0; ai < 2; ++ai)
#pragma unroll
            for (int m = 0; m < 4; ++m) { const int trow = ai * 128 + wr * 64 + m * 16 + fr; const int row = u.pm * 256 + trow;
                const float rc = __shfl(myrs[ai], fr + 16 * m);
                const float rk = rc * __builtin_amdgcn_rsqf((rc * rc * ss[ai][m][0] + X2[trow]) * (1.f / 192.f) + EPS);
                *(u32x4*)(kdst + (size_t)row * 3072 + h * 192 + colw) = pack8(acc[ai][0][m][0] * g0 * rk, acc[ai][0][m][1] * g1 * rk);
                *(u32x4*)(vdst + (size_t)row * 2048 + h * 128 + colw) = pack8(acc[ai][1][m][0] * rc, acc[ai][1][m][1] * rc); }
        { const LAS float* X = (const LAS float*)(lds + LDS_X); const f32x4 pv = *(const LAS f32x4*)(X + (rr * 2 + 0) * 4);
          const float rs = __builtin_amdgcn_rsqf((rcr * rcr * ((pv[0] + pv[1]) + (pv[2] + pv[3])) + sr) * (1.f / 192.f) + EPS);
          const int pos = (u.pm < 32) ? NMETA + (rrow & (SEQ - 1)) : (rr < NMETA ? rr : 0);
          const float* ctab = (const float*)(wsp(ws, WS_TAB) + TAB_COS) + pos * 32; const float* stab = (const float*)(wsp(ws, WS_TAB) + TAB_SIN) + pos * 32;
          const bf16* kr2 = kr; asm volatile("" : "+v"(kr2));
#pragma unroll
          for (int j = 0; j < 4; ++j) { const int g = hf * 4 + j; const int i0 = 4 * g; const u32x4 kvj = *(const u32x4*)(kr2 + j * 8);
              const f32x4 c = *(const f32x4*)(ctab + i0), sn = *(const f32x4*)(stab + i0), gg1 = *(const f32x4*)(gk + 128 + i0), gg2 = *(const f32x4*)(gk + 160 + i0);
              f32x4 x1 = {bflo(kvj[0]), bfhi(kvj[0]), bflo(kvj[1]), bfhi(kvj[1])}, x2 = {bflo(kvj[2]), bfhi(kvj[2]), bflo(kvj[3]), bfhi(kvj[3])};
              x1 = x1 * gg1 * rs; x2 = x2 * gg2 * rs;
              *(u32x4*)(kdst + (size_t)rrow * 3072 + h * 192 + 128 + g * 8) = pack8(x1 * c - x2 * sn, x2 * c + x1 * sn); } }
        nst = 16; return false;
    }
};
struct SchedP2KV {
    TileOrder T; const char* CKV; const char* W;
    __device__ __forceinline__ bool next(int i, Unit& u) const {
        int pm, pn; if (!T.tile(i, pm, pn)) return false;
        u.pm = pm; u.pn = pn; u.kind = 0; u.A = CKV + (size_t)pm * 256 * 512 * 2; u.B = W + (size_t)pn * 256 * 512 * 2; return true;
    }
};

struct EpiP4 {
    static constexpr bool RELAX = false;
    unsigned char* ws; int dbg;
    __device__ __forceinline__ bool operator()(Acc& acc, const Unit& u, int wr, int wc, int fr, int fq, LAS unsigned char* lds, int& nst) const {
        { const int l_ = opaque(threadIdx.x) & 63; fr = l_ & 15; fq = l_ >> 4; }
        const int row0 = u.pm * 256 + wr * 64 + fr; const int col0 = u.pn * 256 + wc * 32 + 8 * fq;
        const bf16* sa = (const bf16*)(wsp(ws, WS_SA)); const bf16* sb = (const bf16*)(wsp(ws, WS_SB)); bf16* mb = (bf16*)(wsp(ws, WS_MB));
        if (u.kind == 0 && dbg != 1) {
#pragma unroll
            for (int ai = 0; ai < 2; ++ai) { u32x4 av[4][2], bv[4][2];
#pragma unroll
                for (int m = 0; m < 4; ++m)
#pragma unroll
                    for (int bj = 0; bj < 2; ++bj) { const size_t off = (size_t)(row0 + ai * 128 + m * 16) * 2048 + col0 + bj * 128; av[m][bj] = *(const u32x4*)(sa + off); bv[m][bj] = *(const u32x4*)(sb + off); }
#pragma unroll
                for (int m = 0; m < 4; ++m)
#pragma unroll
                    for (int bj = 0; bj < 2; ++bj) { const u32x4 a = av[m][bj], b = bv[m][bj];
                        const f32x4 a0 = {bflo(a[0]), bfhi(a[0]), bflo(a[1]), bfhi(a[1])}, a1 = {bflo(a[2]), bfhi(a[2]), bflo(a[3]), bfhi(a[3])};
                        const f32x4 b0 = {bflo(b[0]), bfhi(b[0]), bflo(b[1]), bfhi(b[1])}, b1 = {bflo(b[2]), bfhi(b[2]), bflo(b[3]), bfhi(b[3])};
#pragma unroll
                        for (int e = 0; e < 4; ++e) { acc[ai][bj][m][0][e] *= a0[e] * __builtin_amdgcn_rcpf(b0[e]); acc[ai][bj][m][1][e] *= a1[e] * __builtin_amdgcn_rcpf(b1[e]); } } }
            nst = 0; return true;
        }
        if (u.kind == 0) {
#pragma unroll
            for (int ai = 0; ai < 2; ++ai)
#pragma unroll
                for (int m = 0; m < 4; ++m)
#pragma unroll
                    for (int bj = 0; bj < 2; ++bj) { const size_t off = (size_t)(row0 + ai * 128 + m * 16) * 2048 + col0 + bj * 128; const u32x4 a = *(const u32x4*)(sa + off);
                        const f32x4 a0 = {bflo(a[0]), bfhi(a[0]), bflo(a[1]), bfhi(a[1])}, a1 = {bflo(a[2]), bfhi(a[2]), bflo(a[3]), bfhi(a[3])};
                        *(u32x4*)(mb + off) = pack8(acc[ai][bj][m][0] * a0, acc[ai][bj][m][1] * a1); }
            nst = 16; return false;
        }
        { u32x4 bv[2][4][2];
#pragma unroll
          for (int ai = 0; ai < 2; ++ai)
#pragma unroll
            for (int m = 0; m < 4; ++m)
#pragma unroll
                for (int bj = 0; bj < 2; ++bj) bv[ai][m][bj] = *(const u32x4*)(sb + (size_t)(row0 + ai * 128 + m * 16) * 2048 + col0 + bj * 128);
#pragma unroll
          for (int ai = 0; ai < 2; ++ai)
#pragma unroll
            for (int m = 0; m < 4; ++m)
#pragma unroll
                for (int bj = 0; bj < 2; ++bj) { const u32x4 b = bv[ai][m][bj];
                    const f32x4 b0 = {bflo(b[0]), bfhi(b[0]), bflo(b[1]), bfhi(b[1])}, b1 = {bflo(b[2]), bfhi(b[2]), bflo(b[3]), bfhi(b[3])};
                    *(u32x4*)(mb + (size_t)(row0 + ai * 128 + m * 16) * 2048 + col0 + bj * 128) = pack8(acc[ai][bj][m][0] * b0, acc[ai][bj][m][1] * b1); } }
        nst = 16; return false;
    }
};
struct SchedP4 {
    TileOrder T; const char* OA; const char* OB; const char* WA; const char* WB; int dbg;
    __device__ __forceinline__ bool next(int i, Unit& u) const {
        int pm, pn; const int ti = dbg ? i : (i >> 1), kd = dbg ? (dbg - 1) : (i & 1);
        if (!T.tile(ti, pm, pn)) return false;
        u.pm = pm; u.pn = pn; u.kind = kd;
        u.A = (kd ? OB : OA) + (size_t)pm * 256 * 2048 * 2; u.B = (kd ? WB : WA) + (size_t)pn * 256 * 2048 * 2; return true;
    }
};
struct EpiP5 {
    static constexpr bool RELAX = true;
    const float* x; float* out;
    __device__ __forceinline__ bool operator()(Acc& acc, const Unit& u, int wr, int wc, int fr, int fq, LAS unsigned char* lds, int& nst) const {
        { const int l_ = opaque(threadIdx.x) & 63; fr = l_ & 15; fq = l_ >> 4; }
        const int row0 = u.pm * 256 + wr * 64 + fr; const int col0 = u.pn * 256 + wc * 32 + 8 * fq;
        f32x4 xa[4][2][2], xb[4][2][2];
#pragma unroll
        for (int m = 0; m < 4; ++m)
#pragma unroll
            for (int bj = 0; bj < 2; ++bj) { const size_t off = (size_t)(row0 + m * 16) * 2048 + col0 + bj * 128; xa[m][bj][0] = *(const f32x4*)(x + off); xa[m][bj][1] = *(const f32x4*)(x + off + 4); }
#pragma unroll
        for (int m = 0; m < 4; ++m)
#pragma unroll
            for (int bj = 0; bj < 2; ++bj) { xa[m][bj][0] += acc[0][bj][m][0]; xa[m][bj][1] += acc[0][bj][m][1]; }
#pragma unroll
        for (int m = 0; m < 4; ++m)
#pragma unroll
            for (int bj = 0; bj < 2; ++bj) { const size_t off = (size_t)(row0 + 128 + m * 16) * 2048 + col0 + bj * 128; xb[m][bj][0] = *(const f32x4*)(x + off); xb[m][bj][1] = *(const f32x4*)(x + off + 4); }
#pragma unroll
        for (int m = 0; m < 4; ++m)
#pragma unroll
            for (int bj = 0; bj < 2; ++bj) { const size_t off = (size_t)(row0 + m * 16) * 2048 + col0 + bj * 128; *(f32x4*)(out + off) = xa[m][bj][0]; *(f32x4*)(out + off + 4) = xa[m][bj][1]; }
#pragma unroll
        for (int m = 0; m < 4; ++m)
#pragma unroll
            for (int bj = 0; bj < 2; ++bj) { const size_t off = (size_t)(row0 + 128 + m * 16) * 2048 + col0 + bj * 128; *(f32x4*)(out + off) = xb[m][bj][0] + acc[1][bj][m][0]; *(f32x4*)(out + off + 4) = xb[m][bj][1] + acc[1][bj][m][1]; }
        nst = 32; return false;
    }
};
struct SchedP5 {
    TileOrder T; const char* MB; const char* WO;
    __device__ __forceinline__ bool next(int i, Unit& u) const {
        int pm, pn; if (!T.tile(i, pm, pn)) return false;
        u.pm = pm; u.pn = pn; u.kind = 0; u.A = MB + (size_t)pm * 256 * 2048 * 2; u.B = WO + (size_t)pn * 256 * 2048 * 2; return true;
    }
};

constexpr float NEGBIG = -1e30f;
constexpr float THR_L2 = 8.f * LOG2E;
template <int NCB> __device__ __forceinline__ int v_st(int k, int c) { const int kk = (k & ~0xC) | ((k & 4) << 1) | ((k & 8) >> 1); return ((kk >> 3) * NCB + (c >> 5)) * 512 + ((kk & 7) * 32 + (c & 31)) * 2; }
__device__ __forceinline__ int v_rd_base(int lane) { return ((lane & 3) << 3) | (((lane >> 2) & 3) << 6) | (((lane >> 4) & 1) << 5) | (((lane >> 5) & 1) << 8); }
typedef short v4i16_t __attribute__((ext_vector_type(4)));
typedef LAS const char* lds_cptr;
__device__ __forceinline__ s16x4 vtr(lds_cptr p) { return __builtin_bit_cast(s16x4, __builtin_amdgcn_ds_read_tr16_b64_v4i16((LAS v4i16_t*)p)); }
template <int NCB> __device__ __forceinline__ void pv_all(f32x16* o, lds_cptr vp, bf16x8 pa0, bf16x8 pa1, bf16x8 pa2, bf16x8 pa3) {
    constexpr int KS = NCB * 1024, HF = NCB * 512;
#pragma unroll
    for (int d0 = 0; d0 < NCB; ++d0) {
        const s16x4 l0 = vtr(vp + d0 * 512 + 0 * KS), h0 = vtr(vp + d0 * 512 + 0 * KS + HF), l1 = vtr(vp + d0 * 512 + 1 * KS), h1 = vtr(vp + d0 * 512 + 1 * KS + HF);
        const s16x4 l2 = vtr(vp + d0 * 512 + 2 * KS), h2 = vtr(vp + d0 * 512 + 2 * KS + HF), l3 = vtr(vp + d0 * 512 + 3 * KS), h3 = vtr(vp + d0 * 512 + 3 * KS + HF);
#define PK(L, H) (bf16x8){L[0], L[1], L[2], L[3], H[0], H[1], H[2], H[3]}
        o[d0] = __builtin_amdgcn_mfma_f32_32x32x16_bf16(pa0, PK(l0, h0), o[d0], 0, 0, 0);
        o[d0] = __builtin_amdgcn_mfma_f32_32x32x16_bf16(pa1, PK(l1, h1), o[d0], 0, 0, 0);
        o[d0] = __builtin_amdgcn_mfma_f32_32x32x16_bf16(pa2, PK(l2, h2), o[d0], 0, 0, 0);
        o[d0] = __builtin_amdgcn_mfma_f32_32x32x16_bf16(pa3, PK(l3, h3), o[d0], 0, 0, 0);
#undef PK
    }
}

template <int DQK, int DV, bool BIAS, int VAR = 0>
__device__ __forceinline__ void attn_pass(f32x16 (&o)[DV / 32], float& l_out, const bf16* __restrict__ Q, int ldq, const bf16* __restrict__ Kr, const bf16* __restrict__ Km, int ldk,
                                          const bf16* __restrict__ Vr, const bf16* __restrict__ Vm, int ldv, int q0, LAS unsigned char* ldsb) {
    constexpr int NKP = 64 * DQK * 2 / 8192, NVP = 64 * DV * 2 / 8192, KB = 64 * DQK * 2, VB = 64 * DV * 2, ND0 = DV / 32, NQ = DQK / 16, NCB = DV / 32;
    const int tid = opaque(threadIdx.x), lane = tid & 63, r32 = lane & 31, hi = lane >> 5; const int wid = __builtin_amdgcn_readfirstlane(tid >> 6);
    char* lds = (char*)ldsb;
    float* wsc = (float*)(lds + LDS_WSC) + wid * 64; float* al_l = wsc + 32;
    const float* btab = (const float*)(lds + LDS_BT);
    const int qw0 = q0 + wid * 32;
    bf16x8 qr[NQ];
    { const bf16* Qw = Q + (size_t)(wid * 32 + r32) * ldq + hi * 8;
#pragma unroll
      for (int d0 = 0; d0 < NQ; ++d0) qr[d0] = *(const bf16x8*)(Qw + d0 * 16); }
    const lds_cptr vp0 = (lds_cptr)ldsb + 3 * KB + v_rd_base(lane);
#define KXW(row) ((DQK == 128) ? ((row) & 15) : (((row) >> 1) & 7))
    constexpr int NKO = (DQK == 128) ? 8 : 4;
    int koff[NKO];
#pragma unroll
    for (int d0 = 0; d0 < NKO; ++d0) koff[d0] = r32 * (DQK * 2) + (((2 * d0 + hi) ^ KXW(r32)) << 4);
#define KOFF(d0) (koff[(d0) % NKO] + ((d0) / NKO) * (NKO * 32))
    unsigned ksrc[NKP], vsrc[NVP];
#pragma unroll
    for (int j = 0; j < NKP; ++j) { const int off = 8192 * j + 16 * tid, row = off / (DQK * 2), cpos = (off % (DQK * 2)) >> 4; ksrc[j] = (unsigned)(row * ldk + ((cpos ^ KXW(row)) << 3)); }
#pragma unroll
    for (int j = 0; j < NVP; ++j) { const int off = 8192 * j + 16 * tid, st = off >> 9, kk = (st / NCB) * 8 + ((off & 511) >> 6), c = (st % NCB) * 32 + ((off & 63) >> 1);
        const int k = (kk & ~0xC) | ((kk & 4) << 1) | ((kk & 8) >> 1); vsrc[j] = (unsigned)(k * ldv + c); }
    const unsigned ldsw = (unsigned)wid * 1024u;
#define DMA_K(t, KO_) do { const bf16* kp = (t) == 0 ? Km : Kr + (size_t)((VAR == 1 ? ((t) & 1) + 1 : (t)) - 1) * 64 * ldk; \
        _Pragma("unroll") for (int j = 0; j < NKP; ++j) __builtin_amdgcn_global_load_lds((const unsigned*)(kp + ksrc[j]), (LAS unsigned*)(ldsb + (KO_) + 8192 * j + ldsw), 16, 0, 0); } while (0)
#define DMA_V(t, VO_) do { const bf16* vp = (t) == 0 ? Vm : Vr + (size_t)((VAR == 1 ? ((t) & 1) + 1 : (t)) - 1) * 64 * ldv; \
        _Pragma("unroll") for (int j = 0; j < NVP; ++j) __builtin_amdgcn_global_load_lds((const unsigned*)(vp + vsrc[j]), (LAS unsigned*)(ldsb + 3 * KB + (VO_) + 8192 * j + ldsw), 16, 0, 0); } while (0)
#define WAITBAR_N() do { if (VAR == 2) asm volatile("s_waitcnt vmcnt(%0) lgkmcnt(0)" :: "n"(NKP + NVP) : "memory"); else if (VAR == 3) asm volatile("s_waitcnt lgkmcnt(0)\n\ts_barrier" ::: "memory"); else asm volatile("s_waitcnt vmcnt(%0) lgkmcnt(0)\n\ts_barrier" :: "n"(NKP + NVP) : "memory"); } while (0)
#define WAITBAR_0() do { if (VAR == 2) asm volatile("s_waitcnt vmcnt(0) lgkmcnt(0)" ::: "memory"); else asm volatile("s_waitcnt vmcnt(0) lgkmcnt(0)\n\ts_barrier" ::: "memory"); } while (0)
    float mhat = 0.f, l_reg = 0.f, ccur = 0.f;
    f32x16 negm;
#pragma unroll
    for (int r = 0; r < 16; ++r) negm[r] = 0.f;
#pragma unroll
    for (int d = 0; d < ND0; ++d) o[d] = (f32x16){0.f, 0.f, 0.f, 0.f, 0.f, 0.f, 0.f, 0.f, 0.f, 0.f, 0.f, 0.f, 0.f, 0.f, 0.f, 0.f};
#define PK4(P, BASE, OUT) do { unsigned a0 = cvtpk(P[BASE + 0], P[BASE + 1]), a1 = cvtpk(P[BASE + 2], P[BASE + 3]), b0_ = cvtpk(P[BASE + 4], P[BASE + 5]), b1_ = cvtpk(P[BASE + 6], P[BASE + 7]); \
        auto r0 = __builtin_amdgcn_permlane32_swap(a0, b0_, false, false); auto r1 = __builtin_amdgcn_permlane32_swap(a1, b1_, false, false); \
        u32x4 w = {r0[0], r1[0], r0[1], r1[1]}; OUT = __builtin_bit_cast(bf16x8, w); } while (0)
#define LOADV(VV, D0) do { _Pragma("unroll") for (int ks_ = 0; ks_ < 4; ++ks_) { VV[2 * ks_] = vtr(vp_ + (D0) * 512 + ks_ * (NCB * 1024)); VV[2 * ks_ + 1] = vtr(vp_ + (D0) * 512 + ks_ * (NCB * 1024) + NCB * 512); } } while (0)
#define VFRAG(VV, ks_) (bf16x8){VV[2 * (ks_)][0], VV[2 * (ks_)][1], VV[2 * (ks_)][2], VV[2 * (ks_)][3], VV[2 * (ks_) + 1][0], VV[2 * (ks_) + 1][1], VV[2 * (ks_) + 1][2], VV[2 * (ks_) + 1][3]}
#define MMAV(VV, D0) do { o[D0] = __builtin_amdgcn_mfma_f32_32x32x16_bf16(pa0, VFRAG(VV, 0), o[D0], 0, 0, 0); if (VAR != 7) { o[D0] = __builtin_amdgcn_mfma_f32_32x32x16_bf16(pa1, VFRAG(VV, 1), o[D0], 0, 0, 0); \
        o[D0] = __builtin_amdgcn_mfma_f32_32x32x16_bf16(pa2, VFRAG(VV, 2), o[D0], 0, 0, 0); o[D0] = __builtin_amdgcn_mfma_f32_32x32x16_bf16(pa3, VFRAG(VV, 3), o[D0], 0, 0, 0); } else { asm volatile("" :: "v"(VV[2]), "v"(VV[3]), "v"(VV[4]), "v"(VV[5]), "v"(VV[6]), "v"(VV[7]), "v"(pa1), "v"(pa2), "v"(pa3)); } } while (0)
#define STEP(MODE_, TR_, KO_, VO_, DMA_STMT) do { \
        f32x16 p0, p1; \
        bool cinit = true;        \
        if ((MODE_) == 0) { cinit = false; \
            float neg_ = NEGBIG, zer_ = 0.f; asm volatile("" : "+v"(neg_), "+v"(zer_)); \
            _Pragma("unroll") for (int r = 0; r < 16; ++r) { p1[r] = neg_; \
                if (r < 8) { if (BIAS) { int idx = crow(r, hi) - NMETA - (qw0 + r32) + 128; idx = idx < 0 ? 0 : idx; p0[r] = btab[idx]; } else p0[r] = zer_; } \
                else p0[r] = neg_; } \
        } else if (BIAS) { \
            const int d = 64 * (TR_) - qw0; \
            if (d <= -154 || d >= 122) { const float cn = btab[d < 0 ? 0 : 256] - mhat; \
                if (__any(cn != ccur)) { ccur = cn; _Pragma("unroll") for (int r = 0; r < 16; ++r) negm[r] = cn; } } \
            else { cinit = false; const int ib = d + 4 * hi - r32 + 128; \
                _Pragma("unroll") for (int r = 0; r < 16; ++r) { int i0 = ib + (r & 3) + 8 * (r >> 2), i1 = i0 + 32; \
                    i0 = i0 < 0 ? 0 : (i0 > 256 ? 256 : i0); i1 = i1 < 0 ? 0 : (i1 > 256 ? 256 : i1); p0[r] = btab[i0] - mhat; p1[r] = btab[i1] - mhat; \
                    if ((r & 3) == 3) asm volatile("" ::: "memory"); } } \
        } \
        { const LAS char* Kb = (const LAS char*)ldsb + (KO_); bf16x8 kp[3][2]; \
          kp[0][0] = *(const LAS bf16x8*)(Kb + KOFF(0)); kp[0][1] = *(const LAS bf16x8*)(Kb + KOFF(0) + 32 * (DQK * 2)); \
          kp[1][0] = *(const LAS bf16x8*)(Kb + KOFF(1)); kp[1][1] = *(const LAS bf16x8*)(Kb + KOFF(1) + 32 * (DQK * 2)); \
          _Pragma("unroll") for (int d0 = 0; d0 < NQ; ++d0) { \
              SBAR(); \
              if (d0 + 2 < NQ) { if (VAR != 6) { kp[(d0 + 2) % 3][0] = *(const LAS bf16x8*)(Kb + KOFF(d0 + 2)); kp[(d0 + 2) % 3][1] = *(const LAS bf16x8*)(Kb + KOFF(d0 + 2) + 32 * (DQK * 2)); } else { kp[(d0 + 2) % 3][0] = kp[d0 % 3][0]; kp[(d0 + 2) % 3][1] = kp[d0 % 3][1]; } } \
              if (d0 == 0 && cinit) { p0 = __builtin_amdgcn_mfma_f32_32x32x16_bf16(kp[0][0], qr[0], negm, 0, 0, 0); p1 = __builtin_amdgcn_mfma_f32_32x32x16_bf16(kp[0][1], qr[0], negm, 0, 0, 0); } \
              else if (VAR != 7 || d0 == 0) { p0 = __builtin_amdgcn_mfma_f32_32x32x16_bf16(kp[d0 % 3][0], qr[d0], p0, 0, 0, 0); p1 = __builtin_amdgcn_mfma_f32_32x32x16_bf16(kp[d0 % 3][1], qr[d0], p1, 0, 0, 0); } \
              else { asm volatile("" :: "v"(kp[d0 % 3][0]), "v"(kp[d0 % 3][1])); } } \
          SBAR(); } \
        const lds_cptr vp_ = vp0 + (VO_); s16x4 va[8], vb[8]; \
        LOADV(va, 0); SBAR(); \
        DMA_STMT; SBAR(); \
          \
        float rm = fmaxf(fmaxf(p0[0], p0[1]), p1[0]); \
        _Pragma("unroll") for (int r = 2; r < 16; r += 2) rm = fmaxf(fmaxf(rm, p0[r]), p0[r + 1]); \
        _Pragma("unroll") for (int r = 1; r < 16; r += 2) rm = fmaxf(fmaxf(rm, p1[r]), p1[(r + 1) & 15]); \
        { auto rr = __builtin_amdgcn_permlane32_swap(__float_as_uint(rm), __float_as_uint(rm), false, false); rm = fmaxf(__uint_as_float(rr[0]), __uint_as_float(rr[1])); } \
        if ((MODE_) == 0 || __builtin_expect(__any(rm > THR_L2), 0)) { \
            const float dl = (MODE_) == 0 ? rm : fmaxf(rm, 0.f); mhat += dl; ccur -= dl; \
            _Pragma("unroll") for (int r = 0; r < 16; ++r) { p0[r] -= dl; p1[r] -= dl; negm[r] = ccur; } \
            if ((MODE_) != 0) { const float f = __builtin_amdgcn_exp2f(-dl); l_reg *= f; \
                if (hi == 0) al_l[r32] = f; asm volatile("s_waitcnt lgkmcnt(0)" ::: "memory"); \
                _Pragma("unroll") for (int d = 0; d < ND0; ++d) _Pragma("unroll") for (int r = 0; r < 16; ++r) o[d][r] *= al_l[crow(r, hi)]; } } \
        float ps = 0.f; \
        if (VAR != 4) { \
        _Pragma("unroll") for (int r = 0; r < 16; ++r) { p0[r] = __builtin_amdgcn_exp2f(p0[r]); ps += p0[r]; } \
        _Pragma("unroll") for (int r = 0; r < 16; ++r) { p1[r] = __builtin_amdgcn_exp2f(p1[r]); ps += p1[r]; } } \
        { auto rr = __builtin_amdgcn_permlane32_swap(__float_as_uint(ps), __float_as_uint(ps), false, false); ps = __uint_as_float(rr[0]) + __uint_as_float(rr[1]); } \
        l_reg += ps; \
        bf16x8 pa0, pa1, pa2, pa3; \
        PK4(p0, 0, pa0); PK4(p0, 8, pa1); PK4(p1, 0, pa2); PK4(p1, 8, pa3); \
        if (VAR != 5) { \
        _Pragma("unroll") for (int d0 = 0; d0 < NCB; d0 += 2) { \
            SBAR(); if (d0 + 1 < NCB) LOADV(vb, d0 + 1); MMAV(va, d0); \
            SBAR(); if (d0 + 2 < NCB) LOADV(va, d0 + 2); if (d0 + 1 < NCB) MMAV(vb, d0 + 1); } \
        } else { asm volatile("" :: "v"(pa0), "v"(pa1), "v"(pa2), "v"(pa3), "v"(va[0]), "v"(va[7])); } \
        SBAR(); } while (0)
    int kc = 0, kn = KB, kf = 2 * KB, vc = 0, vn = VB, vf = 2 * VB;
#define ROT() do { const int a_ = kc; kc = kn; kn = kf; kf = a_; const int b_ = vc; vc = vn; vn = vf; vf = b_; } while (0)
    DMA_K(0, 0); DMA_V(0, 0); DMA_K(1, KB); DMA_V(1, VB); WAITBAR_N();
    STEP(0, 0, kc, vc, { DMA_K(2, kf); DMA_V(2, vf); }); WAITBAR_N(); ROT();
#pragma unroll 1
    for (int t = 1; t <= 30; ++t) { STEP(1, t - 1, kc, vc, { if (VAR != 3) { DMA_K(t + 2, kf); DMA_V(t + 2, vf); } }); WAITBAR_N(); ROT(); }
    STEP(1, 30, kc, vc, {}); WAITBAR_0(); ROT();
    STEP(1, 31, kc, vc, {});
    __syncthreads();
#undef ROT
#undef STEP
#undef LOADV
#undef VFRAG
#undef MMAV
#undef KXW
#undef KOFF
#undef PK4
#undef DMA_K
#undef DMA_V
#undef WAITBAR_N
#undef WAITBAR_0
    l_out = l_reg;
}

template <int VAR = 0> __device__ __forceinline__ void mla_unit(unsigned char* ws, int bl, int h, int qb, LAS unsigned char* ldsb, bool nostore = false) {
    const int tid = opaque(threadIdx.x); int lane = tid & 63, r32 = lane & 31, hi = lane >> 5; const int wid = __builtin_amdgcn_readfirstlane(tid >> 6);
    char* lds = (char*)ldsb; float* wsc = (float*)(lds + LDS_WSC) + wid * 64;
    const size_t rb = (size_t)bl * SEQ; const int q0 = qb * 256;
    const bf16* QM = (const bf16*)(wsp(ws, WS_QM)); const bf16* KM = (const bf16*)(wsp(ws, WS_KM)); const bf16* VM = (const bf16*)(wsp(ws, WS_VM));
    f32x16 o[4]; float l;
    attn_pass<192, 128, false, VAR>(o, l, QM + (rb + q0) * 3072 + h * 192, 3072, KM + rb * 3072 + h * 192, KM + (size_t)MH * 3072 + h * 192, 3072,
                               VM + rb * 2048 + h * 128, VM + (size_t)MH * 2048 + h * 128, 2048, q0, ldsb);
    lane = opaque(lane); r32 = lane & 31; hi = lane >> 5;
    bf16* zp = (bf16*)(wsp(ws, WS_ZA)) + (rb + q0 + wid * 32 + (lane >> 4)) * 2048 + h * 128 + (lane & 15) * 8;
    u32x4 zv[8];
#pragma unroll
    for (int i = 0; i < 8; ++i) zv[i] = *(const u32x4*)(zp + (size_t)i * 4 * 2048);
    if (hi == 0) wsc[r32] = l; LDS_WAIT();
    bf16* stg = (bf16*)(lds + wid * 8192);
#pragma unroll
    for (int r = 0; r < 16; ++r) { const float rl = __builtin_amdgcn_rcpf(wsc[crow(r, hi)]); const int orow = crow(r, hi);
#pragma unroll
        for (int d0 = 0; d0 < 4; ++d0) { const unsigned w = cvtpk(o[d0][r] * rl, 0.f); stg[orow * 128 + d0 * 32 + r32] = (bf16)(w & 0xffffu); } }
    LDS_WAIT();
    const bf16* sp = stg + (lane >> 4) * 128 + (lane & 15) * 8;
#pragma unroll
    for (int i = 0; i < 8; ++i) {
        const u32x4 s = *(const u32x4*)(sp + i * 4 * 128); const u32x4 z = zv[i]; u32x4 w;
#pragma unroll
        for (int e = 0; e < 4; ++e) w[e] = cvtpk(bflo(s[e]) * bflo(z[e]), bfhi(s[e]) * bfhi(z[e]));
        if (!nostore) *(u32x4*)(zp + (size_t)i * 4 * 2048) = w; }
    __syncthreads();
}
constexpr int PS_PX = 131072;
template <int VAR = 0>
__device__ __forceinline__ void attn_pass_ps(f32x16 (&o)[4], float& l_out, const bf16* __restrict__ Q, int ldq, const bf16* __restrict__ Kr, const bf16* __restrict__ Km, int ldk,
                                             const bf16* __restrict__ Vr, const bf16* __restrict__ Vm, int ldv, int q0, LAS unsigned char* ldsb) {
    constexpr int NKP = 2, NVP = 4, KB = 16384, VB = 32768, NQ = 8, NCB = 8, VR0 = 2 * KB;
    const int tid = opaque(threadIdx.x), lane = tid & 63, r32 = lane & 31, hi = lane >> 5; const int wid = __builtin_amdgcn_readfirstlane(tid >> 6);
    const int pair = wid >> 1, half = wid & 1, grp = wid >> 2;
    char* lds = (char*)ldsb;
    float* wsc = (float*)(lds + LDS_WSC) + wid * 64; float* al_l = wsc + 32;
    float* rmx = (float*)(lds + LDS_WSS);
    const float* btab = (const float*)(lds + LDS_BT);
    const int qw0 = q0 + pair * 32;
    bf16x8 qr[NQ];
    { const bf16* Qw = Q + (size_t)(pair * 32 + r32) * ldq + hi * 8;
#pragma unroll
      for (int d0 = 0; d0 < NQ; ++d0) qr[d0] = *(const bf16x8*)(Qw + d0 * 16); }
    const lds_cptr vp0 = (lds_cptr)ldsb + VR0 + v_rd_base(lane) + half * (4 * 512);
    int koff[NQ];
#pragma unroll
    for (int d0 = 0; d0 < NQ; ++d0) koff[d0] = (32 * half + r32) * 256 + (((2 * d0 + hi) ^ (r32 & 15)) << 4);
    unsigned ksrc[NKP], vsrc[NVP];
#pragma unroll
    for (int j = 0; j < NKP; ++j) { const int off = 8192 * j + 16 * tid, row = off >> 8, cpos = (off & 255) >> 4; ksrc[j] = (unsigned)(row * ldk + ((cpos ^ (row & 15)) << 3)); }
#pragma unroll
    for (int j = 0; j < NVP; ++j) { const int off = 8192 * j + 16 * tid, st = off >> 9, kk = (st / NCB) * 8 + ((off & 511) >> 6), c = (st % NCB) * 32 + ((off & 63) >> 1);
        const int k = (kk & ~0xC) | ((kk & 4) << 1) | ((kk & 8) >> 1); vsrc[j] = (unsigned)(k * ldv + c); }
    const unsigned ldsw = (unsigned)wid * 1024u;
    const LAS char* pxo = (const LAS char*)ldsb + PS_PX + wid * 2048 + lane * 16;
    const LAS char* pxp = (const LAS char*)ldsb + PS_PX + (wid ^ 1) * 2048 + lane * 16;
#define DMA_K(t, KO_) do { const bf16* kp_ = (t) == 0 ? Km : Kr + (size_t)((t) - 1) * 64 * ldk; \
        _Pragma("unroll") for (int j = 0; j < NKP; ++j) __builtin_amdgcn_global_load_lds((const unsigned*)(kp_ + ksrc[j]), (LAS unsigned*)(ldsb + (KO_) + 8192 * j + ldsw), 16, 0, 0); } while (0)
#define DMA_V(t, VO_) do { const bf16* vp_g = (t) == 0 ? Vm : Vr + (size_t)((t) - 1) * 64 * ldv; \
        _Pragma("unroll") for (int j = 0; j < NVP; ++j) __builtin_amdgcn_global_load_lds((const unsigned*)(vp_g + vsrc[j]), (LAS unsigned*)(ldsb + VR0 + (VO_) + 8192 * j + ldsw), 16, 0, 0); } while (0)
#define BAR_L() asm volatile("s_waitcnt lgkmcnt(0)\n\ts_barrier" ::: "memory")
#define WAIT_E() asm volatile("s_waitcnt vmcnt(%0) lgkmcnt(0)\n\ts_barrier" :: "n"(NKP + NVP) : "memory")
#define WAIT_O() asm volatile("s_waitcnt vmcnt(%0) lgkmcnt(0)\n\ts_barrier" :: "n"(NVP) : "memory")
#define WAITBAR_0() asm volatile("s_waitcnt vmcnt(0) lgkmcnt(0)\n\ts_barrier" ::: "memory")
    float mhat = 0.f, l_reg = 0.f, ccur = 0.f;
#pragma unroll
    for (int d = 0; d < 4; ++d) o[d] = (f32x16){0.f, 0.f, 0.f, 0.f, 0.f, 0.f, 0.f, 0.f, 0.f, 0.f, 0.f, 0.f, 0.f, 0.f, 0.f, 0.f};
#define PK4(P, BASE, OUT) do { unsigned a0 = cvtpk(P[BASE + 0], P[BASE + 1]), a1 = cvtpk(P[BASE + 2], P[BASE + 3]), b0_ = cvtpk(P[BASE + 4], P[BASE + 5]), b1_ = cvtpk(P[BASE + 6], P[BASE + 7]); \
        auto r0 = __builtin_amdgcn_permlane32_swap(a0, b0_, false, false); auto r1 = __builtin_amdgcn_permlane32_swap(a1, b1_, false, false); \
        u32x4 w = {r0[0], r1[0], r0[1], r1[1]}; OUT = __builtin_bit_cast(bf16x8, w); } while (0)
#define LOADV(VV, D0) do { _Pragma("unroll") for (int j_ = 0; j_ < 2; ++j_) { VV[2 * j_] = vtr(vown_ + (D0) * 512 + j_ * 8192); VV[2 * j_ + 1] = vtr(vown_ + (D0) * 512 + j_ * 8192 + 4096); \
        VV[4 + 2 * j_] = vtr(vpar_ + (D0) * 512 + j_ * 8192); VV[4 + 2 * j_ + 1] = vtr(vpar_ + (D0) * 512 + j_ * 8192 + 4096); } } while (0)
#define VFRAG(VV, ks_) (bf16x8){VV[2 * (ks_)][0], VV[2 * (ks_)][1], VV[2 * (ks_)][2], VV[2 * (ks_)][3], VV[2 * (ks_) + 1][0], VV[2 * (ks_) + 1][1], VV[2 * (ks_) + 1][2], VV[2 * (ks_) + 1][3]}
#define MMAV(VV, D0) do { o[D0] = __builtin_amdgcn_mfma_f32_32x32x16_bf16(pk0, VFRAG(VV, 0), o[D0], 0, 0, 0); o[D0] = __builtin_amdgcn_mfma_f32_32x32x16_bf16(pk1, VFRAG(VV, 1), o[D0], 0, 0, 0); \
        o[D0] = __builtin_amdgcn_mfma_f32_32x32x16_bf16(pk2, VFRAG(VV, 2), o[D0], 0, 0, 0); o[D0] = __builtin_amdgcn_mfma_f32_32x32x16_bf16(pk3, VFRAG(VV, 3), o[D0], 0, 0, 0); } while (0)
#define H1(MODE_, TR_, KO_, DMA_STMT) do { \
        f32x16 p; bool cinit = true; \
        if ((MODE_) == 0) { cinit = false; float neg_ = NEGBIG; asm volatile("" : "+v"(neg_)); \
            _Pragma("unroll") for (int r = 0; r < 16; ++r) { if (r < 8 && half == 0) { int idx = crow(r, hi) - NMETA - (qw0 + r32) + 128; idx = idx < 0 ? 0 : idx; p[r] = btab[idx] - mhat; } else p[r] = neg_; } \
        } else { const int d = 64 * (TR_) + 32 * half - qw0; \
            if (d <= -122 || d >= 122) { const float cn = btab[d < 0 ? 0 : 256] - mhat; \
                ccur = cn; } \
            else { cinit = false; const int ib = d + 4 * hi - r32 + 128; \
                _Pragma("unroll") for (int r = 0; r < 16; ++r) { int i0 = ib + (r & 3) + 8 * (r >> 2); i0 = i0 < 0 ? 0 : (i0 > 256 ? 256 : i0); p[r] = btab[i0] - mhat; \
                    if ((r & 3) == 3) asm volatile("" ::: "memory"); } } } \
        if (cinit) { _Pragma("unroll") for (int r = 0; r < 16; ++r) p[r] = ccur; }        \
        { const LAS char* Kb = (const LAS char*)ldsb + (KO_); bf16x8 kp[3]; \
          kp[0] = *(const LAS bf16x8*)(Kb + koff[0]); kp[1] = *(const LAS bf16x8*)(Kb + koff[1]); \
          _Pragma("unroll") for (int d0 = 0; d0 < NQ; ++d0) { \
              SBAR(); if (d0 + 2 < NQ) kp[(d0 + 2) % 3] = *(const LAS bf16x8*)(Kb + koff[d0 + 2]); \
              p = __builtin_amdgcn_mfma_f32_32x32x16_bf16(kp[d0 % 3], qr[d0], p, 0, 0, 0); } \
          SBAR(); } \
        DMA_STMT; SBAR(); \
        rm = fmaxf(fmaxf(p[0], p[1]), p[2]); \
        _Pragma("unroll") for (int r = 3; r < 15; r += 2) rm = fmaxf(fmaxf(rm, p[r]), p[r + 1]); \
        rm = fmaxf(rm, p[15]); \
        { auto rr = __builtin_amdgcn_permlane32_swap(__float_as_uint(rm), __float_as_uint(rm), false, false); rm = fmaxf(__uint_as_float(rr[0]), __uint_as_float(rr[1])); } \
        if (hi == 0) rmx[wid * 32 + r32] = rm; \
        float ps = 0.f; \
        _Pragma("unroll") for (int r = 0; r < 16; ++r) { p[r] = __builtin_amdgcn_exp2f(p[r]); ps += p[r]; } \
        { auto rr = __builtin_amdgcn_permlane32_swap(__float_as_uint(ps), __float_as_uint(ps), false, false); ps = __uint_as_float(rr[0]) + __uint_as_float(rr[1]); } \
        l_reg += ps; \
        PK4(p, 0, pw0); PK4(p, 8, pw1); \
        *(LAS bf16x8*)(pxo) = pw0; *(LAS bf16x8*)(pxo + 1024) = pw1; } while (0)
#define H2(VO_, DMA_STMT) do { \
        DMA_STMT; SBAR(); \
        const lds_cptr vown_ = vp0 + (VO_) + half * 16384, vpar_ = vp0 + (VO_) + (1 - half) * 16384; s16x4 va[8], vb[8]; \
        LOADV(va, 0); \
        const bf16x8 pq0 = *(const LAS bf16x8*)(pxp), pq1 = *(const LAS bf16x8*)(pxp + 1024); \
        const float rmp = fmaxf(rm, rmx[(wid ^ 1) * 32 + r32]); \
        const bf16x8 pk0 = pw0, pk1 = pw1, pk2 = pq0, pk3 = pq1; \
        SBAR(); LOADV(vb, 1); MMAV(va, 0); \
        SBAR(); LOADV(va, 2); MMAV(vb, 1); \
        SBAR(); LOADV(vb, 3); MMAV(va, 2); \
        SBAR(); MMAV(vb, 3); \
        SBAR(); \
        if (__builtin_expect(__any(rmp > THR_L2), 0)) {   \
            const float dl = fmaxf(rmp, 0.f); mhat += dl; ccur -= dl; \
            const float f = __builtin_amdgcn_exp2f(-dl); l_reg *= f; \
            if (hi == 0) al_l[r32] = f; asm volatile("s_waitcnt lgkmcnt(0)" ::: "memory"); \
            _Pragma("unroll") for (int dd = 0; dd < 4; ++dd) { _Pragma("unroll") for (int r = 0; r < 16; ++r) o[dd][r] *= al_l[crow(r, hi)]; } } } while (0)
    bf16x8 pw0, pw1; float rm;
    int v0 = 0, v1 = VB, v2 = 2 * VB;
#define ROTV() do { const int b_ = v0; v0 = v1; v1 = v2; v2 = b_; } while (0)
#define KS(t) (((t) & 1) * KB)
    DMA_K(0, 0); DMA_V(0, 0); DMA_K(1, KB); DMA_V(1, VB);
    asm volatile("s_waitcnt vmcnt(%0) lgkmcnt(0)\n\ts_barrier" :: "n"(NKP + 2 * NVP) : "memory");
    if (grp == 0) {
        H1(0, 0, KS(0), {}); WAIT_E(); H2(v0, { DMA_V(2, v2); }); WAIT_O(); ROTV();
#pragma unroll 1
        for (int t = 1; t <= 30; ++t) { H1(1, t - 1, KS(t), { DMA_K(t + 1, KS(t + 1)); }); WAIT_E(); H2(v0, { DMA_V(t + 2, v2); }); WAIT_O(); ROTV(); }
        H1(1, 30, KS(31), { DMA_K(32, KS(32)); }); WAIT_E(); H2(v0, {}); WAITBAR_0(); ROTV();
        H1(1, 31, KS(32), {}); WAITBAR_0(); H2(v0, {}); BAR_L();
        BAR_L();
    } else {
        WAIT_E();
        H1(0, 0, KS(0), {}); WAIT_O(); H2(v0, { DMA_K(2, KS(2)); DMA_V(2, v2); }); WAIT_E(); ROTV();
#pragma unroll 1
        for (int t = 1; t <= 30; ++t) { H1(1, t - 1, KS(t), {}); WAIT_O(); H2(v0, { DMA_K(t + 2, KS(t + 2)); DMA_V(t + 2, v2); }); WAIT_E(); ROTV(); }
        H1(1, 30, KS(31), {}); WAITBAR_0(); H2(v0, {}); WAITBAR_0(); ROTV();
        H1(1, 31, KS(32), {}); BAR_L(); H2(v0, {}); BAR_L();
    }
    if (hi == 0) rmx[wid * 32 + r32] = l_reg;
    BAR_L();
    l_out = l_reg + rmx[(wid ^ 1) * 32 + r32];
    __syncthreads();
#undef ROTV
#undef KS
#undef H1
#undef H2
#undef LOADV
#undef VFRAG
#undef MMAV
#undef PK4
#undef DMA_K
#undef DMA_V
#undef BAR_L
#undef WAIT_E
#undef WAIT_O
#undef WAITBAR_0
}

template <int VAR = 0> __device__ __forceinline__ void diff_unit_ps(unsigned char* ws, float* o1s, const float* subln, int bl, int h, int qb, LAS unsigned char* ldsb, bool nostore = false) {
    const int tid = opaque(threadIdx.x); int lane = tid & 63, r32 = lane & 31, hi = lane >> 5; const int wid = __builtin_amdgcn_readfirstlane(tid >> 6);
    const int pair = wid >> 1, half = wid & 1;
    char* lds = (char*)ldsb; float* wsc = (float*)(lds + LDS_WSC) + wid * 64; float* wss = (float*)(lds + LDS_X);
    const size_t rb = (size_t)bl * SEQ; const int q0 = qb * 128;
    const bf16* QD = (const bf16*)(wsp(ws, WS_QD)); const bf16* KD = (const bf16*)(wsp(ws, WS_KD)); const bf16* VD = (const bf16*)(wsp(ws, WS_VD));
    { float* bt = (float*)(lds + LDS_BT); const float* src = (const float*)(wsp(ws, WS_TAB) + TAB_BIAS) + h * 260; if (tid < 257) bt[tid] = src[tid]; }
    __syncthreads();
    const float lam = *(const float*)(wsp(ws, WS_TAB) + TAB_LAM);
    const size_t stb = ((size_t)blockIdx.x * 4 + pair) * (32 * 256) + half * 128;
#pragma unroll 1
    for (int mp = 0; mp < 2; ++mp) {
        f32x16 o[4]; float l;
        attn_pass_ps<VAR>(o, l, QD + (rb + q0) * 2048 + h * 256 + mp * 128, 2048, KD + rb * 2048 + h * 256 + mp * 128, KD + (size_t)MH * 2048 + h * 256 + mp * 128, 2048,
                          VD + rb * 2048 + h * 256, VD + (size_t)MH * 2048 + h * 256, 2048, q0, ldsb);
        lane = opaque(lane); r32 = lane & 31; hi = lane >> 5;
        GF* st = (GF*)o1s + stb + r32;
        if (mp == 0) {
            if (hi == 0) wsc[r32] = l; LDS_WAIT();
#pragma unroll
            for (int r = 0; r < 16; ++r) { const float rl = __builtin_amdgcn_rcpf(wsc[crow(r, hi)]); GF* sp = st + crow(r, hi) * 256; asm volatile("" : "+v"(sp));
#pragma unroll
                for (int d0 = 0; d0 < 4; ++d0) sp[d0 * 32] = o[d0][r] * rl; }
            asm volatile("s_waitcnt vmcnt(0) lgkmcnt(0)" ::: "memory");
        } else {
            float o1[16][4];
#pragma unroll
            for (int r = 0; r < 16; ++r) { const GF* sp = st + crow(r, hi) * 256;
#pragma unroll
                for (int d0 = 0; d0 < 4; ++d0) o1[r][d0] = sp[d0 * 32]; }
            if (hi == 0) wsc[r32] = l; LDS_WAIT();
            float* ys = (float*)(lds + wid * 16384) + r32;
#pragma unroll
            for (int r = 0; r < 16; ++r) { const float rl = __builtin_amdgcn_rcpf(wsc[crow(r, hi)]); float sq = 0.f;
#pragma unroll
                for (int d0 = 0; d0 < 4; ++d0) { const float y = o1[r][d0] - lam * (o[d0][r] * rl); ys[crow(r, hi) * 128 + d0 * 32] = y; sq += y * y; }
                sq += __shfl_xor(sq, 1); sq += __shfl_xor(sq, 2); sq += __shfl_xor(sq, 4); sq += __shfl_xor(sq, 8); sq += __shfl_xor(sq, 16);
                if (r32 == 0) wss[wid * 32 + crow(r, hi)] = sq; }
        }
    }
    { bf16* zp = (bf16*)(wsp(ws, WS_ZB)) + (rb + q0 + pair * 32 + (lane >> 4)) * 2048 + h * 256 + half * 128 + (lane & 15) * 8;
      u32x4 zv[8];
#pragma unroll
      for (int i = 0; i < 8; ++i) zv[i] = *(const u32x4*)(zp + (size_t)i * 4 * 2048);
      const f32x4 g0 = *(const f32x4*)(subln + half * 128 + (lane & 15) * 8), g1 = *(const f32x4*)(subln + half * 128 + (lane & 15) * 8 + 4);
      __syncthreads();
      const float* yl = (const float*)(lds + wid * 16384) + (lane >> 4) * 128 + (lane & 15) * 8;
#pragma unroll
      for (int i = 0; i < 8; ++i) { const int row = 4 * i + (lane >> 4);
          const float rsn = __builtin_amdgcn_rsqf((wss[wid * 32 + row] + wss[(wid ^ 1) * 32 + row]) * (1.f / 256.f) + EPS) * 0.8f;
          const f32x4 y0 = *(const f32x4*)(yl + i * 4 * 128), y1 = *(const f32x4*)(yl + i * 4 * 128 + 4); const u32x4 z = zv[i]; u32x4 w;
          w[0] = cvtpk(y0[0] * rsn * g0[0] * bflo(z[0]), y0[1] * rsn * g0[1] * bfhi(z[0])); w[1] = cvtpk(y0[2] * rsn * g0[2] * bflo(z[1]), y0[3] * rsn * g0[3] * bfhi(z[1]));
          w[2] = cvtpk(y1[0] * rsn * g1[0] * bflo(z[2]), y1[1] * rsn * g1[1] * bfhi(z[2])); w[3] = cvtpk(y1[2] * rsn * g1[2] * bflo(z[3]), y1[3] * rsn * g1[3] * bfhi(z[3]));
          if (!nostore) *(u32x4*)(zp + (size_t)i * 4 * 2048) = w; } }
    __syncthreads();
}

template <int VAR = 0> __device__ __forceinline__ void diff_unit(unsigned char* ws, float* o1s, const float* subln, int bl, int h, int qb, LAS unsigned char* ldsb, bool nostore = false) {
    const int tid = opaque(threadIdx.x); int lane = tid & 63, r32 = lane & 31, hi = lane >> 5; const int wid = __builtin_amdgcn_readfirstlane(tid >> 6);
    char* lds = (char*)ldsb; float* wsc = (float*)(lds + LDS_WSC) + wid * 64; float* wss = (float*)(lds + LDS_WSS) + wid * 32;
    const size_t rb = (size_t)bl * SEQ; const int q0 = qb * 256;
    const bf16* QD = (const bf16*)(wsp(ws, WS_QD)); const bf16* KD = (const bf16*)(wsp(ws, WS_KD)); const bf16* VD = (const bf16*)(wsp(ws, WS_VD));
    { float* bt = (float*)(lds + LDS_BT); const float* src = (const float*)(wsp(ws, WS_TAB) + TAB_BIAS) + h * 260; for (int i = tid; i < 257; i += NTHREADS) bt[i] = src[i]; }
    __syncthreads();
    const float lam = *(const float*)(wsp(ws, WS_TAB) + TAB_LAM);
#pragma unroll 1
    for (int pass = 0; pass < 4; ++pass) {
        const int mp = pass >> 1, vh = pass & 1;
        f32x16 o[4]; float l;
        attn_pass<128, 128, true, VAR>(o, l, QD + (rb + q0) * 2048 + h * 256 + mp * 128, 2048, KD + rb * 2048 + h * 256 + mp * 128, KD + (size_t)MH * 2048 + h * 256 + mp * 128, 2048,
                                  VD + rb * 2048 + h * 256 + vh * 128, VD + (size_t)MH * 2048 + h * 256 + vh * 128, 2048, q0, ldsb);
        lane = opaque(lane); r32 = lane & 31; hi = lane >> 5;
        if (hi == 0) wsc[r32] = l; LDS_WAIT();
        GF* st = (GF*)o1s + ((size_t)blockIdx.x * 8 + wid) * (32 * 256) + vh * 128 + r32;
        if (mp == 0) {
#pragma unroll
            for (int r = 0; r < 16; ++r) { const float rl = __builtin_amdgcn_rcpf(wsc[crow(r, hi)]); GF* sp = st + crow(r, hi) * 256;
#pragma unroll
                for (int d0 = 0; d0 < 4; ++d0) sp[d0 * 32] = o[d0][r] * rl; }
        } else {
#pragma unroll
            for (int r = 0; r < 16; ++r) { const float rl = __builtin_amdgcn_rcpf(wsc[crow(r, hi)]); GF* sp = st + crow(r, hi) * 256; float sq = 0.f;
#pragma unroll
                for (int d0 = 0; d0 < 4; ++d0) { const float y = sp[d0 * 32] - lam * (o[d0][r] * rl); sp[d0 * 32] = y; sq += y * y; }
                sq += __shfl_xor(sq, 1); sq += __shfl_xor(sq, 2); sq += __shfl_xor(sq, 4); sq += __shfl_xor(sq, 8); sq += __shfl_xor(sq, 16);
                if (r32 == 0) { if (vh == 0) wss[crow(r, hi)] = sq; else wss[crow(r, hi)] += sq; } }
        }
        asm volatile("s_waitcnt vmcnt(0) lgkmcnt(0)" ::: "memory");
    }
    { const GF* yp = (const GF*)o1s + ((size_t)blockIdx.x * 8 + wid) * (32 * 256) + (lane >> 5) * 256 + (lane & 31) * 8;
      bf16* zp = (bf16*)(wsp(ws, WS_ZB)) + (rb + q0 + wid * 32 + (lane >> 5)) * 2048 + h * 256 + (lane & 31) * 8;
      const f32x4 g0 = *(const f32x4*)(subln + (lane & 31) * 8), g1 = *(const f32x4*)(subln + (lane & 31) * 8 + 4);
#pragma unroll 4
      for (int i = 0; i < 16; ++i, zp += 2 * 2048, yp += 2 * 256) {
          const float rsn = __builtin_amdgcn_rsqf(wss[2 * i + (lane >> 5)] * (1.f / 256.f) + EPS) * 0.8f;
          const f32x4 y0 = *(const __attribute__((address_space(1))) f32x4*)yp, y1 = *(const __attribute__((address_space(1))) f32x4*)(yp + 4); const u32x4 z = *(const u32x4*)zp; u32x4 w;
          w[0] = cvtpk(y0[0] * rsn * g0[0] * bflo(z[0]), y0[1] * rsn * g0[1] * bfhi(z[0])); w[1] = cvtpk(y0[2] * rsn * g0[2] * bflo(z[1]), y0[3] * rsn * g0[3] * bfhi(z[1]));
          w[2] = cvtpk(y1[0] * rsn * g1[0] * bflo(z[2]), y1[1] * rsn * g1[1] * bfhi(z[2])); w[3] = cvtpk(y1[2] * rsn * g1[2] * bflo(z[3]), y1[3] * rsn * g1[3] * bfhi(z[3]));
          if (!nostore) *(u32x4*)zp = w; } }
    __syncthreads();
}

template <class Map>
__device__ __forceinline__ void transpose_item(const float* __restrict__ W, int Nsrc, int K, bf16* __restrict__ WT, LAS float* scr, int item, int lane, const float* __restrict__ gain, Map map) {
    const int nkb = K / 64, nb = item / nkb, kb = item % nkb, k0 = 64 * kb, n0 = 64 * nb;
    const int sc = map(n0 + lane);
    float v[64];
    const float* wp = W + (size_t)k0 * Nsrc + (sc >= 0 ? sc : 0);
#pragma unroll
    for (int i = 0; i < 64; ++i) v[i] = wp[(size_t)i * Nsrc];
    if (gain) {
#pragma unroll
        for (int i = 0; i < 64; ++i) v[i] *= gain[k0 + i]; }
#pragma unroll
    for (int i = 0; i < 64; ++i) scr[i * 65 + lane] = (sc >= 0) ? v[i] : 0.f;
    LDS_WAIT(); asm volatile("" ::: "memory");
    const int c = lane & 7;
#pragma unroll
    for (int j = 0; j < 8; ++j) { const int n = (lane >> 3) + 8 * j; const LAS float* s = scr + (8 * c) * 65 + n;
        u32x4 o; o.x = cvtpk(s[0 * 65], s[1 * 65]); o.y = cvtpk(s[2 * 65], s[3 * 65]); o.z = cvtpk(s[4 * 65], s[5 * 65]); o.w = cvtpk(s[6 * 65], s[7 * 65]);
        *(u32x4*)(WT + (size_t)(n0 + n) * K + k0 + 8 * c) = o; }
    LDS_WAIT(); asm volatile("" ::: "memory");
}
__device__ __forceinline__ int rope_orig(int c) { return 32 * ((c >> 2) & 1) + 4 * (c >> 3) + (c & 3); }
struct MapWin { __device__ int operator()(int n) const { if (n < 1280) return n; if (n < 1536) { const int c = n - 1280; return c < 64 ? 1280 + rope_orig(c) : -1; } return n - 192; } };
struct MapWuq { __device__ int operator()(int n) const { const int h = n >> 8, c = n & 255; if (c < 128) return h * 192 + c; if (c < 192) return h * 192 + 128 + rope_orig(c - 128); return -1; } };
struct MapId { __device__ int operator()(int n) const { return n; } };

__device__ __forceinline__ int t5_bucket(int rel) {
    const int n = rel < 0 ? -rel : rel; int b;
    if (n < 8) b = n; else b = 8 + (n >= 12) + (n >= 16) + (n >= 23) + (n >= 32) + (n >= 46) + (n >= 64) + (n >= 91);
    return b + (rel > 0 ? 16 : 0);
}
__device__ __forceinline__ void rms_row_bf16(const float* __restrict__ xrow, const float* __restrict__ g, bf16* __restrict__ orow, int lane) {
    u32x4* o16 = (u32x4*)orow + lane;
    if (!xrow) {
#pragma unroll
        for (int j = 0; j < 4; ++j) o16[64 * j] = (u32x4){0u, 0u, 0u, 0u};
        return; }
    const f32x4* xr = (const f32x4*)xrow + 2 * lane; const f32x4* gr = (const f32x4*)g + 2 * lane;
    f32x4 v[8]; float s = 0.f;
#pragma unroll
    for (int j = 0; j < 4; ++j) { v[2 * j] = xr[128 * j]; v[2 * j + 1] = xr[128 * j + 1]; }
#pragma unroll
    for (int j = 0; j < 8; ++j) s += (v[j][0] * v[j][0] + v[j][1] * v[j][1]) + (v[j][2] * v[j][2] + v[j][3] * v[j][3]);
    const float rs = __builtin_amdgcn_rsqf(wave_sum(s) * (1.f / 2048.f) + EPS);
#pragma unroll
    for (int j = 0; j < 4; ++j) { const f32x4 g0 = gr[128 * j], g1 = gr[128 * j + 1]; const f32x4 y0 = v[2 * j] * rs * g0, y1 = v[2 * j + 1] * rs * g1;
        o16[64 * j] = (u32x4){cvtpk(y0[0], y0[1]), cvtpk(y0[2], y0[3]), cvtpk(y1[0], y1[1]), cvtpk(y1[2], y1[3])}; }
}
__device__ __forceinline__ void rms_row2_bf16(const float* __restrict__ x0, const float* __restrict__ x1, const float* __restrict__ g, bf16* __restrict__ o0, bf16* __restrict__ o1, int lane) {
    const f32x4* xa = (const f32x4*)x0 + 2 * lane; const f32x4* xb = (const f32x4*)x1 + 2 * lane; const f32x4* gr = (const f32x4*)g + 2 * lane;
    f32x4 va[8], vb[8]; float sa = 0.f, sb = 0.f;
#pragma unroll
    for (int j = 0; j < 4; ++j) { va[2 * j] = xa[128 * j]; va[2 * j + 1] = xa[128 * j + 1]; vb[2 * j] = xb[128 * j]; vb[2 * j + 1] = xb[128 * j + 1]; }
#pragma unroll
    for (int j = 0; j < 8; ++j) { sa += (va[j][0] * va[j][0] + va[j][1] * va[j][1]) + (va[j][2] * va[j][2] + va[j][3] * va[j][3]); sb += (vb[j][0] * vb[j][0] + vb[j][1] * vb[j][1]) + (vb[j][2] * vb[j][2] + vb[j][3] * vb[j][3]); }
    const float ra = __builtin_amdgcn_rsqf(wave_sum(sa) * (1.f / 2048.f) + EPS), rb = __builtin_amdgcn_rsqf(wave_sum(sb) * (1.f / 2048.f) + EPS);
    u32x4* oa = (u32x4*)o0 + lane; u32x4* ob = (u32x4*)o1 + lane;
#pragma unroll
    for (int j = 0; j < 4; ++j) { const f32x4 g0 = gr[128 * j], g1 = gr[128 * j + 1];
        const f32x4 y0 = va[2 * j] * ra * g0, y1 = va[2 * j + 1] * ra * g1, z0 = vb[2 * j] * rb * g0, z1 = vb[2 * j + 1] * rb * g1;
        oa[64 * j] = (u32x4){cvtpk(y0[0], y0[1]), cvtpk(y0[2], y0[3]), cvtpk(y1[0], y1[1]), cvtpk(y1[2], y1[3])};
        ob[64 * j] = (u32x4){cvtpk(z0[0], z0[1]), cvtpk(z0[2], z0[3]), cvtpk(z1[0], z1[1]), cvtpk(z1[2], z1[3])}; }
}
template <int PART>
__device__ __forceinline__ void p0_part(LAS unsigned char* ldsb, int vcu, int G) {
    const int tid = opaque(threadIdx.x), lane = tid & 63; const int wave = __builtin_amdgcn_readfirstlane(tid >> 6);
    LAS float* scr = (LAS float*)(ldsb + wave * 16896);
    const int gw = vcu * NWAVES + wave, NGW = G * NWAVES;
    unsigned char* ws = kws();
    constexpr int I_WIN = (NIN / 64) * 32, I_WUQ = 64 * 12, I_WUKV = 64 * 8, I_SQ = 32 * 32;
    if (PART == 0) {
        for (int it = gw; it < I_WIN + I_WUQ + I_WUKV; it += NGW) {
            int r = it;
            if (r < I_WIN) { transpose_item(kin(4), INW, 2048, (bf16*)(wsp(ws, WS_WIN)), scr, r, lane, nullptr, MapWin()); continue; } r -= I_WIN;
            if (r < I_WUQ) { transpose_item(kin(7), 3072, 768, (bf16*)(wsp(ws, WS_WUQ)), scr, r, lane, kin(5), MapWuq()); continue; } r -= I_WUQ;
            transpose_item(kin(8), 4096, 512, (bf16*)(wsp(ws, WS_WUKV)), scr, r, lane, kin(6), MapId());
        }
    } else {
        for (int it = gw; it < 3 * I_SQ; it += NGW) {
            int r = it;
            if (r < I_SQ) { transpose_item(kin(15), 2048, 2048, (bf16*)(wsp(ws, WS_WA)), scr, r, lane, nullptr, MapId()); continue; } r -= I_SQ;
            if (r < I_SQ) { transpose_item(kin(16), 2048, 2048, (bf16*)(wsp(ws, WS_WB)), scr, r, lane, nullptr, MapId()); continue; } r -= I_SQ;
            transpose_item(kin(17), 2048, 2048, (bf16*)(wsp(ws, WS_WO)), scr, r, lane, nullptr, MapId());
        }
    }
    bf16* ureal = (bf16*)((unsigned char*)kout() + (size_t)64 * 1024 * 1024); bf16* umeta = (bf16*)(wsp(ws, WS_UMETA));
    constexpr int RB = PART == 0 ? 0 : MH, NR = PART == 0 ? MH + 256 : MH;
    for (int r = gw; r < NR; r += 2 * NGW) {
        const int r2 = r + NGW;
        if (r2 < MH) { const int m = RB + r, m2 = RB + r2; rms_row2_bf16(kin(0) + (size_t)m * DM, kin(0) + (size_t)m2 * DM, kin(3), ureal + (size_t)m * DM, ureal + (size_t)m2 * DM, lane); continue; }
#pragma unroll 1
        for (int q = 0; q < 2; ++q) { const int rr = r + q * NGW; if (rr >= NR) break;
            if (rr < MH) { const int mm = RB + rr; rms_row_bf16(kin(0) + (size_t)mm * DM, kin(3), ureal + (size_t)mm * DM, lane); }
            else { const int j = rr - MH; rms_row_bf16(j < NMETA ? kin(1) + (size_t)j * DM : nullptr, kin(3), umeta + (size_t)j * DM, lane); } }
    }
    if (PART == 0) {
        const int gt = vcu * NTHREADS + tid, NGT = G * NTHREADS;
        float* ctab = (float*)(wsp(ws, WS_TAB) + TAB_COS); float* stab = (float*)(wsp(ws, WS_TAB) + TAB_SIN); float* btab = (float*)(wsp(ws, WS_TAB) + TAB_BIAS);
        for (int i = gt; i < 2064 * 32; i += NGT) { const int pos = i >> 5, k = i & 31; const float inv = powf(10000.f, -(float)k / 32.f); const float ang = (float)pos * inv; ctab[i] = cosf(ang); stab[i] = sinf(ang); }
        for (int i = gt; i < 8 * 257; i += NGT) { const int h = i / 257, j = i % 257; btab[h * 260 + j] = kin(2)[t5_bucket(j - 128) * 8 + h] * LOG2E; }
        if (vcu == 0 && wave == 0) { const float* dl = kin(13);
            float a = dl[lane] * dl[128 + lane] + dl[64 + lane] * dl[192 + lane], b = dl[256 + lane] * dl[384 + lane] + dl[320 + lane] * dl[448 + lane];
            a = wave_sum(a); b = wave_sum(b); if (lane == 0) *(float*)(wsp(ws, WS_TAB) + TAB_LAM) = __expf(a) - __expf(b) + 0.2f; }
    }
}

#ifndef MK_PH_LO
#define MK_PH_LO 0
#define MK_PH_HI 99
#endif
#ifndef MK_ONLY
#define MK_ON(n) 1
#else
#define MK_ON(n) (MK_ONLY == (n))
#endif
#ifndef MK_REPEAT
#define MK_REPEAT -1
#endif
#ifdef MK_VARIANT
#define MK_SKIPEPI(n, rep) ((MK_VARIANT == 9) && (MK_REPEAT == (n)) && (rep) == 0)
#else
#define MK_SKIPEPI(n, rep) false
#endif
#define MK_REP(n) ((MK_REPEAT == (n)) ? 2 : ((n) == 9 ? 0 : 1))
#define WSL() kws()
template <int half> __device__ __forceinline__ void run_half(LAS unsigned char* lds, const XcdBarrier& xb, int G, int bx, int vcu) {
        unsigned char* ws;
        for (int rep = 0; rep < MK_REP(1); ++rep) { ws = WSL(); if (MK_ON(1)) { SchedP1 S; S.T.init(half == 0 ? 33 : 32, 62, G, bx); S.U = (const char*)kout() + (size_t)64 * 1024 * 1024 + (size_t)half * MH * 2048 * 2; S.Umeta = (const char*)(wsp(ws, WS_UMETA)); S.W = (const char*)(wsp(ws, WS_WIN));
          EpiP1 E{ws, kin(11), kin(12), MK_SKIPEPI(1, rep)};
          gemm_phase(lds, 2048, 2048, 32, S, E); } }
        xcd_barrier(xb);
        for (int rep = 0; rep < MK_REP(2); ++rep) { for (int rq = 0; rq < MK_REP(21); ++rq) { ws = WSL(); if (MK_ON(2)) { SchedP2Q S; S.T.init(32, 16, G, bx); S.CQ = (const char*)(wsp(ws, WS_CQ)); S.W = (const char*)(wsp(ws, WS_WUQ)); EpiP2Q E{ws, kin(9), MK_SKIPEPI(2, rep)};
          gemm_phase(lds, 768, 768, 12, S, E); } }
        for (int rk = 0; rk < MK_REP(22); ++rk) { ws = WSL(); if (MK_ON(3)) { SchedP2KV S; S.T.init(half == 0 ? 33 : 32, 16, G, bx); S.CKV = (const char*)(wsp(ws, WS_CKV)); S.W = (const char*)(wsp(ws, WS_WUKV)); EpiP2KV E{ws, kin(10), MK_SKIPEPI(2, rep)};
          gemm_phase(lds, 512, 512, 8, S, E); } } }
        xcd_barrier(xb);
        for (int rep = 0; rep < ((MK_REPEAT >= 3 && MK_REPEAT <= 5) ? 2 : 1); ++rep) { const bool ns = (rep == 0) && (MK_REPEAT >= 3 && MK_REPEAT <= 5); const bool do_mla = !ns || MK_REPEAT != 5, do_diff = !ns || MK_REPEAT != 4; ws = WSL(); { const int x = vcu >> 5, v = vcu & 31;
          float* o1s = half == 0 ? kout() : (float*)(wsp(ws, WS_WIN));
          if (G == 256) {
#ifdef MK_VARIANT
              if (ns) { if (do_mla) for (int i = 0; i < 2; ++i) { const int pair = 8 * x + 4 * i + (v >> 3); mla_unit<MK_VARIANT>(ws, pair >> 4, pair & 15, v & 7, lds, true); }
                        if (do_diff) for (int i = 0; i < 2; ++i) { const int pair = 4 * x + 2 * i + (v >> 4); diff_unit_ps<MK_VARIANT>(ws, o1s, kin(14), pair >> 3, pair & 7, v & 15, lds, true); } } else
#endif
              {
              if (MK_ON(4) && do_mla) for (int i = 0; i < 2; ++i) { if (half == 0 && (vcu & 3) == i) { p0_part<1>(lds, vcu, G); __syncthreads(); }
                  const int pair = 8 * x + 4 * i + (v >> 3); mla_unit(ws, pair >> 4, pair & 15, v & 7, lds, ns); }
              if (MK_ON(5) && do_diff) for (int i = 0; i < 2; ++i) { if (half == 0 && (vcu & 3) == 2 + i) { p0_part<1>(lds, vcu, G); __syncthreads(); }
                  const int pair = 4 * x + 2 * i + (v >> 4); diff_unit_ps(ws, o1s, kin(14), pair >> 3, pair & 7, v & 15, lds, ns); }
              }
          } else {
              if (half == 0) { p0_part<1>(lds, vcu, G); __syncthreads(); }
              if (MK_ON(4)) for (int uidx = bx; uidx < 512; uidx += G) mla_unit(ws, uidx >> 7, (uidx >> 3) & 15, uidx & 7, lds, ns);
              if (MK_ON(5)) for (int uidx = bx; uidx < 512; uidx += G) diff_unit_ps(ws, o1s, kin(14), uidx >> 7, (uidx >> 4) & 7, uidx & 15, lds, ns);
          } } }
        xcd_barrier(xb);
        for (int rep = 0; rep < MK_REP(6); ++rep) { ws = WSL(); if (MK_ON(6)) { SchedP4 S; S.T.init(32, 8, G, bx); S.OA = (const char*)(wsp(ws, WS_ZA)); S.OB = (const char*)(wsp(ws, WS_ZB)); S.WA = (const char*)(wsp(ws, WS_WA)); S.WB = (const char*)(wsp(ws, WS_WB)); S.dbg = kdbg();
          EpiP4 E{ws, kdbg()}; gemm_phase(lds, 2048, 2048, 32, S, E); } }
        xcd_barrier(xb);
        for (int rep = 0; rep < MK_REP(7); ++rep) { ws = WSL(); if (MK_ON(7)) { SchedP5 S; S.T.init(32, 8, G, bx); S.MB = (const char*)(wsp(ws, WS_MB)); S.WO = (const char*)(wsp(ws, WS_WO));
          EpiP5 E{kin(0) + (size_t)half * MH * DM, kout() + (size_t)half * MH * DM}; gemm_phase(lds, 2048, 2048, 32, S, E); } }
    }
__global__ void __launch_bounds__(NTHREADS, 2) mega(Params p) {
    extern __shared__ __attribute__((aligned(16))) unsigned char lds_raw[];
    LAS unsigned char* lds = (LAS unsigned char*)lds_raw;
    cg::grid_group grid = cg::this_grid();
    const int G = gridDim.x, bx = blockIdx.x; const int vcu = (G % 8 == 0) ? (bx % 8) * (G / 8) + bx / 8 : bx;
    if (threadIdx.x < 4) ((LAS unsigned*)(lds + LDS_MISC))[threadIdx.x] = 0u;
    __syncthreads();
    const XcdBarrier xb = xcd_barrier_post((unsigned*)(kws() + WS_CTL) + 4096, (volatile LAS unsigned*)(lds + LDS_MISC));
    { unsigned* xr = (unsigned*)(kws() + WS_CTL) + 8192;
      if (threadIdx.x == 0) ((LAS unsigned*)(lds + LDS_MISC))[2] = xb_add(&xr[64 * (xb.x & 15)], 1u); }
    for (int rep = 0; rep < MK_REP(0); ++rep) { if (MK_ON(0)) p0_part<0>(lds, vcu, G); }
    grid.sync();
    for (int rep = 0; rep < MK_REP(9); ++rep) xcd_barrier(xb);
    int lb = bx;
    { unsigned* xr = (unsigned*)(kws() + WS_CTL) + 8192; bool ok = (G % 8 == 0) && xb.x < 8u;
      unsigned cv[8];
#pragma unroll
      for (int j = 0; j < 8; ++j) cv[j] = xb_ld(&xr[64 * j]);
      unsigned bad = 0u;
#pragma unroll
      for (int j = 0; j < 8; ++j) bad |= cv[j] ^ (unsigned)(G / 8);
      ok = ok && (bad == 0u);
      const int rank = (int)((volatile LAS unsigned*)(lds + LDS_MISC))[2];
      if (ok) lb = rank * 8 + (int)xb.x; }
    lb = __builtin_amdgcn_readfirstlane(lb);
    const int vcu2 = (G % 8 == 0) ? (lb % 8) * (G / 8) + lb / 8 : lb;
    run_half<0>(lds, xb, G, lb, vcu2);
    run_half<1>(lds, xb, G, lb, vcu2);
}
}
extern "C" void kernel_launch(void* const* d_in, const int* in_sizes, int n_in, void* d_out, int out_size, void* d_ws, size_t ws_size, hipStream_t stream) {
    static int grid_blocks = 0;
    if (!grid_blocks) {
        int dev = 0, cus = 0, per_cu = 0;
        (void)hipGetDevice(&dev);
        (void)hipDeviceGetAttribute(&cus, hipDeviceAttributeMultiprocessorCount, dev);
        (void)hipFuncSetAttribute((const void*)mk::mega, hipFuncAttributeMaxDynamicSharedMemorySize, mk::LDS_BYTES);
        (void)hipOccupancyMaxActiveBlocksPerMultiprocessor(&per_cu, (const void*)mk::mega, mk::NTHREADS, mk::LDS_BYTES);
        if (per_cu < 1) per_cu = 1;
        grid_blocks = cus * per_cu;
        if (ws_size < mk::WS_CTL + mk::CTL_BYTES) { fprintf(stderr, "kernel_launch: workspace too small: %zu < %zu\n", ws_size, (size_t)mk::WS_END); grid_blocks = -1; }
    }
    if (grid_blocks < 0) return;
    (void)hipMemsetAsync((char*)d_ws + mk::WS_CTL, 0, mk::CTL_BYTES, stream);
    mk::Params p{};
    for (int i = 0; i < 18; ++i) p.in[i] = (const float*)d_in[i];
    p.out = (float*)d_out; p.ws = (unsigned char*)d_ws;
    void* args[] = {&p};
    hipError_t e = hipLaunchCooperativeKernel((const void*)mk::mega, dim3(grid_blocks), dim3(mk::NTHREADS), args, mk::LDS_BYTES, stream);
    if (e != hipSuccess) fprintf(stderr, "cooperative launch failed: %s (grid %d)\n", hipGetErrorString(e), grid_blocks);
}
```

```cpp
#include <hip/hip_runtime.h>
#include <hip/hip_cooperative_groups.h>
#include <math.h>
#include <stdint.h>
#include <cstdio>
namespace mk {
namespace cg = cooperative_groups;
#define LAS __attribute__((address_space(3)))
typedef unsigned short bf16;
typedef short bf16x8 __attribute__((ext_vector_type(8)));
typedef short s16x4 __attribute__((ext_vector_type(4)));
typedef float f32x4 __attribute__((ext_vector_type(4)));
typedef float f32x2 __attribute__((ext_vector_type(2)));
typedef float f32x16 __attribute__((ext_vector_type(16)));
typedef unsigned u32x4 __attribute__((ext_vector_type(4)));
typedef unsigned u32x2 __attribute__((ext_vector_type(2)));
typedef __bf16 bf16x2_t __attribute__((ext_vector_type(2)));
typedef __attribute__((address_space(1))) float GF;

constexpr int DM = 2048, NBATCH = 8, SEQ = 2048, NMETA = 16;
constexpr int HB = 4, MH = HB * SEQ, MHK = MH + 256;
constexpr int NIN = 15872;
constexpr int INW = 15680;
constexpr float EPS = 1e-6f, LOG2E = 1.4426950408889634f;
constexpr float QS_MLA = 0.07216878364870322f * LOG2E;
constexpr float QS_DIFF = 0.08838834764831845f * LOG2E;
constexpr int NWAVES = 8, NTHREADS = 512;
constexpr int T_CQ = 0, T_CKV = 3, T_KR = 5, T_ZA = 6, T_QD = 14, T_KD = 22, T_VD = 30, T_ZB = 38, T_GA = 46, T_GB = 54, T_END = 62;

constexpr size_t al(size_t x) { return (x + 4095) / 4096 * 4096; }
constexpr size_t WS_WIN = 0;
constexpr size_t WS_WUQ = WS_WIN + al((size_t)NIN * 2048 * 2);
constexpr size_t WS_WUKV = WS_WUQ + al((size_t)4096 * 768 * 2);
constexpr size_t WS_WA = WS_WUKV + al((size_t)4096 * 512 * 2);
constexpr size_t WS_WB = WS_WA + al((size_t)2048 * 2048 * 2);
constexpr size_t WS_WO = WS_WB + al((size_t)2048 * 2048 * 2);
constexpr size_t WS_UMETA = WS_WO + al((size_t)2048 * 2048 * 2);
constexpr size_t WS_TAB = WS_UMETA + al((size_t)256 * 2048 * 2);
constexpr size_t TAB_COS = 0, TAB_SIN = (size_t)2064 * 32 * 4, TAB_BIAS = 2 * TAB_SIN, TAB_LAM = TAB_BIAS + 8 * 260 * 4;
constexpr size_t WS_CQ = WS_TAB + al(TAB_LAM + 64);
constexpr size_t WS_CKV = WS_CQ + al((size_t)MHK * 768 * 2);
constexpr size_t WS_KR = WS_CKV + al((size_t)MHK * 512 * 2);
constexpr size_t WS_SSP = WS_KR + al((size_t)MHK * 64 * 2);
constexpr size_t SZ_ACT = al((size_t)MHK * 2048 * 2);
constexpr size_t WS_ZA = WS_SSP + al((size_t)MHK * 16 * 4);
constexpr size_t WS_QD = WS_ZA + SZ_ACT, WS_KD = WS_QD + SZ_ACT, WS_VD = WS_KD + SZ_ACT, WS_ZB = WS_VD + SZ_ACT, WS_SA = WS_ZB + SZ_ACT, WS_SB = WS_SA + SZ_ACT;
constexpr size_t WS_QM = WS_SB + SZ_ACT;
constexpr size_t WS_KM = WS_QM + al((size_t)MHK * 3072 * 2);
constexpr size_t WS_VM = WS_KM + al((size_t)MHK * 3072 * 2);
constexpr size_t WS_END = WS_VM + SZ_ACT;
constexpr size_t WS_MB = WS_VM;
constexpr size_t O1S_BYTES = (size_t)256 * 8 * 32 * 256 * 4;
static_assert(WS_WUKV - WS_WIN >= O1S_BYTES, "O1 stash of half 1 overlays WIN_T|WUQ_T");
constexpr size_t WS_CTL = WS_END, CTL_BYTES = 65536;
static_assert(WS_CTL + CTL_BYTES <= (size_t)512 * 1024 * 1024, "workspace");

constexpr int LDS_RING = 0, RING_BYTES = 147456;
constexpr int LDS_X = RING_BYTES;
constexpr int LDS_X2 = LDS_X + 8192;
constexpr int LDS_WSC = LDS_X2 + 1024;
constexpr int LDS_WSS = LDS_WSC + 2048;
constexpr int LDS_BT = LDS_WSS + 1024;
constexpr int LDS_MISC = LDS_BT + 1056;
constexpr int LDS_BYTES = 163840;

struct Params {
    const float* in[18];
    float* out; unsigned char* ws;
    int dbg, pad;
};

#define CAS __attribute__((address_space(4)))
typedef const float* cfp_t; typedef float* fp_t; typedef unsigned char* ucp_t;
__device__ __forceinline__ const float* kin(int k) { const volatile CAS cfp_t* kp = (const volatile CAS cfp_t*)__builtin_amdgcn_kernarg_segment_ptr(); return kp[k]; }
__device__ __forceinline__ float* kout() { const volatile CAS fp_t* kp = (const volatile CAS fp_t*)__builtin_amdgcn_kernarg_segment_ptr(); return kp[18]; }
__device__ __forceinline__ unsigned char* kws() { const volatile CAS ucp_t* kp = (const volatile CAS ucp_t*)__builtin_amdgcn_kernarg_segment_ptr(); return kp[19]; }
__device__ __forceinline__ unsigned char* wsp(unsigned char* ws, size_t off) { unsigned k = (unsigned)(off >> 12); asm volatile("" : "+s"(k)); return ws + ((size_t)k << 12); }
__device__ __forceinline__ int kdbg() { const volatile CAS int* kp = (const volatile CAS int*)__builtin_amdgcn_kernarg_segment_ptr(); return kp[40]; }
__device__ __forceinline__ unsigned cvtpk(float lo, float hi) { f32x2 v = {lo, hi}; bf16x2_t b = __builtin_convertvector(v, bf16x2_t); return __builtin_bit_cast(unsigned, b); }
__device__ __forceinline__ float bflo(unsigned u) { return __builtin_bit_cast(float, u << 16); }
__device__ __forceinline__ float bfhi(unsigned u) { return __builtin_bit_cast(float, u & 0xffff0000u); }
__device__ __forceinline__ float silu_f(float v) { return v * __builtin_amdgcn_rcpf(1.f + __expf(-v)); }
__device__ __forceinline__ float sigm_f(float v) { return __builtin_amdgcn_rcpf(1.f + __expf(-v)); }
__device__ __forceinline__ float wave_sum(float v) {
#pragma unroll
    for (int o = 1; o < 64; o <<= 1) v += __shfl_xor(v, o);
    return v;
}
__device__ __forceinline__ int crow(int r, int hi) { return (r & 3) + 8 * (r >> 2) + 4 * hi; }
__device__ __forceinline__ int opaque(int x) { asm volatile("" : "+v"(x)); return x; }
#define LDS_WAIT() asm volatile("s_waitcnt lgkmcnt(0)" ::: "memory")
#define SBAR() __builtin_amdgcn_sched_barrier(0)


#define XB_TMO      128
#define XB_XCNT(j)  (256  + 64 * (j))
#define XB_XSUB(j)  (1280 + 64 * (j))
#define XB_XGEN(j)  (2304 + 64 * (j))
#define XB_TOP      3328
#define XB_TOPGEN   3392
#define XB_SPIN_CAP (1u << 22)
__device__ __forceinline__ unsigned xb_ld(unsigned* p)              { return __hip_atomic_load(p, __ATOMIC_RELAXED, __HIP_MEMORY_SCOPE_AGENT); }
__device__ __forceinline__ unsigned xb_add(unsigned* p, unsigned v) { return __hip_atomic_fetch_add(p, v, __ATOMIC_RELAXED, __HIP_MEMORY_SCOPE_AGENT); }
__device__ __forceinline__ unsigned xb_xcc_id() { return (unsigned)__builtin_amdgcn_s_getreg((3 << 11) | 20) & 0xFu; }
#define XB_SPIN(cond, bar) do { unsigned _sp = 0; while (cond) { __builtin_amdgcn_s_sleep(1); \
    if ((++_sp & 255u) == 0u) { if (xb_ld(&(bar)[XB_TMO])) break; if (_sp > XB_SPIN_CAP) { atomicAdd(&(bar)[XB_TMO], 1u); break; } } } } while (0)
struct XcdBarrier { unsigned* bar; unsigned x; volatile LAS unsigned* st; };
__device__ __forceinline__ XcdBarrier xcd_barrier_post(unsigned* bar, volatile LAS unsigned* st) {
    XcdBarrier b; b.bar = bar; b.x = xb_xcc_id(); b.st = st;
    if (threadIdx.x == 0) (void)xb_add(&bar[XB_XCNT(b.x)], 1u);
    return b;
}
__device__ __forceinline__ void xcd_barrier_complete(unsigned* bar, unsigned x, unsigned& nloc, unsigned& nx) {
    const unsigned G = gridDim.x * gridDim.y * gridDim.z;
    unsigned sum, cnt, mine, sp = 0u;
    for (;;) {
        sum = 0u; cnt = 0u; mine = 0u;
#pragma unroll
        for (unsigned j = 0; j < 16; ++j) { const unsigned c = xb_ld(&bar[XB_XCNT(j)]); sum += c; cnt += (c > 0u) ? 1u : 0u; mine = (j == x) ? c : mine; }
        if (sum == G) break;
        __builtin_amdgcn_s_sleep(1);
        if ((++sp & 255u) == 0u) { if (xb_ld(&bar[XB_TMO])) break; if (sp > XB_SPIN_CAP) { atomicAdd(&bar[XB_TMO], 1u); break; } }
    }
    nloc = mine > 0u ? mine : 1u; nx = cnt > 0u ? cnt : 1u;
}
__device__ __forceinline__ void xcd_barrier(const XcdBarrier& b) {
    asm volatile("s_waitcnt vmcnt(0)" ::: "memory");
    __syncthreads();
    if (threadIdx.x == 0) {
        unsigned* bar = b.bar;
        __builtin_amdgcn_s_waitcnt(0);
        unsigned nloc = b.st[0], nx = b.st[1];
        if (nloc == 0u) { xcd_barrier_complete(bar, b.x, nloc, nx); b.st[0] = nloc; b.st[1] = nx; }
        const unsigned old = xb_add(&bar[XB_XSUB(b.x)], 1u);
        const unsigned gen = old / nloc;
        if (old + 1u == (gen + 1u) * nloc) {
            __builtin_amdgcn_fence(__ATOMIC_RELEASE, "agent");
            asm volatile("s_waitcnt vmcnt(0)" ::: "memory");
            (void)xb_add(&bar[XB_TOP], 1u);
        }
        XB_SPIN(xb_ld(&bar[XB_TOP]) < (gen + 1u) * nx, bar);
        __builtin_amdgcn_fence(__ATOMIC_ACQUIRE, "agent");
        asm volatile("s_waitcnt vmcnt(0)" ::: "memory");
    }
    __syncthreads();
}

constexpr int BM = 256, BK = 64, HALF = 128, HTB = HALF * BK * 2, NXCD = 8, WGM = 4;
__device__ __forceinline__ int lds_byte(int r, int c) { const int st = (r >> 4) * 2 + (c >> 5), rr = r & 15, cc = c & 31, ob = rr * 64 + cc * 2; return st * 1024 + (ob ^ (((ob >> 9) & 1) << 5)); }
__device__ __forceinline__ void stage_rc(int b, int& R, int& C) { const int st = b / 1024, sb = b % 1024, swz = sb ^ (((sb >> 9) & 1) << 5); R = (st >> 1) * 16 + swz / 64; C = (st & 1) * 32 + (swz % 64) / 2; }
__device__ __forceinline__ int perm32(int rho) { const int n = rho >> 4, i = rho & 15; return 8 * (i >> 2) + 4 * n + (i & 3); }

struct Unit { const char* A; const char* B; int pm, pn, kind; };
struct TileOrder {
    int nM, nN, nwg, G, c;
    __device__ void init(int nM_, int nN_, int G_, int c_) { nM = nM_; nN = nN_; nwg = nM * nN; G = G_; c = c_; }
    __device__ bool tile(int i, int& pm, int& pn) const {
        const long L = (long)i * G + c; if (L >= nwg) return false;
        int wgid = (int)L; { const int q = nwg / NXCD, r = nwg % NXCD, xcd = wgid % NXCD, off = wgid / NXCD; wgid = (xcd < r ? xcd * (q + 1) : r * (q + 1) + (xcd - r) * q) + off; }
        const int nig = WGM * nN, gid = wgid / nig, fm = gid * WGM, gsz = (nM - fm) < WGM ? (nM - fm) : WGM;
        pm = fm + ((wgid % nig) % gsz); pn = (wgid % nig) / gsz; return true;
    }
};

typedef f32x4 Acc[2][2][4][2];

template <class Epi, class Sched>
__device__ __forceinline__ void gemm_phase(LAS unsigned char* lds, const int lda, const int ldb, const int nt, const Sched& S, const Epi& E) {
    const int tid = opaque(threadIdx.x), wid = __builtin_amdgcn_readfirstlane(tid >> 6), lane = tid & 63, wr = wid >> 2, wc = wid & 3, fr = lane & 15, fq = lane >> 4;
    unsigned voffA[2], voffB[2];
#pragma unroll
    for (int i = 0; i < 2; ++i) { int R, C; stage_rc(tid * 16 + i * 8192, R, C); const int Rb = (R & ~31) + perm32(R & 31);
        voffA[i] = (unsigned)(R * lda + C) * 2u; voffB[i] = (unsigned)(Rb * ldb + C) * 2u; }
    const size_t kstep = (size_t)(BK * 2);
    const size_t hstepA = (size_t)HALF * lda * 2, hstepB = (size_t)HALF * ldb * 2;
    const unsigned ldsw = (unsigned)wid * 1024u;
    const int aoff = lds_byte(wr * 64 + fr, fq * 8), boff = lds_byte(wc * 32 + fr, fq * 8);
#define PG8_SA(b, h) (((b) * 2 + (h)) * HTB)
#define PG8_SB(b, h) ((4 + (b) * 2 + (h)) * HTB)
#define PG8_STAGE(bufoff, gbase, voff) do { _Pragma("unroll") for (int _i = 0; _i < 2; ++_i) \
        __builtin_amdgcn_global_load_lds((const unsigned*)((const char*)(gbase) + (voff)[_i]), (LAS unsigned*)(lds + (bufoff) + ldsw + _i * 8192), 16, 0, 0); } while (0)
#define PG8_LDA(dst, b, h) do { _Pragma("unroll") for (int m = 0; m < 4; ++m) _Pragma("unroll") for (int k = 0; k < 2; ++k) dst[m][k] = *(const LAS bf16x8*)(lds + PG8_SA(b, h) + aoff + m * 2048 + k * 1024); } while (0)
#define PG8_LDB(dst, b, h) do { _Pragma("unroll") for (int n = 0; n < 2; ++n) _Pragma("unroll") for (int k = 0; k < 2; ++k) dst[n][k] = *(const LAS bf16x8*)(lds + PG8_SB(b, h) + boff + n * 2048 + k * 1024); } while (0)
#define PG8_MMA(ai, bj, At, Bt) do { __builtin_amdgcn_s_setprio(1); _Pragma("unroll") for (int m = 0; m < 4; ++m) _Pragma("unroll") for (int n = 0; n < 2; ++n) _Pragma("unroll") for (int k = 0; k < 2; ++k) \
        acc[ai][bj][m][n] = __builtin_amdgcn_mfma_f32_16x16x32_bf16(Bt[n][k], At[m][k], acc[ai][bj][m][n], 0, 0, 0); __builtin_amdgcn_s_setprio(0); } while (0)
#define PG8_WAIT_V(n) asm volatile("s_waitcnt vmcnt(" #n ")" ::: "memory")
#define PG8_WAIT_L(n) asm volatile("s_waitcnt lgkmcnt(" #n ")" ::: "memory")
#define PG8_WAIT_VR(r) asm volatile("s_cmp_eq_u32 %0, 0\n\ts_cbranch_scc1 .Lpg8w%=\n\ts_waitcnt vmcnt(24)\n\ts_branch .Lpg8x%=\n.Lpg8w%=:\n\ts_waitcnt vmcnt(8)\n.Lpg8x%=:" :: "s"(r) : "memory", "scc")
#define PG8_BAR __builtin_amdgcn_s_barrier()
#define PG8_SCHED __builtin_amdgcn_sched_barrier(0)
    Unit cur, nxt; int ui = 0, pend = 0;
    if (!S.next(0, cur)) return;
    Acc acc;
#pragma unroll
    for (int a = 0; a < 2; ++a)
#pragma unroll
        for (int b = 0; b < 2; ++b)
#pragma unroll
            for (int m = 0; m < 4; ++m)
#pragma unroll
                for (int n = 0; n < 2; ++n) acc[a][b][m][n] = (f32x4){0.f, 0.f, 0.f, 0.f};
    bf16x8 At[4][2], B0[2][2], B1[2][2];
    const char* cA = cur.A; const char* cB = cur.B;
    PG8_STAGE(PG8_SB(0, 0), cB, voffB); PG8_STAGE(PG8_SB(0, 1), cB + hstepB, voffB); PG8_STAGE(PG8_SA(0, 0), cA, voffA); PG8_STAGE(PG8_SA(0, 1), cA + hstepA, voffA);
    if (wr == 1) PG8_BAR;
    PG8_WAIT_V(2); PG8_BAR;
    PG8_STAGE(PG8_SB(1, 0), cB + kstep, voffB); PG8_STAGE(PG8_SA(1, 0), cA + kstep, voffA); PG8_STAGE(PG8_SB(1, 1), cB + hstepB + kstep, voffB);
    PG8_WAIT_V(6); PG8_BAR;
    for (;;) {
        const bool has_next = S.next(ui + 1, nxt);
        const char* nA = has_next ? nxt.A : cA; const char* nB = has_next ? nxt.B : cB;
#define PG8_TRIP(WV) do { \
            const bool last = (t == nt - 2); \
            const char* a1 = cA + (size_t)(t + 1) * kstep; \
            const char* a2 = last ? nA : cA + (size_t)(t + 2) * kstep; const char* b2 = last ? nB : cB + (size_t)(t + 2) * kstep; \
            const char* a3 = a2 + kstep; const char* b3 = b2 + kstep; \
            PG8_LDB(B0, 0, 0); PG8_LDB(B1, 0, 1); PG8_SCHED; PG8_LDA(At, 0, 0); PG8_STAGE(PG8_SA(1, 1), a1 + hstepA, voffA); \
            if constexpr (Epi::RELAX) PG8_WAIT_VR(WV); else PG8_WAIT_V(8); PG8_WAIT_L(0); PG8_BAR; PG8_MMA(0, 0, At, B0); PG8_MMA(0, 1, At, B1); PG8_BAR; PG8_SCHED; \
            PG8_LDA(At, 0, 1); PG8_STAGE(PG8_SB(0, 0), b2, voffB); PG8_STAGE(PG8_SB(0, 1), b2 + hstepB, voffB); PG8_STAGE(PG8_SA(0, 0), a2, voffA); \
            if constexpr (Epi::RELAX) PG8_WAIT_VR(WV); else PG8_WAIT_V(8); PG8_WAIT_L(0); PG8_BAR; PG8_MMA(1, 0, At, B0); PG8_MMA(1, 1, At, B1); PG8_BAR; PG8_SCHED; \
            PG8_LDB(B0, 1, 0); PG8_LDB(B1, 1, 1); PG8_SCHED; PG8_LDA(At, 1, 0); PG8_STAGE(PG8_SA(0, 1), a2 + hstepA, voffA); \
            if constexpr (Epi::RELAX) PG8_WAIT_VR(WV); else PG8_WAIT_V(8); PG8_WAIT_L(0); PG8_BAR; PG8_MMA(0, 0, At, B0); PG8_MMA(0, 1, At, B1); PG8_BAR; PG8_SCHED; \
            PG8_LDA(At, 1, 1); PG8_STAGE(PG8_SB(1, 0), b3, voffB); PG8_STAGE(PG8_SB(1, 1), b3 + hstepB, voffB); PG8_STAGE(PG8_SA(1, 0), a3, voffA); \
            if constexpr (Epi::RELAX) PG8_WAIT_VR(WV); else PG8_WAIT_V(8); PG8_WAIT_L(0); PG8_BAR; PG8_MMA(1, 0, At, B0); PG8_MMA(1, 1, At, B1); PG8_BAR; PG8_SCHED; } while (0)
        for (int t = 0; t < nt; t += 2) { const int rel = (Epi::RELAX && t == 0) ? ui : 0; PG8_TRIP(rel); }
#undef PG8_TRIP
        if (wr == 0) PG8_BAR;
        int nst = 0;
        const bool keep = E(acc, cur, wr, wc, fr, fq, lds, nst);
        (void)nst; (void)pend;
        if (!has_next) break;
        if (!keep) {
#pragma unroll
            for (int a = 0; a < 2; ++a)
#pragma unroll
                for (int b = 0; b < 2; ++b)
#pragma unroll
                    for (int m = 0; m < 4; ++m)
#pragma unroll
                        for (int n = 0; n < 2; ++n) acc[a][b][m][n] = (f32x4){0.f, 0.f, 0.f, 0.f};
        }
        cur = nxt; cA = nA; cB = nB; ++ui;
        if (wr == 1) PG8_BAR;
    }
    PG8_WAIT_V(0);
    PG8_BAR;
#undef PG8_SA
#undef PG8_SB
#undef PG8_STAGE
#undef PG8_LDA
#undef PG8_LDB
#undef PG8_MMA
#undef PG8_WAIT_V
#undef PG8_WAIT_L
#undef PG8_WAIT_VR
#undef PG8_BAR
#undef PG8_SCHED
}

__device__ __forceinline__ void tile_half_ss(const Acc& acc, LAS unsigned char* lds, int wr, int wc, int fr, int fq, float (&ss)[2][4][2]) {
    LAS float* X = (LAS float*)(lds + LDS_X);
#pragma unroll
    for (int ai = 0; ai < 2; ++ai)
#pragma unroll
        for (int m = 0; m < 4; ++m)
#pragma unroll
            for (int bj = 0; bj < 2; ++bj) {
                const f32x4 a = acc[ai][bj][m][0], b = acc[ai][bj][m][1];
                float s = (a[0] * a[0] + a[1] * a[1]) + (a[2] * a[2] + a[3] * a[3]) + (b[0] * b[0] + b[1] * b[1]) + (b[2] * b[2] + b[3] * b[3]);
                s += __shfl_xor(s, 16); s += __shfl_xor(s, 32);
                if (fq == 0) X[((ai * 128 + wr * 64 + m * 16 + fr) * 2 + bj) * 4 + wc] = s;
            }
    LDS_WAIT(); __builtin_amdgcn_s_barrier(); asm volatile("" ::: "memory");
#pragma unroll
    for (int ai = 0; ai < 2; ++ai)
#pragma unroll
        for (int m = 0; m < 4; ++m)
#pragma unroll
            for (int bj = 0; bj < 2; ++bj) {
                const f32x4 v = *(const LAS f32x4*)(X + ((ai * 128 + wr * 64 + m * 16 + fr) * 2 + bj) * 4);
                ss[ai][m][bj] = (v[0] + v[1]) + (v[2] + v[3]);
            }
}
__device__ __forceinline__ u32x4 pack8(const f32x4 a, const f32x4 b) { u32x4 w; w.x = cvtpk(a[0], a[1]); w.y = cvtpk(a[2], a[3]); w.z = cvtpk(b[0], b[1]); w.w = cvtpk(b[2], b[3]); return w; }

struct EpiP1 {
    static constexpr bool RELAX = true;
    unsigned char* ws; const float* gqd; const float* gkd; bool skip;
    __device__ __forceinline__ bool operator()(Acc& acc, const Unit& u, int wr, int wc, int fr, int fq, LAS unsigned char* lds, int& nst) const {
        if (skip) return false;
        { const int l_ = opaque(threadIdx.x) & 63; fr = l_ & 15; fq = l_ >> 4; }
        const int pn = u.pn; const int row0 = u.pm * 256 + wr * 64 + fr;
        const int colw = wc * 32 + 8 * fq;
        if (pn < T_KR) {
            float ss[2][4][2]; tile_half_ss(acc, lds, wr, wc, fr, fq, ss);
            const bool iscq = pn < T_CKV;
            bf16* dst = iscq ? (bf16*)(wsp(ws, WS_CQ)) : (bf16*)(wsp(ws, WS_CKV)); const int ld = iscq ? 768 : 512; const int c0 = iscq ? pn * 256 : (pn - T_CKV) * 256;
            const int chunk0 = iscq ? pn * 2 : 6 + (pn - T_CKV) * 2;
            float* ssp = (float*)(wsp(ws, WS_SSP));
#pragma unroll
            for (int ai = 0; ai < 2; ++ai)
#pragma unroll
                for (int m = 0; m < 4; ++m) { const int row = row0 + ai * 128 + m * 16;
#pragma unroll
                    for (int bj = 0; bj < 2; ++bj) {
                        *(u32x4*)(dst + (size_t)row * ld + c0 + bj * 128 + colw) = pack8(acc[ai][bj][m][0], acc[ai][bj][m][1]);
                        if (wc == 0 && fq == 0) ssp[(size_t)row * 16 + chunk0 + bj] = ss[ai][m][bj];
                    } }
            nst = 16; return false;
        }
        if (pn == T_KR) {
            { bf16* dst = (bf16*)(wsp(ws, WS_KR)); bf16* dum = (bf16*)(wsp(ws, WS_CTL) + 32768) + (size_t)(threadIdx.x) * 8;
#pragma unroll
                for (int ai = 0; ai < 2; ++ai)
#pragma unroll
                    for (int m = 0; m < 4; ++m) { const int row = row0 + ai * 128 + m * 16; const u32x4 w = pack8(acc[ai][0][m][0], acc[ai][0][m][1]);
                        *(u32x4*)(wc < 2 ? dst + (size_t)row * 64 + colw : dum) = w; *(u32x4*)dum = w; } }
            return false;
        }
        if (pn >= T_QD && pn < T_VD) {
            float ss[2][4][2]; tile_half_ss(acc, lds, wr, wc, fr, fq, ss);
            const bool isq = pn < T_KD; const float* g = isq ? gqd : gkd; const float post = isq ? QS_DIFF : 1.f;
            bf16* dst = isq ? (bf16*)(wsp(ws, WS_QD)) : (bf16*)(wsp(ws, WS_KD)); const int c0 = (isq ? pn - T_QD : pn - T_KD) * 256;
            const f32x4 g0 = *(const f32x4*)(g + colw), g1 = *(const f32x4*)(g + colw + 4);
#pragma unroll
            for (int ai = 0; ai < 2; ++ai)
#pragma unroll
                for (int m = 0; m < 4; ++m) { const int row = row0 + ai * 128 + m * 16;
#pragma unroll
                    for (int bj = 0; bj < 2; ++bj) { const float rs = __builtin_amdgcn_rsqf(ss[ai][m][bj] * (1.f / 128.f) + EPS) * post;
                        *(u32x4*)(dst + (size_t)row * 2048 + c0 + bj * 128 + colw) = pack8(acc[ai][bj][m][0] * g0 * rs, acc[ai][bj][m][1] * g1 * rs); } }
            nst = 16; return false;
        }
        int mode; bf16* dst; int c0;
        if (pn < T_QD) { mode = 1; dst = (bf16*)(wsp(ws, WS_ZA)); c0 = (pn - T_ZA) * 256; }
        else if (pn < T_ZB) { mode = 0; dst = (bf16*)(wsp(ws, WS_VD)); c0 = (pn - T_VD) * 256; }
        else if (pn < T_GA) { mode = 1; dst = (bf16*)(wsp(ws, WS_ZB)); c0 = (pn - T_ZB) * 256; }
        else if (pn < T_GB) { mode = 2; dst = (bf16*)(wsp(ws, WS_SA)); c0 = (pn - T_GA) * 256; }
        else { mode = 2; dst = (bf16*)(wsp(ws, WS_SB)); c0 = (pn - T_GB) * 256; }
#pragma unroll
        for (int ai = 0; ai < 2; ++ai)
#pragma unroll
            for (int m = 0; m < 4; ++m) { const int row = row0 + ai * 128 + m * 16;
#pragma unroll
                for (int bj = 0; bj < 2; ++bj) { f32x4 a = acc[ai][bj][m][0], b = acc[ai][bj][m][1];
                    if (mode == 1) {
#pragma unroll
                        for (int e = 0; e < 4; ++e) { a[e] = silu_f(a[e]); b[e] = silu_f(b[e]); } }
                    else if (mode == 2) {
#pragma unroll
                        for (int e = 0; e < 4; ++e) { a[e] = sigm_f(a[e]); b[e] = sigm_f(b[e]); } }
                    *(u32x4*)(dst + (size_t)row * 2048 + c0 + bj * 128 + colw) = pack8(a, b); } }
        nst = 16; return false;
    }
};
struct SchedP1 {
    TileOrder T; const char* U; const char* Umeta; const char* W;
    __device__ __forceinline__ bool next(int i, Unit& u) const {
        int pm, pn; if (!T.tile(i, pm, pn)) return false;
        u.pm = pm; u.pn = pn; u.kind = 0;
        u.A = (pm < 32) ? U + (size_t)pm * 256 * 2048 * 2 : Umeta; u.B = W + (size_t)pn * 256 * 2048 * 2; return true;
    }
};

__device__ __forceinline__ float ssp_rs(const float* ssp, int row, int c0, int n, float invw) {
    float s = 0.f; for (int c = 0; c < n; ++c) s += ssp[(size_t)row * 16 + c0 + c]; return __builtin_amdgcn_rsqf(s * invw + EPS);
}
struct EpiP2Q {
    static constexpr bool RELAX = false;
    unsigned char* ws; const float* gq; bool skip;
    __device__ __forceinline__ bool operator()(Acc& acc, const Unit& u, int wr, int wc, int fr, int fq, LAS unsigned char* lds, int& nst) const {
        if (skip) return false;
        { const int l_ = opaque(threadIdx.x) & 63; fr = l_ & 15; fq = l_ >> 4; }
        const int h = u.pn; const int row0 = u.pm * 256 + wr * 64 + fr; const int colw = wc * 32 + 8 * fq;
        const float* ssp = (const float*)(wsp(ws, WS_SSP));
        float myrs[2];
        { const float* p0 = ssp + (size_t)(row0 + fq * 16) * 16; const float* p1 = p0 + (size_t)128 * 16;
          const f32x4 a0 = *(const f32x4*)p0, b0 = *(const f32x4*)p1; const f32x2 a1 = *(const f32x2*)(p0 + 4), b1 = *(const f32x2*)(p1 + 4);
          myrs[0] = __builtin_amdgcn_rsqf(((a0[0] + a0[1]) + (a0[2] + a0[3]) + (a1[0] + a1[1])) * (1.f / 768.f) + EPS);
          myrs[1] = __builtin_amdgcn_rsqf(((b0[0] + b0[1]) + (b0[2] + b0[3]) + (b1[0] + b1[1])) * (1.f / 768.f) + EPS); }
        float ss[2][4][2]; tile_half_ss(acc, lds, wr, wc, fr, fq, ss);
        float sc[2][4];
#pragma unroll
        for (int ai = 0; ai < 2; ++ai)
#pragma unroll
            for (int m = 0; m < 4; ++m) { const float rc = __shfl(myrs[ai], fr + 16 * m);
                sc[ai][m] = rc * __builtin_amdgcn_rsqf(rc * rc * (ss[ai][m][0] + ss[ai][m][1]) * (1.f / 192.f) + EPS) * QS_MLA; }
        bf16* dst = (bf16*)(wsp(ws, WS_QM));
        { const f32x4 g0 = *(const f32x4*)(gq + colw), g1 = *(const f32x4*)(gq + colw + 4);
#pragma unroll
          for (int ai = 0; ai < 2; ++ai)
#pragma unroll
            for (int m = 0; m < 4; ++m) { const int row = row0 + ai * 128 + m * 16;
                *(u32x4*)(dst + (size_t)row * 3072 + h * 192 + colw) = pack8(acc[ai][0][m][0] * g0 * sc[ai][m], acc[ai][0][m][1] * g1 * sc[ai][m]); } }
        if (wc < 2) {
            const int ib = opaque(16 * wc + 4 * fq);
            const f32x4 gr1 = *(const f32x4*)(gq + 128 + ib), gr2 = *(const f32x4*)(gq + 160 + ib);
            const float* ctab = (const float*)(wsp(ws, WS_TAB) + TAB_COS); const float* stab = (const float*)(wsp(ws, WS_TAB) + TAB_SIN);
#pragma unroll
            for (int ai = 0; ai < 2; ++ai) {
                f32x4 c[4], sn[4];
#pragma unroll
                for (int m = 0; m < 4; ++m) { const int pos = NMETA + ((row0 + ai * 128 + m * 16) & (SEQ - 1)); c[m] = *(const f32x4*)(ctab + pos * 32 + ib); sn[m] = *(const f32x4*)(stab + pos * 32 + ib); }
#pragma unroll
                for (int m = 0; m < 4; ++m) { const int row = row0 + ai * 128 + m * 16;
                    const f32x4 x1 = acc[ai][1][m][0] * gr1 * sc[ai][m], x2 = acc[ai][1][m][1] * gr2 * sc[ai][m];
                    *(u32x4*)(dst + (size_t)row * 3072 + h * 192 + 128 + colw) = pack8(x1 * c[m] - x2 * sn[m], x2 * c[m] + x1 * sn[m]); }
                asm volatile("" ::: "memory"); }
        }
        nst = 8; return false;
    }
};
struct SchedP2Q {
    TileOrder T; const char* CQ; const char* W;
    __device__ __forceinline__ bool next(int i, Unit& u) const {
        int pm, pn; if (!T.tile(i, pm, pn)) return false;
        u.pm = pm; u.pn = pn; u.kind = 0; u.A = CQ + (size_t)pm * 256 * 768 * 2; u.B = W + (size_t)pn * 256 * 768 * 2; return true;
    }
};
struct EpiP2KV {
    static constexpr bool RELAX = false;
    unsigned char* ws; const float* gk; bool skip;
    __device__ __forceinline__ bool operator()(Acc& acc, const Unit& u, int wr, int wc, int fr, int fq, LAS unsigned char* lds, int& nst) const {
        if (skip) return false;
        { const int l_ = opaque(threadIdx.x) & 63; fr = l_ & 15; fq = l_ >> 4; }
        const int h = u.pn; const int row0 = u.pm * 256 + wr * 64 + fr; const int colw = wc * 32 + 8 * fq;
        const float* ssp = (const float*)(wsp(ws, WS_SSP));
        const int tid = opaque(threadIdx.x), rr = tid >> 1, hf = tid & 1; const int rrow = u.pm * 256 + rr;
        const bf16* kr = (const bf16*)(wsp(ws, WS_KR)) + (size_t)rrow * 64 + hf * 32;
        float sr = 0.f;
        { u32x4 kv[4];
#pragma unroll
          for (int j = 0; j < 4; ++j) kv[j] = *(const u32x4*)(kr + j * 8);
#pragma unroll
          for (int j = 0; j < 4; ++j)
#pragma unroll
            for (int e = 0; e < 4; ++e) { const float a = bflo(kv[j][e]), b = bfhi(kv[j][e]); sr += a * a + b * b; } }
        sr += __shfl_xor(sr, 1);
        float myrs[2];
        { const float* p0 = ssp + (size_t)(row0 + fq * 16) * 16 + 6; const float* p1 = p0 + (size_t)128 * 16;
          const f32x2 a0 = *(const f32x2*)p0, a1 = *(const f32x2*)(p0 + 2), b0 = *(const f32x2*)p1, b1 = *(const f32x2*)(p1 + 2);
          myrs[0] = __builtin_amdgcn_rsqf(((a0[0] + a0[1]) + (a1[0] + a1[1])) * (1.f / 512.f) + EPS);
          myrs[1] = __builtin_amdgcn_rsqf(((b0[0] + b0[1]) + (b1[0] + b1[1])) * (1.f / 512.f) + EPS); }
        float rcr;
        { const float* p = ssp + (size_t)rrow * 16 + 6; const f32x2 a0 = *(const f32x2*)p, a1 = *(const f32x2*)(p + 2); rcr = __builtin_amdgcn_rsqf(((a0[0] + a0[1]) + (a1[0] + a1[1])) * (1.f / 512.f) + EPS); }
        LAS float* X2 = (LAS float*)(lds + LDS_X2);
        if (hf == 0) X2[rr] = sr;
        float ss[2][4][2]; tile_half_ss(acc, lds, wr, wc, fr, fq, ss);
        const f32x4 g0 = *(const f32x4*)(gk + colw), g1 = *(const f32x4*)(gk + colw + 4);
        bf16* kdst = (bf16*)(wsp(ws, WS_KM)); bf16* vdst = (bf16*)(wsp(ws, WS_VM));
#pragma unroll
        for (int ai = 0; ai < 2; ++ai)
#pragma unroll
            for (int m = 0; m < 4; ++m) { const int trow = ai * 128 + wr * 64 + m * 16 + fr; const int row = u.pm * 256 + trow;
                const float rc = __shfl(myrs[ai], fr + 16 * m);
                const float rk = rc * __builtin_amdgcn_rsqf((rc * rc * ss[ai][m][0] + X2[trow]) * (1.f / 192.f) + EPS);
                *(u32x4*)(kdst + (size_t)row * 3072 + h * 192 + colw) = pack8(acc[ai][0][m][0] * g0 * rk, acc[ai][0][m][1] * g1 * rk);
                *(u32x4*)(vdst + (size_t)row * 2048 + h * 128 + colw) = pack8(acc[ai][1][m][0] * rc, acc[ai][1][m][1] * rc); }
        { const LAS float* X = (const LAS float*)(lds + LDS_X); const f32x4 pv = *(const LAS f32x4*)(X + (rr * 2 + 0) * 4);
          const float rs = __builtin_amdgcn_rsqf((rcr * rcr * ((pv[0] + pv[1]) + (pv[2] + pv[3])) + sr) * (1.f / 192.f) + EPS);
          const int pos = (u.pm < 32) ? NMETA + (rrow & (SEQ - 1)) : (rr < NMETA ? rr : 0);
          const float* ctab = (const float*)(wsp(ws, WS_TAB) + TAB_COS) + pos * 32; const float* stab = (const float*)(wsp(ws, WS_TAB) + TAB_SIN) + pos * 32;
          const bf16* kr2 = kr; asm volatile("" : "+v"(kr2));
#pragma unroll
          for (int j = 0; j < 4; ++j) { const int g = hf * 4 + j; const int i0 = 4 * g; const u32x4 kvj = *(const u32x4*)(kr2 + j * 8);
              const f32x4 c = *(const f32x4*)(ctab + i0), sn = *(const f32x4*)(stab + i0), gg1 = *(const f32x4*)(gk + 128 + i0), gg2 = *(const f32x4*)(gk + 160 + i0);
              f32x4 x1 = {bflo(kvj[0]), bfhi(kvj[0]), bflo(kvj[1]), bfhi(kvj[1])}, x2 = {bflo(kvj[2]), bfhi(kvj[2]), bflo(kvj[3]), bfhi(kvj[3])};
              x1 = x1 * gg1 * rs; x2 = x2 * gg2 * rs;
              *(u32x4*)(kdst + (size_t)rrow * 3072 + h * 192 + 128 + g * 8) = pack8(x1 * c - x2 * sn, x2 * c + x1 * sn); } }
        nst = 16; return false;
    }
};
struct SchedP2KV {
    TileOrder T; const char* CKV; const char* W;
    __device__ __forceinline__ bool next(int i, Unit& u) const {
        int pm, pn; if (!T.tile(i, pm, pn)) return false;
        u.pm = pm; u.pn = pn; u.kind = 0; u.A = CKV + (size_t)pm * 256 * 512 * 2; u.B = W + (size_t)pn * 256 * 512 * 2; return true;
    }
};

struct EpiP4 {
    static constexpr bool RELAX = false;
    unsigned char* ws; int dbg;
    __device__ __forceinline__ bool operator()(Acc& acc, const Unit& u, int wr, int wc, int fr, int fq, LAS unsigned char* lds, int& nst) const {
        { const int l_ = opaque(threadIdx.x) & 63; fr = l_ & 15; fq = l_ >> 4; }
        const int row0 = u.pm * 256 + wr * 64 + fr; const int col0 = u.pn * 256 + wc * 32 + 8 * fq;
        const bf16* sa = (const bf16*)(wsp(ws, WS_SA)); const bf16* sb = (const bf16*)(wsp(ws, WS_SB)); bf16* mb = (bf16*)(wsp(ws, WS_MB));
        if (u.kind == 0 && dbg != 1) {
#pragma unroll
            for (int ai = 0; ai < 2; ++ai) { u32x4 av[4][2], bv[4][2];
#pragma unroll
                for (int m = 0; m < 4; ++m)
#pragma unroll
                    for (int bj = 0; bj < 2; ++bj) { const size_t off = (size_t)(row0 + ai * 128 + m * 16) * 2048 + col0 + bj * 128; av[m][bj] = *(const u32x4*)(sa + off); bv[m][bj] = *(const u32x4*)(sb + off); }
#pragma unroll
                for (int m = 0; m < 4; ++m)
#pragma unroll
                    for (int bj = 0; bj < 2; ++bj) { const u32x4 a = av[m][bj], b = bv[m][bj];
                        const f32x4 a0 = {bflo(a[0]), bfhi(a[0]), bflo(a[1]), bfhi(a[1])}, a1 = {bflo(a[2]), bfhi(a[2]), bflo(a[3]), bfhi(a[3])};
                        const f32x4 b0 = {bflo(b[0]), bfhi(b[0]), bflo(b[1]), bfhi(b[1])}, b1 = {bflo(b[2]), bfhi(b[2]), bflo(b[3]), bfhi(b[3])};
#pragma unroll
                        for (int e = 0; e < 4; ++e) { acc[ai][bj][m][0][e] *= a0[e] * __builtin_amdgcn_rcpf(b0[e]); acc[ai][bj][m][1][e] *= a1[e] * __builtin_amdgcn_rcpf(b1[e]); } } }
            nst = 0; return true;
        }
        if (u.kind == 0) {
#pragma unroll
            for (int ai = 0; ai < 2; ++ai)
#pragma unroll
                for (int m = 0; m < 4; ++m)
#pragma unroll
                    for (int bj = 0; bj < 2; ++bj) { const size_t off = (size_t)(row0 + ai * 128 + m * 16) * 2048 + col0 + bj * 128; const u32x4 a = *(const u32x4*)(sa + off);
                        const f32x4 a0 = {bflo(a[0]), bfhi(a[0]), bflo(a[1]), bfhi(a[1])}, a1 = {bflo(a[2]), bfhi(a[2]), bflo(a[3]), bfhi(a[3])};
                        *(u32x4*)(mb + off) = pack8(acc[ai][bj][m][0] * a0, acc[ai][bj][m][1] * a1); }
            nst = 16; return false;
        }
        { u32x4 bv[2][4][2];
#pragma unroll
          for (int ai = 0; ai < 2; ++ai)
#pragma unroll
            for (int m = 0; m < 4; ++m)
#pragma unroll
                for (int bj = 0; bj < 2; ++bj) bv[ai][m][bj] = *(const u32x4*)(sb + (size_t)(row0 + ai * 128 + m * 16) * 2048 + col0 + bj * 128);
#pragma unroll
          for (int ai = 0; ai < 2; ++ai)
#pragma unroll
            for (int m = 0; m < 4; ++m)
#pragma unroll
                for (int bj = 0; bj < 2; ++bj) { const u32x4 b = bv[ai][m][bj];
                    const f32x4 b0 = {bflo(b[0]), bfhi(b[0]), bflo(b[1]), bfhi(b[1])}, b1 = {bflo(b[2]), bfhi(b[2]), bflo(b[3]), bfhi(b[3])};
                    *(u32x4*)(mb + (size_t)(row0 + ai * 128 + m * 16) * 2048 + col0 + bj * 128) = pack8(acc[ai][bj][m][0] * b0, acc[ai][bj][m][1] * b1); } }
        nst = 16; return false;
    }
};
struct SchedP4 {
    TileOrder T; const char* OA; const char* OB; const char* WA; const char* WB; int dbg;
    __device__ __forceinline__ bool next(int i, Unit& u) const {
        int pm, pn; const int ti = dbg ? i : (i >> 1), kd = dbg ? (dbg - 1) : (i & 1);
        if (!T.tile(ti, pm, pn)) return false;
        u.pm = pm; u.pn = pn; u.kind = kd;
        u.A = (kd ? OB : OA) + (size_t)pm * 256 * 2048 * 2; u.B = (kd ? WB : WA) + (size_t)pn * 256 * 2048 * 2; return true;
    }
};
struct EpiP5 {
    static constexpr bool RELAX = true;
    const float* x; float* out;
    __device__ __forceinline__ bool operator()(Acc& acc, const Unit& u, int wr, int wc, int fr, int fq, LAS unsigned char* lds, int& nst) const {
        { const int l_ = opaque(threadIdx.x) & 63; fr = l_ & 15; fq = l_ >> 4; }
        const int row0 = u.pm * 256 + wr * 64 + fr; const int col0 = u.pn * 256 + wc * 32 + 8 * fq;
        f32x4 xa[4][2][2], xb[4][2][2];
#pragma unroll
        for (int m = 0; m < 4; ++m)
#pragma unroll
            for (int bj = 0; bj < 2; ++bj) { const size_t off = (size_t)(row0 + m * 16) * 2048 + col0 + bj * 128; xa[m][bj][0] = *(const f32x4*)(x + off); xa[m][bj][1] = *(const f32x4*)(x + off + 4); }
#pragma unroll
        for (int m = 0; m < 4; ++m)
#pragma unroll
            for (int bj = 0; bj < 2; ++bj) { xa[m][bj][0] += acc[0][bj][m][0]; xa[m][bj][1] += acc[0][bj][m][1]; }
#pragma unroll
        for (int m = 0; m < 4; ++m)
#pragma unroll
            for (int bj = 0; bj < 2; ++bj) { const size_t off = (size_t)(row0 + 128 + m * 16) * 2048 + col0 + bj * 128; xb[m][bj][0] = *(const f32x4*)(x + off); xb[m][bj][1] = *(const f32x4*)(x + off + 4); }
#pragma unroll
        for (int m = 0; m < 4; ++m)
#pragma unroll
            for (int bj = 0; bj < 2; ++bj) { const size_t off = (size_t)(row0 + m * 16) * 2048 + col0 + bj * 128; *(f32x4*)(out + off) = xa[m][bj][0]; *(f32x4*)(out + off + 4) = xa[m][bj][1]; }
#pragma unroll
        for (int m = 0; m < 4; ++m)
#pragma unroll
            for (int bj = 0; bj < 2; ++bj) { const size_t off = (size_t)(row0 + 128 + m * 16) * 2048 + col0 + bj * 128; *(f32x4*)(out + off) = xb[m][bj][0] + acc[1][bj][m][0]; *(f32x4*)(out + off + 4) = xb[m][bj][1] + acc[1][bj][m][1]; }
        nst = 32; return false;
    }
};
struct SchedP5 {
    TileOrder T; const char* MB; const char* WO;
    __device__ __forceinline__ bool next(int i, Unit& u) const {
        int pm, pn; if (!T.tile(i, pm, pn)) return false;
        u.pm = pm; u.pn = pn; u.kind = 0; u.A = MB + (size_t)pm * 256 * 2048 * 2; u.B = WO + (size_t)pn * 256 * 2048 * 2; return true;
    }
};

constexpr float NEGBIG = -1e30f;
constexpr float THR_L2 = 8.f * LOG2E;
template <int NCB> __device__ __forceinline__ int v_st(int k, int c) { const int kk = (k & ~0xC) | ((k & 4) << 1) | ((k & 8) >> 1); return ((kk >> 3) * NCB + (c >> 5)) * 512 + ((kk & 7) * 32 + (c & 31)) * 2; }
__device__ __forceinline__ int v_rd_base(int lane) { return ((lane & 3) << 3) | (((lane >> 2) & 3) << 6) | (((lane >> 4) & 1) << 5) | (((lane >> 5) & 1) << 8); }
typedef short v4i16_t __attribute__((ext_vector_type(4)));
typedef LAS const char* lds_cptr;
__device__ __forceinline__ s16x4 vtr(lds_cptr p) { return __builtin_bit_cast(s16x4, __builtin_amdgcn_ds_read_tr16_b64_v4i16((LAS v4i16_t*)p)); }
template <int NCB> __device__ __forceinline__ void pv_all(f32x16* o, lds_cptr vp, bf16x8 pa0, bf16x8 pa1, bf16x8 pa2, bf16x8 pa3) {
    constexpr int KS = NCB * 1024, HF = NCB * 512;
#pragma unroll
    for (int d0 = 0; d0 < NCB; ++d0) {
        const s16x4 l0 = vtr(vp + d0 * 512 + 0 * KS), h0 = vtr(vp + d0 * 512 + 0 * KS + HF), l1 = vtr(vp + d0 * 512 + 1 * KS), h1 = vtr(vp + d0 * 512 + 1 * KS + HF);
        const s16x4 l2 = vtr(vp + d0 * 512 + 2 * KS), h2 = vtr(vp + d0 * 512 + 2 * KS + HF), l3 = vtr(vp + d0 * 512 + 3 * KS), h3 = vtr(vp + d0 * 512 + 3 * KS + HF);
#define PK(L, H) (bf16x8){L[0], L[1], L[2], L[3], H[0], H[1], H[2], H[3]}
        o[d0] = __builtin_amdgcn_mfma_f32_32x32x16_bf16(pa0, PK(l0, h0), o[d0], 0, 0, 0);
        o[d0] = __builtin_amdgcn_mfma_f32_32x32x16_bf16(pa1, PK(l1, h1), o[d0], 0, 0, 0);
        o[d0] = __builtin_amdgcn_mfma_f32_32x32x16_bf16(pa2, PK(l2, h2), o[d0], 0, 0, 0);
        o[d0] = __builtin_amdgcn_mfma_f32_32x32x16_bf16(pa3, PK(l3, h3), o[d0], 0, 0, 0);
#undef PK
    }
}

template <int DQK, int DV, bool BIAS, int VAR = 0>
__device__ __forceinline__ void attn_pass(f32x16 (&o)[DV / 32], float& l_out, const bf16* __restrict__ Q, int ldq, const bf16* __restrict__ Kr, const bf16* __restrict__ Km, int ldk,
                                          const bf16* __restrict__ Vr, const bf16* __restrict__ Vm, int ldv, int q0, LAS unsigned char* ldsb) {
    constexpr int NKP = 64 * DQK * 2 / 8192, NVP = 64 * DV * 2 / 8192, KB = 64 * DQK * 2, VB = 64 * DV * 2, ND0 = DV / 32, NQ = DQK / 16, NCB = DV / 32;
    const int tid = opaque(threadIdx.x), lane = tid & 63, r32 = lane & 31, hi = lane >> 5; const int wid = __builtin_amdgcn_readfirstlane(tid >> 6);
    char* lds = (char*)ldsb;
    float* wsc = (float*)(lds + LDS_WSC) + wid * 64; float* al_l = wsc + 32;
    const float* btab = (const float*)(lds + LDS_BT);
    const int qw0 = q0 + wid * 32;
    bf16x8 qr[NQ];
    { const bf16* Qw = Q + (size_t)(wid * 32 + r32) * ldq + hi * 8;
#pragma unroll
      for (int d0 = 0; d0 < NQ; ++d0) qr[d0] = *(const bf16x8*)(Qw + d0 * 16); }
    const lds_cptr vp0 = (lds_cptr)ldsb + 3 * KB + v_rd_base(lane);
#define KXW(row) ((DQK == 128) ? ((row) & 15) : (((row) >> 1) & 7))
    constexpr int NKO = (DQK == 128) ? 8 : 4;
    int koff[NKO];
#pragma unroll
    for (int d0 = 0; d0 < NKO; ++d0) koff[d0] = r32 * (DQK * 2) + (((2 * d0 + hi) ^ KXW(r32)) << 4);
#define KOFF(d0) (koff[(d0) % NKO] + ((d0) / NKO) * (NKO * 32))
    unsigned ksrc[NKP], vsrc[NVP];
#pragma unroll
    for (int j = 0; j < NKP; ++j) { const int off = 8192 * j + 16 * tid, row = off / (DQK * 2), cpos = (off % (DQK * 2)) >> 4; ksrc[j] = (unsigned)(row * ldk + ((cpos ^ KXW(row)) << 3)); }
#pragma unroll
    for (int j = 0; j < NVP; ++j) { const int off = 8192 * j + 16 * tid, st = off >> 9, kk = (st / NCB) * 8 + ((off & 511) >> 6), c = (st % NCB) * 32 + ((off & 63) >> 1);
        const int k = (kk & ~0xC) | ((kk & 4) << 1) | ((kk & 8) >> 1); vsrc[j] = (unsigned)(k * ldv + c); }
    const unsigned ldsw = (unsigned)wid * 1024u;
#define DMA_K(t, KO_) do { const bf16* kp = (t) == 0 ? Km : Kr + (size_t)((VAR == 1 ? ((t) & 1) + 1 : (t)) - 1) * 64 * ldk; \
        _Pragma("unroll") for (int j = 0; j < NKP; ++j) __builtin_amdgcn_global_load_lds((const unsigned*)(kp + ksrc[j]), (LAS unsigned*)(ldsb + (KO_) + 8192 * j + ldsw), 16, 0, 0); } while (0)
#define DMA_V(t, VO_) do { const bf16* vp = (t) == 0 ? Vm : Vr + (size_t)((VAR == 1 ? ((t) & 1) + 1 : (t)) - 1) * 64 * ldv; \
        _Pragma("unroll") for (int j = 0; j < NVP; ++j) __builtin_amdgcn_global_load_lds((const unsigned*)(vp + vsrc[j]), (LAS unsigned*)(ldsb + 3 * KB + (VO_) + 8192 * j + ldsw), 16, 0, 0); } while (0)
#define WAITBAR_N() do { if (VAR == 2) asm volatile("s_waitcnt vmcnt(%0) lgkmcnt(0)" :: "n"(NKP + NVP) : "memory"); else if (VAR == 3) asm volatile("s_waitcnt lgkmcnt(0)\n\ts_barrier" ::: "memory"); else asm volatile("s_waitcnt vmcnt(%0) lgkmcnt(0)\n\ts_barrier" :: "n"(NKP + NVP) : "memory"); } while (0)
#define WAITBAR_0() do { if (VAR == 2) asm volatile("s_waitcnt vmcnt(0) lgkmcnt(0)" ::: "memory"); else asm volatile("s_waitcnt vmcnt(0) lgkmcnt(0)\n\ts_barrier" ::: "memory"); } while (0)
    float mhat = 0.f, l_reg = 0.f, ccur = 0.f;
    f32x16 negm;
#pragma unroll
    for (int r = 0; r < 16; ++r) negm[r] = 0.f;
#pragma unroll
    for (int d = 0; d < ND0; ++d) o[d] = (f32x16){0.f, 0.f, 0.f, 0.f, 0.f, 0.f, 0.f, 0.f, 0.f, 0.f, 0.f, 0.f, 0.f, 0.f, 0.f, 0.f};
#define PK4(P, BASE, OUT) do { unsigned a0 = cvtpk(P[BASE + 0], P[BASE + 1]), a1 = cvtpk(P[BASE + 2], P[BASE + 3]), b0_ = cvtpk(P[BASE + 4], P[BASE + 5]), b1_ = cvtpk(P[BASE + 6], P[BASE + 7]); \
        auto r0 = __builtin_amdgcn_permlane32_swap(a0, b0_, false, false); auto r1 = __builtin_amdgcn_permlane32_swap(a1, b1_, false, false); \
        u32x4 w = {r0[0], r1[0], r0[1], r1[1]}; OUT = __builtin_bit_cast(bf16x8, w); } while (0)
#define LOADV(VV, D0) do { _Pragma("unroll") for (int ks_ = 0; ks_ < 4; ++ks_) { VV[2 * ks_] = vtr(vp_ + (D0) * 512 + ks_ * (NCB * 1024)); VV[2 * ks_ + 1] = vtr(vp_ + (D0) * 512 + ks_ * (NCB * 1024) + NCB * 512); } } while (0)
#define VFRAG(VV, ks_) (bf16x8){VV[2 * (ks_)][0], VV[2 * (ks_)][1], VV[2 * (ks_)][2], VV[2 * (ks_)][3], VV[2 * (ks_) + 1][0], VV[2 * (ks_) + 1][1], VV[2 * (ks_) + 1][2], VV[2 * (ks_) + 1][3]}
#define MMAV(VV, D0) do { o[D0] = __builtin_amdgcn_mfma_f32_32x32x16_bf16(pa0, VFRAG(VV, 0), o[D0], 0, 0, 0); if (VAR != 7) { o[D0] = __builtin_amdgcn_mfma_f32_32x32x16_bf16(pa1, VFRAG(VV, 1), o[D0], 0, 0, 0); \
        o[D0] = __builtin_amdgcn_mfma_f32_32x32x16_bf16(pa2, VFRAG(VV, 2), o[D0], 0, 0, 0); o[D0] = __builtin_amdgcn_mfma_f32_32x32x16_bf16(pa3, VFRAG(VV, 3), o[D0], 0, 0, 0); } else { asm volatile("" :: "v"(VV[2]), "v"(VV[3]), "v"(VV[4]), "v"(VV[5]), "v"(VV[6]), "v"(VV[7]), "v"(pa1), "v"(pa2), "v"(pa3)); } } while (0)
#define STEP(MODE_, TR_, KO_, VO_, DMA_STMT) do { \
        f32x16 p0, p1; \
        bool cinit = true;        \
        if ((MODE_) == 0) { cinit = false; \
            float neg_ = NEGBIG, zer_ = 0.f; asm volatile("" : "+v"(neg_), "+v"(zer_)); \
            _Pragma("unroll") for (int r = 0; r < 16; ++r) { p1[r] = neg_; \
                if (r < 8) { if (BIAS) { int idx = crow(r, hi) - NMETA - (qw0 + r32) + 128; idx = idx < 0 ? 0 : idx; p0[r] = btab[idx]; } else p0[r] = zer_; } \
                else p0[r] = neg_; } \
        } else if (BIAS) { \
            const int d = 64 * (TR_) - qw0; \
            if (d <= -154 || d >= 122) { const float cn = btab[d < 0 ? 0 : 256] - mhat; \
                if (__any(cn != ccur)) { ccur = cn; _Pragma("unroll") for (int r = 0; r < 16; ++r) negm[r] = cn; } } \
            else { cinit = false; const int ib = d + 4 * hi - r32 + 128; \
                _Pragma("unroll") for (int r = 0; r < 16; ++r) { int i0 = ib + (r & 3) + 8 * (r >> 2), i1 = i0 + 32; \
                    i0 = i0 < 0 ? 0 : (i0 > 256 ? 256 : i0); i1 = i1 < 0 ? 0 : (i1 > 256 ? 256 : i1); p0[r] = btab[i0] - mhat; p1[r] = btab[i1] - mhat; \
                    if ((r & 3) == 3) asm volatile("" ::: "memory"); } } \
        } \
        { const LAS char* Kb = (const LAS char*)ldsb + (KO_); bf16x8 kp[3][2]; \
          kp[0][0] = *(const LAS bf16x8*)(Kb + KOFF(0)); kp[0][1] = *(const LAS bf16x8*)(Kb + KOFF(0) + 32 * (DQK * 2)); \
          kp[1][0] = *(const LAS bf16x8*)(Kb + KOFF(1)); kp[1][1] = *(const LAS bf16x8*)(Kb + KOFF(1) + 32 * (DQK * 2)); \
          _Pragma("unroll") for (int d0 = 0; d0 < NQ; ++d0) { \
              SBAR(); \
              if (d0 + 2 < NQ) { if (VAR != 6) { kp[(d0 + 2) % 3][0] = *(const LAS bf16x8*)(Kb + KOFF(d0 + 2)); kp[(d0 + 2) % 3][1] = *(const LAS bf16x8*)(Kb + KOFF(d0 + 2) + 32 * (DQK * 2)); } else { kp[(d0 + 2) % 3][0] = kp[d0 % 3][0]; kp[(d0 + 2) % 3][1] = kp[d0 % 3][1]; } } \
              if (d0 == 0 && cinit) { p0 = __builtin_amdgcn_mfma_f32_32x32x16_bf16(kp[0][0], qr[0], negm, 0, 0, 0); p1 = __builtin_amdgcn_mfma_f32_32x32x16_bf16(kp[0][1], qr[0], negm, 0, 0, 0); } \
              else if (VAR != 7 || d0 == 0) { p0 = __builtin_amdgcn_mfma_f32_32x32x16_bf16(kp[d0 % 3][0], qr[d0], p0, 0, 0, 0); p1 = __builtin_amdgcn_mfma_f32_32x32x16_bf16(kp[d0 % 3][1], qr[d0], p1, 0, 0, 0); } \
              else { asm volatile("" :: "v"(kp[d0 % 3][0]), "v"(kp[d0 % 3][1])); } } \
          SBAR(); } \
        const lds_cptr vp_ = vp0 + (VO_); s16x4 va[8], vb[8]; \
        LOADV(va, 0); SBAR(); \
        DMA_STMT; SBAR(); \
          \
        float rm = fmaxf(fmaxf(p0[0], p0[1]), p1[0]); \
        _Pragma("unroll") for (int r = 2; r < 16; r += 2) rm = fmaxf(fmaxf(rm, p0[r]), p0[r + 1]); \
        _Pragma("unroll") for (int r = 1; r < 16; r += 2) rm = fmaxf(fmaxf(rm, p1[r]), p1[(r + 1) & 15]); \
        { auto rr = __builtin_amdgcn_permlane32_swap(__float_as_uint(rm), __float_as_uint(rm), false, false); rm = fmaxf(__uint_as_float(rr[0]), __uint_as_float(rr[1])); } \
        if ((MODE_) == 0 || __builtin_expect(__any(rm > THR_L2), 0)) { \
            const float dl = (MODE_) == 0 ? rm : fmaxf(rm, 0.f); mhat += dl; ccur -= dl; \
            _Pragma("unroll") for (int r = 0; r < 16; ++r) { p0[r] -= dl; p1[r] -= dl; negm[r] = ccur; } \
            if ((MODE_) != 0) { const float f = __builtin_amdgcn_exp2f(-dl); l_reg *= f; \
                if (hi == 0) al_l[r32] = f; asm volatile("s_waitcnt lgkmcnt(0)" ::: "memory"); \
                _Pragma("unroll") for (int d = 0; d < ND0; ++d) _Pragma("unroll") for (int r = 0; r < 16; ++r) o[d][r] *= al_l[crow(r, hi)]; } } \
        float ps = 0.f; \
        if (VAR != 4) { \
        _Pragma("unroll") for (int r = 0; r < 16; ++r) { p0[r] = __builtin_amdgcn_exp2f(p0[r]); ps += p0[r]; } \
        _Pragma("unroll") for (int r = 0; r < 16; ++r) { p1[r] = __builtin_amdgcn_exp2f(p1[r]); ps += p1[r]; } } \
        { auto rr = __builtin_amdgcn_permlane32_swap(__float_as_uint(ps), __float_as_uint(ps), false, false); ps = __uint_as_float(rr[0]) + __uint_as_float(rr[1]); } \
        l_reg += ps; \
        bf16x8 pa0, pa1, pa2, pa3; \
        PK4(p0, 0, pa0); PK4(p0, 8, pa1); PK4(p1, 0, pa2); PK4(p1, 8, pa3); \
        if (VAR != 5) { \
        _Pragma("unroll") for (int d0 = 0; d0 < NCB; d0 += 2) { \
            SBAR(); if (d0 + 1 < NCB) LOADV(vb, d0 + 1); MMAV(va, d0); \
            SBAR(); if (d0 + 2 < NCB) LOADV(va, d0 + 2); if (d0 + 1 < NCB) MMAV(vb, d0 + 1); } \
        } else { asm volatile("" :: "v"(pa0), "v"(pa1), "v"(pa2), "v"(pa3), "v"(va[0]), "v"(va[7])); } \
        SBAR(); } while (0)
    int kc = 0, kn = KB, kf = 2 * KB, vc = 0, vn = VB, vf = 2 * VB;
#define ROT() do { const int a_ = kc; kc = kn; kn = kf; kf = a_; const int b_ = vc; vc = vn; vn = vf; vf = b_; } while (0)
    DMA_K(0, 0); DMA_V(0, 0); DMA_K(1, KB); DMA_V(1, VB); WAITBAR_N();
    STEP(0, 0, kc, vc, { DMA_K(2, kf); DMA_V(2, vf); }); WAITBAR_N(); ROT();
#pragma unroll 1
    for (int t = 1; t <= 30; ++t) { STEP(1, t - 1, kc, vc, { if (VAR != 3) { DMA_K(t + 2, kf); DMA_V(t + 2, vf); } }); WAITBAR_N(); ROT(); }
    STEP(1, 30, kc, vc, {}); WAITBAR_0(); ROT();
    STEP(1, 31, kc, vc, {});
    __syncthreads();
#undef ROT
#undef STEP
#undef LOADV
#undef VFRAG
#undef MMAV
#undef KXW
#undef KOFF
#undef PK4
#undef DMA_K
#undef DMA_V
#undef WAITBAR_N
#undef WAITBAR_0
    l_out = l_reg;
}

template <int VAR = 0> __device__ __forceinline__ void mla_unit(unsigned char* ws, int bl, int h, int qb, LAS unsigned char* ldsb, bool nostore = false) {
    const int tid = opaque(threadIdx.x); int lane = tid & 63, r32 = lane & 31, hi = lane >> 5; const int wid = __builtin_amdgcn_readfirstlane(tid >> 6);
    char* lds = (char*)ldsb; float* wsc = (float*)(lds + LDS_WSC) + wid * 64;
    const size_t rb = (size_t)bl * SEQ; const int q0 = qb * 256;
    const bf16* QM = (const bf16*)(wsp(ws, WS_QM)); const bf16* KM = (const bf16*)(wsp(ws, WS_KM)); const bf16* VM = (const bf16*)(wsp(ws, WS_VM));
    f32x16 o[4]; float l;
    attn_pass<192, 128, false, VAR>(o, l, QM + (rb + q0) * 3072 + h * 192, 3072, KM + rb * 3072 + h * 192, KM + (size_t)MH * 3072 + h * 192, 3072,
                               VM + rb * 2048 + h * 128, VM + (size_t)MH * 2048 + h * 128, 2048, q0, ldsb);
    lane = opaque(lane); r32 = lane & 31; hi = lane >> 5;
    bf16* zp = (bf16*)(wsp(ws, WS_ZA)) + (rb + q0 + wid * 32 + (lane >> 4)) * 2048 + h * 128 + (lane & 15) * 8;
    u32x4 zv[8];
#pragma unroll
    for (int i = 0; i < 8; ++i) zv[i] = *(const u32x4*)(zp + (size_t)i * 4 * 2048);
    if (hi == 0) wsc[r32] = l; LDS_WAIT();
    bf16* stg = (bf16*)(lds + wid * 8192);
#pragma unroll
    for (int r = 0; r < 16; ++r) { const float rl = __builtin_amdgcn_rcpf(wsc[crow(r, hi)]); const int orow = crow(r, hi);
#pragma unroll
        for (int d0 = 0; d0 < 4; ++d0) { const unsigned w = cvtpk(o[d0][r] * rl, 0.f); stg[orow * 128 + d0 * 32 + r32] = (bf16)(w & 0xffffu); } }
    LDS_WAIT();
    const bf16* sp = stg + (lane >> 4) * 128 + (lane & 15) * 8;
#pragma unroll
    for (int i = 0; i < 8; ++i) {
        const u32x4 s = *(const u32x4*)(sp + i * 4 * 128); const u32x4 z = zv[i]; u32x4 w;
#pragma unroll
        for (int e = 0; e < 4; ++e) w[e] = cvtpk(bflo(s[e]) * bflo(z[e]), bfhi(s[e]) * bfhi(z[e]));
        if (!nostore) *(u32x4*)(zp + (size_t)i * 4 * 2048) = w; }
    __syncthreads();
}
constexpr int PS_PX = 131072;
template <int VAR = 0>
__device__ __forceinline__ void attn_pass_ps(f32x16 (&o)[4], float& l_out, const bf16* __restrict__ Q, int ldq, const bf16* __restrict__ Kr, const bf16* __restrict__ Km, int ldk,
                                             const bf16* __restrict__ Vr, const bf16* __restrict__ Vm, int ldv, int q0, LAS unsigned char* ldsb) {
    constexpr int NKP = 2, NVP = 4, KB = 16384, VB = 32768, NQ = 8, NCB = 8, VR0 = 2 * KB;
    const int tid = opaque(threadIdx.x), lane = tid & 63, r32 = lane & 31, hi = lane >> 5; const int wid = __builtin_amdgcn_readfirstlane(tid >> 6);
    const int pair = wid >> 1, half = wid & 1, grp = wid >> 2;
    char* lds = (char*)ldsb;
    float* wsc = (float*)(lds + LDS_WSC) + wid * 64; float* al_l = wsc + 32;
    float* rmx = (float*)(lds + LDS_WSS);
    const float* btab = (const float*)(lds + LDS_BT);
    const int qw0 = q0 + pair * 32;
    bf16x8 qr[NQ];
    { const bf16* Qw = Q + (size_t)(pair * 32 + r32) * ldq + hi * 8;
#pragma unroll
      for (int d0 = 0; d0 < NQ; ++d0) qr[d0] = *(const bf16x8*)(Qw + d0 * 16); }
    const lds_cptr vp0 = (lds_cptr)ldsb + VR0 + v_rd_base(lane) + half * (4 * 512);
    int koff[NQ];
#pragma unroll
    for (int d0 = 0; d0 < NQ; ++d0) koff[d0] = (32 * half + r32) * 256 + (((2 * d0 + hi) ^ (r32 & 15)) << 4);
    unsigned ksrc[NKP], vsrc[NVP];
#pragma unroll
    for (int j = 0; j < NKP; ++j) { const int off = 8192 * j + 16 * tid, row = off >> 8, cpos = (off & 255) >> 4; ksrc[j] = (unsigned)(row * ldk + ((cpos ^ (row & 15)) << 3)); }
#pragma unroll
    for (int j = 0; j < NVP; ++j) { const int off = 8192 * j + 16 * tid, st = off >> 9, kk = (st / NCB) * 8 + ((off & 511) >> 6), c = (st % NCB) * 32 + ((off & 63) >> 1);
        const int k = (kk & ~0xC) | ((kk & 4) << 1) | ((kk & 8) >> 1); vsrc[j] = (unsigned)(k * ldv + c); }
    const unsigned ldsw = (unsigned)wid * 1024u;
    const LAS char* pxo = (const LAS char*)ldsb + PS_PX + wid * 2048 + lane * 16;
    const LAS char* pxp = (const LAS char*)ldsb + PS_PX + (wid ^ 1) * 2048 + lane * 16;
#define DMA_K(t, KO_) do { const bf16* kp_ = (t) == 0 ? Km : Kr + (size_t)((t) - 1) * 64 * ldk; \
        _Pragma("unroll") for (int j = 0; j < NKP; ++j) __builtin_amdgcn_global_load_lds((const unsigned*)(kp_ + ksrc[j]), (LAS unsigned*)(ldsb + (KO_) + 8192 * j + ldsw), 16, 0, 0); } while (0)
#define DMA_V(t, VO_) do { const bf16* vp_g = (t) == 0 ? Vm : Vr + (size_t)((t) - 1) * 64 * ldv; \
        _Pragma("unroll") for (int j = 0; j < NVP; ++j) __builtin_amdgcn_global_load_lds((const unsigned*)(vp_g + vsrc[j]), (LAS unsigned*)(ldsb + VR0 + (VO_) + 8192 * j + ldsw), 16, 0, 0); } while (0)
#define BAR_L() asm volatile("s_waitcnt lgkmcnt(0)\n\ts_barrier" ::: "memory")
#define WAIT_E() asm volatile("s_waitcnt vmcnt(%0) lgkmcnt(0)\n\ts_barrier" :: "n"(NKP + NVP) : "memory")
#define WAIT_O() asm volatile("s_waitcnt vmcnt(%0) lgkmcnt(0)\n\ts_barrier" :: "n"(NVP) : "memory")
#define WAITBAR_0() asm volatile("s_waitcnt vmcnt(0) lgkmcnt(0)\n\ts_barrier" ::: "memory")
    float mhat = 0.f, l_reg = 0.f, ccur = 0.f;
#pragma unroll
    for (int d = 0; d < 4; ++d) o[d] = (f32x16){0.f, 0.f, 0.f, 0.f, 0.f, 0.f, 0.f, 0.f, 0.f, 0.f, 0.f, 0.f, 0.f, 0.f, 0.f, 0.f};
#define PK4(P, BASE, OUT) do { unsigned a0 = cvtpk(P[BASE + 0], P[BASE + 1]), a1 = cvtpk(P[BASE + 2], P[BASE + 3]), b0_ = cvtpk(P[BASE + 4], P[BASE + 5]), b1_ = cvtpk(P[BASE + 6], P[BASE + 7]); \
        auto r0 = __builtin_amdgcn_permlane32_swap(a0, b0_, false, false); auto r1 = __builtin_amdgcn_permlane32_swap(a1, b1_, false, false); \
        u32x4 w = {r0[0], r1[0], r0[1], r1[1]}; OUT = __builtin_bit_cast(bf16x8, w); } while (0)
#define LOADV(VV, D0) do { _Pragma("unroll") for (int j_ = 0; j_ < 2; ++j_) { VV[2 * j_] = vtr(vown_ + (D0) * 512 + j_ * 8192); VV[2 * j_ + 1] = vtr(vown_ + (D0) * 512 + j_ * 8192 + 4096); \
        VV[4 + 2 * j_] = vtr(vpar_ + (D0) * 512 + j_ * 8192); VV[4 + 2 * j_ + 1] = vtr(vpar_ + (D0) * 512 + j_ * 8192 + 4096); } } while (0)
#define VFRAG(VV, ks_) (bf16x8){VV[2 * (ks_)][0], VV[2 * (ks_)][1], VV[2 * (ks_)][2], VV[2 * (ks_)][3], VV[2 * (ks_) + 1][0], VV[2 * (ks_) + 1][1], VV[2 * (ks_) + 1][2], VV[2 * (ks_) + 1][3]}
#define MMAV(VV, D0) do { o[D0] = __builtin_amdgcn_mfma_f32_32x32x16_bf16(pk0, VFRAG(VV, 0), o[D0], 0, 0, 0); o[D0] = __builtin_amdgcn_mfma_f32_32x32x16_bf16(pk1, VFRAG(VV, 1), o[D0], 0, 0, 0); \
        o[D0] = __builtin_amdgcn_mfma_f32_32x32x16_bf16(pk2, VFRAG(VV, 2), o[D0], 0, 0, 0); o[D0] = __builtin_amdgcn_mfma_f32_32x32x16_bf16(pk3, VFRAG(VV, 3), o[D0], 0, 0, 0); } while (0)
#define H1(MODE_, TR_, KO_, DMA_STMT) do { \
        f32x16 p; bool cinit = true; \
        if ((MODE_) == 0) { cinit = false; float neg_ = NEGBIG; asm volatile("" : "+v"(neg_)); \
            _Pragma("unroll") for (int r = 0; r < 16; ++r) { if (r < 8 && half == 0) { int idx = crow(r, hi) - NMETA - (qw0 + r32) + 128; idx = idx < 0 ? 0 : idx; p[r] = btab[idx] - mhat; } else p[r] = neg_; } \
        } else { const int d = 64 * (TR_) + 32 * half - qw0; \
            if (d <= -122 || d >= 122) { const float cn = btab[d < 0 ? 0 : 256] - mhat; \
                ccur = cn; } \
            else { cinit = false; const int ib = d + 4 * hi - r32 + 128; \
                _Pragma("unroll") for (int r = 0; r < 16; ++r) { int i0 = ib + (r & 3) + 8 * (r >> 2); i0 = i0 < 0 ? 0 : (i0 > 256 ? 256 : i0); p[r] = btab[i0] - mhat; \
                    if ((r & 3) == 3) asm volatile("" ::: "memory"); } } } \
        if (cinit) { _Pragma("unroll") for (int r = 0; r < 16; ++r) p[r] = ccur; }        \
        { const LAS char* Kb = (const LAS char*)ldsb + (KO_); bf16x8 kp[3]; \
          kp[0] = *(const LAS bf16x8*)(Kb + koff[0]); kp[1] = *(const LAS bf16x8*)(Kb + koff[1]); \
          _Pragma("unroll") for (int d0 = 0; d0 < NQ; ++d0) { \
              SBAR(); if (d0 + 2 < NQ) kp[(d0 + 2) % 3] = *(const LAS bf16x8*)(Kb + koff[d0 + 2]); \
              p = __builtin_amdgcn_mfma_f32_32x32x16_bf16(kp[d0 % 3], qr[d0], p, 0, 0, 0); } \
          SBAR(); } \
        DMA_STMT; SBAR(); \
        rm = fmaxf(fmaxf(p[0], p[1]), p[2]); \
        _Pragma("unroll") for (int r = 3; r < 15; r += 2) rm = fmaxf(fmaxf(rm, p[r]), p[r + 1]); \
        rm = fmaxf(rm, p[15]); \
        { auto rr = __builtin_amdgcn_permlane32_swap(__float_as_uint(rm), __float_as_uint(rm), false, false); rm = fmaxf(__uint_as_float(rr[0]), __uint_as_float(rr[1])); } \
        if (hi == 0) rmx[wid * 32 + r32] = rm; \
        float ps = 0.f; \
        _Pragma("unroll") for (int r = 0; r < 16; ++r) { p[r] = __builtin_amdgcn_exp2f(p[r]); ps += p[r]; } \
        { auto rr = __builtin_amdgcn_permlane32_swap(__float_as_uint(ps), __float_as_uint(ps), false, false); ps = __uint_as_float(rr[0]) + __uint_as_float(rr[1]); } \
        l_reg += ps; \
        PK4(p, 0, pw0); PK4(p, 8, pw1); \
        *(LAS bf16x8*)(pxo) = pw0; *(LAS bf16x8*)(pxo + 1024) = pw1; } while (0)
#define H2(VO_, DMA_STMT) do { \
        DMA_STMT; SBAR(); \
        const lds_cptr vown_ = vp0 + (VO_) + half * 16384, vpar_ = vp0 + (VO_) + (1 - half) * 16384; s16x4 va[8], vb[8]; \
        LOADV(va, 0); \
        const bf16x8 pq0 = *(const LAS bf16x8*)(pxp), pq1 = *(const LAS bf16x8*)(pxp + 1024); \
        const float rmp = fmaxf(rm, rmx[(wid ^ 1) * 32 + r32]); \
        const bf16x8 pk0 = pw0, pk1 = pw1, pk2 = pq0, pk3 = pq1; \
        SBAR(); LOADV(vb, 1); MMAV(va, 0); \
        SBAR(); LOADV(va, 2); MMAV(vb, 1); \
        SBAR(); LOADV(vb, 3); MMAV(va, 2); \
        SBAR(); MMAV(vb, 3); \
        SBAR(); \
        if (__builtin_expect(__any(rmp > THR_L2), 0)) {   \
            const float dl = fmaxf(rmp, 0.f); mhat += dl; ccur -= dl; \
            const float f = __builtin_amdgcn_exp2f(-dl); l_reg *= f; \
            if (hi == 0) al_l[r32] = f; asm volatile("s_waitcnt lgkmcnt(0)" ::: "memory"); \
            _Pragma("unroll") for (int dd = 0; dd < 4; ++dd) { _Pragma("unroll") for (int r = 0; r < 16; ++r) o[dd][r] *= al_l[crow(r, hi)]; } } } while (0)
    bf16x8 pw0, pw1; float rm;
    int v0 = 0, v1 = VB, v2 = 2 * VB;
#define ROTV() do { const int b_ = v0; v0 = v1; v1 = v2; v2 = b_; } while (0)
#define KS(t) (((t) & 1) * KB)
    DMA_K(0, 0); DMA_V(0, 0); DMA_K(1, KB); DMA_V(1, VB);
    asm volatile("s_waitcnt vmcnt(%0) lgkmcnt(0)\n\ts_barrier" :: "n"(NKP + 2 * NVP) : "memory");
    if (grp == 0) {
        H1(0, 0, KS(0), {}); WAIT_E(); H2(v0, { DMA_V(2, v2); }); WAIT_O(); ROTV();
#pragma unroll 1
        for (int t = 1; t <= 30; ++t) { H1(1, t - 1, KS(t), { DMA_K(t + 1, KS(t + 1)); }); WAIT_E(); H2(v0, { DMA_V(t + 2, v2); }); WAIT_O(); ROTV(); }
        H1(1, 30, KS(31), { DMA_K(32, KS(32)); }); WAIT_E(); H2(v0, {}); WAITBAR_0(); ROTV();
        H1(1, 31, KS(32), {}); WAITBAR_0(); H2(v0, {}); BAR_L();
        BAR_L();
    } else {
        WAIT_E();
        H1(0, 0, KS(0), {}); WAIT_O(); H2(v0, { DMA_K(2, KS(2)); DMA_V(2, v2); }); WAIT_E(); ROTV();
#pragma unroll 1
        for (int t = 1; t <= 30; ++t) { H1(1, t - 1, KS(t), {}); WAIT_O(); H2(v0, { DMA_K(t + 2, KS(t + 2)); DMA_V(t + 2, v2); }); WAIT_E(); ROTV(); }
        H1(1, 30, KS(31), {}); WAITBAR_0(); H2(v0, {}); WAITBAR_0(); ROTV();
        H1(1, 31, KS(32), {}); BAR_L(); H2(v0, {}); BAR_L();
    }
    if (hi == 0) rmx[wid * 32 + r32] = l_reg;
    BAR_L();
    l_out = l_reg + rmx[(wid ^ 1) * 32 + r32];
    __syncthreads();
#undef ROTV
#undef KS
#undef H1
#undef H2
#undef LOADV
#undef VFRAG
#undef MMAV
#undef PK4
#undef DMA_K
#undef DMA_V
#undef BAR_L
#undef WAIT_E
#undef WAIT_O
#undef WAITBAR_0
}

template <int VAR = 0> __device__ __forceinline__ void diff_unit_ps(unsigned char* ws, float* o1s, const float* subln, int bl, int h, int qb, LAS unsigned char* ldsb, bool nostore = false) {
    const int tid = opaque(threadIdx.x); int lane = tid & 63, r32 = lane & 31, hi = lane >> 5; const int wid = __builtin_amdgcn_readfirstlane(tid >> 6);
    const int pair = wid >> 1, half = wid & 1;
    char* lds = (char*)ldsb; float* wsc = (float*)(lds + LDS_WSC) + wid * 64; float* wss = (float*)(lds + LDS_X);
    const size_t rb = (size_t)bl * SEQ; const int q0 = qb * 128;
    const bf16* QD = (const bf16*)(wsp(ws, WS_QD)); const bf16* KD = (const bf16*)(wsp(ws, WS_KD)); const bf16* VD = (const bf16*)(wsp(ws, WS_VD));
    { float* bt = (float*)(lds + LDS_BT); const float* src = (const float*)(wsp(ws, WS_TAB) + TAB_BIAS) + h * 260; if (tid < 257) bt[tid] = src[tid]; }
    __syncthreads();
    const float lam = *(const float*)(wsp(ws, WS_TAB) + TAB_LAM);
    const size_t stb = ((size_t)blockIdx.x * 4 + pair) * (32 * 256) + half * 128;
#pragma unroll 1
    for (int mp = 0; mp < 2; ++mp) {
        f32x16 o[4]; float l;
        attn_pass_ps<VAR>(o, l, QD + (rb + q0) * 2048 + h * 256 + mp * 128, 2048, KD + rb * 2048 + h * 256 + mp * 128, KD + (size_t)MH * 2048 + h * 256 + mp * 128, 2048,
                          VD + rb * 2048 + h * 256, VD + (size_t)MH * 2048 + h * 256, 2048, q0, ldsb);
        lane = opaque(lane); r32 = lane & 31; hi = lane >> 5;
        GF* st = (GF*)o1s + stb + r32;
        if (mp == 0) {
            if (hi == 0) wsc[r32] = l; LDS_WAIT();
#pragma unroll
            for (int r = 0; r < 16; ++r) { const float rl = __builtin_amdgcn_rcpf(wsc[crow(r, hi)]); GF* sp = st + crow(r, hi) * 256; asm volatile("" : "+v"(sp));
#pragma unroll
                for (int d0 = 0; d0 < 4; ++d0) sp[d0 * 32] = o[d0][r] * rl; }
            asm volatile("s_waitcnt vmcnt(0) lgkmcnt(0)" ::: "memory");
        } else {
            float o1[16][4];
#pragma unroll
            for (int r = 0; r < 16; ++r) { const GF* sp = st + crow(r, hi) * 256;
#pragma unroll
                for (int d0 = 0; d0 < 4; ++d0) o1[r][d0] = sp[d0 * 32]; }
            if (hi == 0) wsc[r32] = l; LDS_WAIT();
            float* ys = (float*)(lds + wid * 16384) + r32;
#pragma unroll
            for (int r = 0; r < 16; ++r) { const float rl = __builtin_amdgcn_rcpf(wsc[crow(r, hi)]); float sq = 0.f;
#pragma unroll
                for (int d0 = 0; d0 < 4; ++d0) { const float y = o1[r][d0] - lam * (o[d0][r] * rl); ys[crow(r, hi) * 128 + d0 * 32] = y; sq += y * y; }
                sq += __shfl_xor(sq, 1); sq += __shfl_xor(sq, 2); sq += __shfl_xor(sq, 4); sq += __shfl_xor(sq, 8); sq += __shfl_xor(sq, 16);
                if (r32 == 0) wss[wid * 32 + crow(r, hi)] = sq; }
        }
    }
    { bf16* zp = (bf16*)(wsp(ws, WS_ZB)) + (rb + q0 + pair * 32 + (lane >> 4)) * 2048 + h * 256 + half * 128 + (lane & 15) * 8;
      u32x4 zv[8];
#pragma unroll
      for (int i = 0; i < 8; ++i) zv[i] = *(const u32x4*)(zp + (size_t)i * 4 * 2048);
      const f32x4 g0 = *(const f32x4*)(subln + half * 128 + (lane & 15) * 8), g1 = *(const f32x4*)(subln + half * 128 + (lane & 15) * 8 + 4);
      __syncthreads();
      const float* yl = (const float*)(lds + wid * 16384) + (lane >> 4) * 128 + (lane & 15) * 8;
#pragma unroll
      for (int i = 0; i < 8; ++i) { const int row = 4 * i + (lane >> 4);
          const float rsn = __builtin_amdgcn_rsqf((wss[wid * 32 + row] + wss[(wid ^ 1) * 32 + row]) * (1.f / 256.f) + EPS) * 0.8f;
          const f32x4 y0 = *(const f32x4*)(yl + i * 4 * 128), y1 = *(const f32x4*)(yl + i * 4 * 128 + 4); const u32x4 z = zv[i]; u32x4 w;
          w[0] = cvtpk(y0[0] * rsn * g0[0] * bflo(z[0]), y0[1] * rsn * g0[1] * bfhi(z[0])); w[1] = cvtpk(y0[2] * rsn * g0[2] * bflo(z[1]), y0[3] * rsn * g0[3] * bfhi(z[1]));
          w[2] = cvtpk(y1[0] * rsn * g1[0] * bflo(z[2]), y1[1] * rsn * g1[1] * bfhi(z[2])); w[3] = cvtpk(y1[2] * rsn * g1[2] * bflo(z[3]), y1[3] * rsn * g1[3] * bfhi(z[3]));
          if (!nostore) *(u32x4*)(zp + (size_t)i * 4 * 2048) = w; } }
    __syncthreads();
}

template <int VAR = 0> __device__ __forceinline__ void diff_unit(unsigned char* ws, float* o1s, const float* subln, int bl, int h, int qb, LAS unsigned char* ldsb, bool nostore = false) {
    const int tid = opaque(threadIdx.x); int lane = tid & 63, r32 = lane & 31, hi = lane >> 5; const int wid = __builtin_amdgcn_readfirstlane(tid >> 6);
    char* lds = (char*)ldsb; float* wsc = (float*)(lds + LDS_WSC) + wid * 64; float* wss = (float*)(lds + LDS_WSS) + wid * 32;
    const size_t rb = (size_t)bl * SEQ; const int q0 = qb * 256;
    const bf16* QD = (const bf16*)(wsp(ws, WS_QD)); const bf16* KD = (const bf16*)(wsp(ws, WS_KD)); const bf16* VD = (const bf16*)(wsp(ws, WS_VD));
    { float* bt = (float*)(lds + LDS_BT); const float* src = (const float*)(wsp(ws, WS_TAB) + TAB_BIAS) + h * 260; for (int i = tid; i < 257; i += NTHREADS) bt[i] = src[i]; }
    __syncthreads();
    const float lam = *(const float*)(wsp(ws, WS_TAB) + TAB_LAM);
#pragma unroll 1
    for (int pass = 0; pass < 4; ++pass) {
        const int mp = pass >> 1, vh = pass & 1;
        f32x16 o[4]; float l;
        attn_pass<128, 128, true, VAR>(o, l, QD + (rb + q0) * 2048 + h * 256 + mp * 128, 2048, KD + rb * 2048 + h * 256 + mp * 128, KD + (size_t)MH * 2048 + h * 256 + mp * 128, 2048,
                                  VD + rb * 2048 + h * 256 + vh * 128, VD + (size_t)MH * 2048 + h * 256 + vh * 128, 2048, q0, ldsb);
        lane = opaque(lane); r32 = lane & 31; hi = lane >> 5;
        if (hi == 0) wsc[r32] = l; LDS_WAIT();
        GF* st = (GF*)o1s + ((size_t)blockIdx.x * 8 + wid) * (32 * 256) + vh * 128 + r32;
        if (mp == 0) {
#pragma unroll
            for (int r = 0; r < 16; ++r) { const float rl = __builtin_amdgcn_rcpf(wsc[crow(r, hi)]); GF* sp = st + crow(r, hi) * 256;
#pragma unroll
                for (int d0 = 0; d0 < 4; ++d0) sp[d0 * 32] = o[d0][r] * rl; }
        } else {
#pragma unroll
            for (int r = 0; r < 16; ++r) { const float rl = __builtin_amdgcn_rcpf(wsc[crow(r, hi)]); GF* sp = st + crow(r, hi) * 256; float sq = 0.f;
#pragma unroll
                for (int d0 = 0; d0 < 4; ++d0) { const float y = sp[d0 * 32] - lam * (o[d0][r] * rl); sp[d0 * 32] = y; sq += y * y; }
                sq += __shfl_xor(sq, 1); sq += __shfl_xor(sq, 2); sq += __shfl_xor(sq, 4); sq += __shfl_xor(sq, 8); sq += __shfl_xor(sq, 16);
                if (r32 == 0) { if (vh == 0) wss[crow(r, hi)] = sq; else wss[crow(r, hi)] += sq; } }
        }
        asm volatile("s_waitcnt vmcnt(0) lgkmcnt(0)" ::: "memory");
    }
    { const GF* yp = (const GF*)o1s + ((size_t)blockIdx.x * 8 + wid) * (32 * 256) + (lane >> 5) * 256 + (lane & 31) * 8;
      bf16* zp = (bf16*)(wsp(ws, WS_ZB)) + (rb + q0 + wid * 32 + (lane >> 5)) * 2048 + h * 256 + (lane & 31) * 8;
      const f32x4 g0 = *(const f32x4*)(subln + (lane & 31) * 8), g1 = *(const f32x4*)(subln + (lane & 31) * 8 + 4);
#pragma unroll 4
      for (int i = 0; i < 16; ++i, zp += 2 * 2048, yp += 2 * 256) {
          const float rsn = __builtin_amdgcn_rsqf(wss[2 * i + (lane >> 5)] * (1.f / 256.f) + EPS) * 0.8f;
          const f32x4 y0 = *(const __attribute__((address_space(1))) f32x4*)yp, y1 = *(const __attribute__((address_space(1))) f32x4*)(yp + 4); const u32x4 z = *(const u32x4*)zp; u32x4 w;
          w[0] = cvtpk(y0[0] * rsn * g0[0] * bflo(z[0]), y0[1] * rsn * g0[1] * bfhi(z[0])); w[1] = cvtpk(y0[2] * rsn * g0[2] * bflo(z[1]), y0[3] * rsn * g0[3] * bfhi(z[1]));
          w[2] = cvtpk(y1[0] * rsn * g1[0] * bflo(z[2]), y1[1] * rsn * g1[1] * bfhi(z[2])); w[3] = cvtpk(y1[2] * rsn * g1[2] * bflo(z[3]), y1[3] * rsn * g1[3] * bfhi(z[3]));
          if (!nostore) *(u32x4*)zp = w; } }
    __syncthreads();
}

template <class Map>
__device__ __forceinline__ void transpose_item(const float* __restrict__ W, int Nsrc, int K, bf16* __restrict__ WT, LAS float* scr, int item, int lane, const float* __restrict__ gain, Map map) {
    const int nkb = K / 64, nb = item / nkb, kb = item % nkb, k0 = 64 * kb, n0 = 64 * nb;
    const int sc = map(n0 + lane);
    float v[64];
    const float* wp = W + (size_t)k0 * Nsrc + (sc >= 0 ? sc : 0);
#pragma unroll
    for (int i = 0; i < 64; ++i) v[i] = __builtin_nontemporal_load(wp + (size_t)i * Nsrc);
    if (gain) {
#pragma unroll
        for (int i = 0; i < 64; ++i) v[i] *= gain[k0 + i]; }
#pragma unroll
    for (int i = 0; i < 64; ++i) scr[i * 65 + lane] = (sc >= 0) ? v[i] : 0.f;
    LDS_WAIT(); asm volatile("" ::: "memory");
    const int c = lane & 7;
#pragma unroll
    for (int j = 0; j < 8; ++j) { const int n = (lane >> 3) + 8 * j; const LAS float* s = scr + (8 * c) * 65 + n;
        u32x4 o; o.x = cvtpk(s[0 * 65], s[1 * 65]); o.y = cvtpk(s[2 * 65], s[3 * 65]); o.z = cvtpk(s[4 * 65], s[5 * 65]); o.w = cvtpk(s[6 * 65], s[7 * 65]);
        *(u32x4*)(WT + (size_t)(n0 + n) * K + k0 + 8 * c) = o; }
    LDS_WAIT(); asm volatile("" ::: "memory");
}
__device__ __forceinline__ int rope_orig(int c) { return 32 * ((c >> 2) & 1) + 4 * (c >> 3) + (c & 3); }
struct MapWin { __device__ int operator()(int n) const { if (n < 1280) return n; if (n < 1536) { const int c = n - 1280; return c < 64 ? 1280 + rope_orig(c) : -1; } return n - 192; } };
struct MapWuq { __device__ int operator()(int n) const { const int h = n >> 8, c = n & 255; if (c < 128) return h * 192 + c; if (c < 192) return h * 192 + 128 + rope_orig(c - 128); return -1; } };
struct MapId { __device__ int operator()(int n) const { return n; } };

__device__ __forceinline__ int t5_bucket(int rel) {
    const int n = rel < 0 ? -rel : rel; int b;
    if (n < 8) b = n; else b = 8 + (n >= 12) + (n >= 16) + (n >= 23) + (n >= 32) + (n >= 46) + (n >= 64) + (n >= 91);
    return b + (rel > 0 ? 16 : 0);
}
__device__ __forceinline__ void rms_row_bf16(const float* __restrict__ xrow, const float* __restrict__ g, bf16* __restrict__ orow, int lane) {
    u32x4* o16 = (u32x4*)orow + lane;
    if (!xrow) {
#pragma unroll
        for (int j = 0; j < 4; ++j) o16[64 * j] = (u32x4){0u, 0u, 0u, 0u};
        return; }
    const f32x4* xr = (const f32x4*)xrow + 2 * lane; const f32x4* gr = (const f32x4*)g + 2 * lane;
    f32x4 v[8]; float s = 0.f;
#pragma unroll
    for (int j = 0; j < 4; ++j) { v[2 * j] = __builtin_nontemporal_load(xr + 128 * j); v[2 * j + 1] = __builtin_nontemporal_load(xr + 128 * j + 1); }
#pragma unroll
    for (int j = 0; j < 8; ++j) s += (v[j][0] * v[j][0] + v[j][1] * v[j][1]) + (v[j][2] * v[j][2] + v[j][3] * v[j][3]);
    const float rs = __builtin_amdgcn_rsqf(wave_sum(s) * (1.f / 2048.f) + EPS);
#pragma unroll
    for (int j = 0; j < 4; ++j) { const f32x4 g0 = gr[128 * j], g1 = gr[128 * j + 1]; const f32x4 y0 = v[2 * j] * rs * g0, y1 = v[2 * j + 1] * rs * g1;
        o16[64 * j] = (u32x4){cvtpk(y0[0], y0[1]), cvtpk(y0[2], y0[3]), cvtpk(y1[0], y1[1]), cvtpk(y1[2], y1[3])}; }
}
__device__ __forceinline__ void rms_row2_bf16(const float* __restrict__ x0, const float* __restrict__ x1, const float* __restrict__ g, bf16* __restrict__ o0, bf16* __restrict__ o1, int lane) {
    const f32x4* xa = (const f32x4*)x0 + 2 * lane; const f32x4* xb = (const f32x4*)x1 + 2 * lane; const f32x4* gr = (const f32x4*)g + 2 * lane;
    f32x4 va[8], vb[8]; float sa = 0.f, sb = 0.f;
#pragma unroll
    for (int j = 0; j < 4; ++j) { va[2 * j] = __builtin_nontemporal_load(xa + 128 * j); va[2 * j + 1] = __builtin_nontemporal_load(xa + 128 * j + 1); vb[2 * j] = __builtin_nontemporal_load(xb + 128 * j); vb[2 * j + 1] = __builtin_nontemporal_load(xb + 128 * j + 1); }
#pragma unroll
    for (int j = 0; j < 8; ++j) { sa += (va[j][0] * va[j][0] + va[j][1] * va[j][1]) + (va[j][2] * va[j][2] + va[j][3] * va[j][3]); sb += (vb[j][0] * vb[j][0] + vb[j][1] * vb[j][1]) + (vb[j][2] * vb[j][2] + vb[j][3] * vb[j][3]); }
    const float ra = __builtin_amdgcn_rsqf(wave_sum(sa) * (1.f / 2048.f) + EPS), rb = __builtin_amdgcn_rsqf(wave_sum(sb) * (1.f / 2048.f) + EPS);
    u32x4* oa = (u32x4*)o0 + lane; u32x4* ob = (u32x4*)o1 + lane;
#pragma unroll
    for (int j = 0; j < 4; ++j) { const f32x4 g0 = gr[128 * j], g1 = gr[128 * j + 1];
        const f32x4 y0 = va[2 * j] * ra * g0, y1 = va[2 * j + 1] * ra * g1, z0 = vb[2 * j] * rb * g0, z1 = vb[2 * j + 1] * rb * g1;
        oa[64 * j] = (u32x4){cvtpk(y0[0], y0[1]), cvtpk(y0[2], y0[3]), cvtpk(y1[0], y1[1]), cvtpk(y1[2], y1[3])};
        ob[64 * j] = (u32x4){cvtpk(z0[0], z0[1]), cvtpk(z0[2], z0[3]), cvtpk(z1[0], z1[1]), cvtpk(z1[2], z1[3])}; }
}
template <int PART>
__device__ __forceinline__ void p0_part(LAS unsigned char* ldsb, int vcu, int G) {
    const int tid = opaque(threadIdx.x), lane = tid & 63; const int wave = __builtin_amdgcn_readfirstlane(tid >> 6);
    LAS float* scr = (LAS float*)(ldsb + wave * 16896);
    const int gw = vcu * NWAVES + wave, NGW = G * NWAVES;
    unsigned char* ws = kws();
    constexpr int I_WIN = (NIN / 64) * 32, I_WUQ = 64 * 12, I_WUKV = 64 * 8, I_SQ = 32 * 32;
    if (PART == 0) {
        for (int it = gw; it < I_WIN + I_WUQ + I_WUKV; it += NGW) {
            int r = it;
            if (r < I_WIN) { transpose_item(kin(4), INW, 2048, (bf16*)(wsp(ws, WS_WIN)), scr, r, lane, nullptr, MapWin()); continue; } r -= I_WIN;
            if (r < I_WUQ) { transpose_item(kin(7), 3072, 768, (bf16*)(wsp(ws, WS_WUQ)), scr, r, lane, kin(5), MapWuq()); continue; } r -= I_WUQ;
            transpose_item(kin(8), 4096, 512, (bf16*)(wsp(ws, WS_WUKV)), scr, r, lane, kin(6), MapId());
        }
    } else {
        for (int it = gw; it < 3 * I_SQ; it += NGW) {
            int r = it;
            if (r < I_SQ) { transpose_item(kin(15), 2048, 2048, (bf16*)(wsp(ws, WS_WA)), scr, r, lane, nullptr, MapId()); continue; } r -= I_SQ;
            if (r < I_SQ) { transpose_item(kin(16), 2048, 2048, (bf16*)(wsp(ws, WS_WB)), scr, r, lane, nullptr, MapId()); continue; } r -= I_SQ;
            transpose_item(kin(17), 2048, 2048, (bf16*)(wsp(ws, WS_WO)), scr, r, lane, nullptr, MapId());
        }
    }
    bf16* ureal = (bf16*)((unsigned char*)kout() + (size_t)64 * 1024 * 1024); bf16* umeta = (bf16*)(wsp(ws, WS_UMETA));
    constexpr int RB = PART == 0 ? 0 : MH, NR = PART == 0 ? MH + 256 : MH;
    for (int r = gw; r < NR; r += 2 * NGW) {
        const int r2 = r + NGW;
        if (r2 < MH) { const int m = RB + r, m2 = RB + r2; rms_row2_bf16(kin(0) + (size_t)m * DM, kin(0) + (size_t)m2 * DM, kin(3), ureal + (size_t)m * DM, ureal + (size_t)m2 * DM, lane); continue; }
#pragma unroll 1
        for (int q = 0; q < 2; ++q) { const int rr = r + q * NGW; if (rr >= NR) break;
            if (rr < MH) { const int mm = RB + rr; rms_row_bf16(kin(0) + (size_t)mm * DM, kin(3), ureal + (size_t)mm * DM, lane); }
            else { const int j = rr - MH; rms_row_bf16(j < NMETA ? kin(1) + (size_t)j * DM : nullptr, kin(3), umeta + (size_t)j * DM, lane); } }
    }
    if (PART == 0) {
        const int gt = vcu * NTHREADS + tid, NGT = G * NTHREADS;
        float* ctab = (float*)(wsp(ws, WS_TAB) + TAB_COS); float* stab = (float*)(wsp(ws, WS_TAB) + TAB_SIN); float* btab = (float*)(wsp(ws, WS_TAB) + TAB_BIAS);
        for (int i = gt; i < 2064 * 32; i += NGT) { const int pos = i >> 5, k = i & 31; const float inv = powf(10000.f, -(float)k / 32.f); const float ang = (float)pos * inv; ctab[i] = cosf(ang); stab[i] = sinf(ang); }
        for (int i = gt; i < 8 * 257; i += NGT) { const int h = i / 257, j = i % 257; btab[h * 260 + j] = kin(2)[t5_bucket(j - 128) * 8 + h] * LOG2E; }
        if (vcu == 0 && wave == 0) { const float* dl = kin(13);
            float a = dl[lane] * dl[128 + lane] + dl[64 + lane] * dl[192 + lane], b = dl[256 + lane] * dl[384 + lane] + dl[320 + lane] * dl[448 + lane];
            a = wave_sum(a); b = wave_sum(b); if (lane == 0) *(float*)(wsp(ws, WS_TAB) + TAB_LAM) = __expf(a) - __expf(b) + 0.2f; }
    }
}

#ifndef MK_PH_LO
#define MK_PH_LO 0
#define MK_PH_HI 99
#endif
#ifndef MK_ONLY
#define MK_ON(n) 1
#else
#define MK_ON(n) (MK_ONLY == (n))
#endif
#ifndef MK_REPEAT
#define MK_REPEAT -1
#endif
#ifdef MK_VARIANT
#define MK_SKIPEPI(n, rep) ((MK_VARIANT == 9) && (MK_REPEAT == (n)) && (rep) == 0)
#else
#define MK_SKIPEPI(n, rep) false
#endif
#define MK_REP(n) ((MK_REPEAT == (n)) ? 2 : ((n) == 9 ? 0 : 1))
#define WSL() kws()
template <int half> __device__ __forceinline__ void run_half(LAS unsigned char* lds, const XcdBarrier& xb, int G, int bx, int vcu) {
        unsigned char* ws;
        for (int rep = 0; rep < MK_REP(1); ++rep) { ws = WSL(); if (MK_ON(1)) { SchedP1 S; S.T.init(half == 0 ? 33 : 32, 62, G, bx); S.U = (const char*)kout() + (size_t)64 * 1024 * 1024 + (size_t)half * MH * 2048 * 2; S.Umeta = (const char*)(wsp(ws, WS_UMETA)); S.W = (const char*)(wsp(ws, WS_WIN));
          EpiP1 E{ws, kin(11), kin(12), MK_SKIPEPI(1, rep)};
          gemm_phase(lds, 2048, 2048, 32, S, E); } }
        xcd_barrier(xb);
        for (int rep = 0; rep < MK_REP(2); ++rep) { for (int rq = 0; rq < MK_REP(21); ++rq) { ws = WSL(); if (MK_ON(2)) { SchedP2Q S; S.T.init(32, 16, G, bx); S.CQ = (const char*)(wsp(ws, WS_CQ)); S.W = (const char*)(wsp(ws, WS_WUQ)); EpiP2Q E{ws, kin(9), MK_SKIPEPI(2, rep)};
          gemm_phase(lds, 768, 768, 12, S, E); } }
        for (int rk = 0; rk < MK_REP(22); ++rk) { ws = WSL(); if (MK_ON(3)) { SchedP2KV S; S.T.init(half == 0 ? 33 : 32, 16, G, bx); S.CKV = (const char*)(wsp(ws, WS_CKV)); S.W = (const char*)(wsp(ws, WS_WUKV)); EpiP2KV E{ws, kin(10), MK_SKIPEPI(2, rep)};
          gemm_phase(lds, 512, 512, 8, S, E); } } }
        xcd_barrier(xb);
        for (int rep = 0; rep < ((MK_REPEAT >= 3 && MK_REPEAT <= 5) ? 2 : 1); ++rep) { const bool ns = (rep == 0) && (MK_REPEAT >= 3 && MK_REPEAT <= 5); const bool do_mla = !ns || MK_REPEAT != 5, do_diff = !ns || MK_REPEAT != 4; ws = WSL(); { const int x = vcu >> 5, v = vcu & 31;
          float* o1s = half == 0 ? kout() : (float*)(wsp(ws, WS_WIN));
          if (G == 256) {
#ifdef MK_VARIANT
              if (ns) { if (do_mla) for (int i = 0; i < 2; ++i) { const int pair = 8 * x + 4 * i + (v >> 3); mla_unit<MK_VARIANT>(ws, pair >> 4, pair & 15, v & 7, lds, true); }
                        if (do_diff) for (int i = 0; i < 2; ++i) { const int pair = 4 * x + 2 * i + (v >> 4); diff_unit_ps<MK_VARIANT>(ws, o1s, kin(14), pair >> 3, pair & 7, v & 15, lds, true); } } else
#endif
              {
              if (MK_ON(4) && do_mla) for (int i = 0; i < 2; ++i) { if (half == 0 && (vcu & 3) == i) { p0_part<1>(lds, vcu, G); __syncthreads(); }
                  const int pair = 8 * x + 4 * i + (v >> 3); mla_unit(ws, pair >> 4, pair & 15, v & 7, lds, ns); }
              if (MK_ON(5) && do_diff) for (int i = 0; i < 2; ++i) { if (half == 0 && (vcu & 3) == 2 + i) { p0_part<1>(lds, vcu, G); __syncthreads(); }
                  const int pair = 4 * x + 2 * i + (v >> 4); diff_unit_ps(ws, o1s, kin(14), pair >> 3, pair & 7, v & 15, lds, ns); }
              }
          } else {
              if (half == 0) { p0_part<1>(lds, vcu, G); __syncthreads(); }
              if (MK_ON(4)) for (int uidx = bx; uidx < 512; uidx += G) mla_unit(ws, uidx >> 7, (uidx >> 3) & 15, uidx & 7, lds, ns);
              if (MK_ON(5)) for (int uidx = bx; uidx < 512; uidx += G) diff_unit_ps(ws, o1s, kin(14), uidx >> 7, (uidx >> 4) & 7, uidx & 15, lds, ns);
          } } }
        xcd_barrier(xb);
        for (int rep = 0; rep < MK_REP(6); ++rep) { ws = WSL(); if (MK_ON(6)) { SchedP4 S; S.T.init(32, 8, G, bx); S.OA = (const char*)(wsp(ws, WS_ZA)); S.OB = (const char*)(wsp(ws, WS_ZB)); S.WA = (const char*)(wsp(ws, WS_WA)); S.WB = (const char*)(wsp(ws, WS_WB)); S.dbg = kdbg();
          EpiP4 E{ws, kdbg()}; gemm_phase(lds, 2048, 2048, 32, S, E); } }
        xcd_barrier(xb);
        for (int rep = 0; rep < MK_REP(7); ++rep) { ws = WSL(); if (MK_ON(7)) { SchedP5 S; S.T.init(32, 8, G, bx); S.MB = (const char*)(wsp(ws, WS_MB)); S.WO = (const char*)(wsp(ws, WS_WO));
          EpiP5 E{kin(0) + (size_t)half * MH * DM, kout() + (size_t)half * MH * DM}; gemm_phase(lds, 2048, 2048, 32, S, E); } }
    }
__global__ void __launch_bounds__(NTHREADS, 2) mega(Params p) {
    extern __shared__ __attribute__((aligned(16))) unsigned char lds_raw[];
    LAS unsigned char* lds = (LAS unsigned char*)lds_raw;
    cg::grid_group grid = cg::this_grid();
    const int G = gridDim.x, bx = blockIdx.x; const int vcu = (G % 8 == 0) ? (bx % 8) * (G / 8) + bx / 8 : bx;
    if (threadIdx.x < 4) ((LAS unsigned*)(lds + LDS_MISC))[threadIdx.x] = 0u;
    __syncthreads();
    const XcdBarrier xb = xcd_barrier_post((unsigned*)(kws() + WS_CTL) + 4096, (volatile LAS unsigned*)(lds + LDS_MISC));
    { unsigned* xr = (unsigned*)(kws() + WS_CTL) + 8192;
      if (threadIdx.x == 0) ((LAS unsigned*)(lds + LDS_MISC))[2] = xb_add(&xr[64 * (xb.x & 15)], 1u); }
    for (int rep = 0; rep < MK_REP(0); ++rep) { if (MK_ON(0)) p0_part<0>(lds, vcu, G); }
    grid.sync();
    for (int rep = 0; rep < MK_REP(9); ++rep) xcd_barrier(xb);
    int lb = bx;
    { unsigned* xr = (unsigned*)(kws() + WS_CTL) + 8192; bool ok = (G % 8 == 0) && xb.x < 8u;
      unsigned cv[8];
#pragma unroll
      for (int j = 0; j < 8; ++j) cv[j] = xb_ld(&xr[64 * j]);
      unsigned bad = 0u;
#pragma unroll
      for (int j = 0; j < 8; ++j) bad |= cv[j] ^ (unsigned)(G / 8);
      ok = ok && (bad == 0u);
      const int rank = (int)((volatile LAS unsigned*)(lds + LDS_MISC))[2];
      if (ok) lb = rank * 8 + (int)xb.x; }
    lb = __builtin_amdgcn_readfirstlane(lb);
    const int vcu2 = (G % 8 == 0) ? (lb % 8) * (G / 8) + lb / 8 : lb;
    run_half<0>(lds, xb, G, lb, vcu2);
    run_half<1>(lds, xb, G, lb, vcu2);
}
}
extern "C" void kernel_launch(void* const* d_in, const int* in_sizes, int n_in, void* d_out, int out_size, void* d_ws, size_t ws_size, hipStream_t stream) {
    static int grid_blocks = 0;
    if (!grid_blocks) {
        int dev = 0, cus = 0, per_cu = 0;
        (void)hipGetDevice(&dev);
        (void)hipDeviceGetAttribute(&cus, hipDeviceAttributeMultiprocessorCount, dev);
        (void)hipFuncSetAttribute((const void*)mk::mega, hipFuncAttributeMaxDynamicSharedMemorySize, mk::LDS_BYTES);
        (void)hipOccupancyMaxActiveBlocksPerMultiprocessor(&per_cu, (const void*)mk::mega, mk::NTHREADS, mk::LDS_BYTES);
        if (per_cu < 1) per_cu = 1;
        grid_blocks = cus * per_cu;
        if (ws_size < mk::WS_CTL + mk::CTL_BYTES) { fprintf(stderr, "kernel_launch: workspace too small: %zu < %zu\n", ws_size, (size_t)mk::WS_END); grid_blocks = -1; }
    }
    if (grid_blocks < 0) return;
    (void)hipMemsetAsync((char*)d_ws + mk::WS_CTL, 0, mk::CTL_BYTES, stream);
    mk::Params p{};
    for (int i = 0; i < 18; ++i) p.in[i] = (const float*)d_in[i];
    p.out = (float*)d_out; p.ws = (unsigned char*)d_ws;
    void* args[] = {&p};
    hipError_t e = hipLaunchCooperativeKernel((const void*)mk::mega, dim3(grid_blocks), dim3(mk::NTHREADS), args, mk::LDS_BYTES, stream);
    if (e != hipSuccess) fprintf(stderr, "cooperative launch failed: %s (grid %d)\n", hipGetErrorString(e), grid_blocks);
}
```
